# Optimizing an MI355X kernel written in HIP

```python
import jax
import jax.numpy as jnp
from jax import lax
import numpy as np

D_MODEL = 1024
BATCH = 8
SEQ = 2048
DEPTH = 2

MEM_LEN = 256
HEAD_DIM = 64
BRANCH_WIDTH = D_MODEL // 2
N_BRANCH = 3
RW_HEADS = BRANCH_WIDTH // HEAD_DIM
RW_WIDTH = RW_HEADS * HEAD_DIM
RW_DECAY_LORA = 64
RW_AAA_LORA = 64
RW_MV_LORA = 32
RW_GATE_LORA = 128
RW_LNX_EPS = 1e-5 * HEAD_DIM
RW_COLS = 3 * RW_WIDTH + RW_DECAY_LORA + RW_AAA_LORA + RW_GATE_LORA
RW_SPLITS = [RW_WIDTH, 2 * RW_WIDTH, 3 * RW_WIDTH, 3 * RW_WIDTH + RW_DECAY_LORA, 3 * RW_WIDTH + RW_DECAY_LORA + RW_AAA_LORA]
MB_HEADS = BRANCH_WIDTH // HEAD_DIM
MB_WIDTH = MB_HEADS * HEAD_DIM
MB_BLOCK = 256
MB_TOPK = 3
MB_QCHUNK = 32
MB_COLS = 3 * MB_WIDTH
SW_Q_HEADS = BRANCH_WIDTH // HEAD_DIM
SW_KV_HEADS = SW_Q_HEADS // 4
SW_WIDTH = SW_Q_HEADS * HEAD_DIM
SW_KV_WIDTH = SW_KV_HEADS * HEAD_DIM
SW_WINDOW = 128
SW_COLS = SW_WIDTH + 2 * SW_KV_WIDTH
GATE_COLS = N_BRANCH * D_MODEL
IN_COLS = RW_COLS + MB_COLS + SW_COLS + GATE_COLS
XA_HEADS = 4
XA_HEAD_DIM = 128
XA_WIDTH = XA_HEADS * XA_HEAD_DIM
D_FF = 4 * D_MODEL
ROPE_THETA = 10000.0
NORM_EPS = 1e-6
MASK_VALUE = -1e30

kernel_name = 'hybrid_rwkv7_moba_swa_gated_block'


def rms_norm(x, g):
    xf = x.astype(jnp.float32)
    y = xf * lax.rsqrt(jnp.mean(jnp.square(xf), axis=-1, keepdims=True) + NORM_EPS)
    return (y * g.astype(jnp.float32)).astype(x.dtype)


def rope_tables(positions):
    inv_freq = 1.0 / (ROPE_THETA ** (jnp.arange(0, HEAD_DIM, 2, dtype=jnp.float32) / HEAD_DIM))
    ang = positions.astype(jnp.float32)[..., None] * inv_freq
    return jnp.cos(ang), jnp.sin(ang)


def apply_rope(t, cos, sin):
    tf = t.astype(jnp.float32)
    t1, t2 = jnp.split(tf, 2, axis=-1)
    c = cos[:, :, None, :]
    s = sin[:, :, None, :]
    return jnp.concatenate([t1 * c - t2 * s, t2 * c + t1 * s], axis=-1).astype(t.dtype)


def token_shift_lerp(u, mu):
    prev = jnp.pad(u, ((0, 0), (1, 0), (0, 0)))[:, :-1]
    return u + mu * (prev - u)


def rwkv7_scan(r, w, k, v, kk, a):
    B, S, H, N = r.shape

    def step(state, inp):
        r_t, w_t, k_t, v_t, kk_t, a_t = inp
        sa = jnp.einsum('bhvk,bhk->bhv', state, -kk_t)
        state = (state * w_t[:, :, None, :]
                 + sa[..., :, None] * (kk_t * a_t)[:, :, None, :]
                 + v_t[..., :, None] * k_t[:, :, None, :])
        return state, jnp.einsum('bhvk,bhk->bhv', state, r_t)

    xs = tuple(jnp.moveaxis(t, 1, 0) for t in (r, w, k, v, kk, a))
    _, out = lax.scan(step, jnp.zeros((B, H, N, N), jnp.float32), xs)
    return jnp.moveaxis(out, 0, 1)


def rwkv7_branch(u, mu, w0, w_up, a0, a_up, g_up, k_k, k_a, r_k, lnx_w, lnx_b, v_first, v_gate):
    B, S, _ = u.shape
    H, N = RW_HEADS, HEAD_DIM
    f32 = jnp.float32
    u = token_shift_lerp(u, mu)
    r, k, v, xw, xa, xg = jnp.split(u, RW_SPLITS, axis=-1)
    w_log = -jax.nn.softplus(-(w0 + jnp.tanh(xw) @ w_up).astype(f32)) - 0.5
    decay = jnp.exp(-jnp.exp(w_log))
    a = jax.nn.sigmoid((a0 + xa @ a_up).astype(f32))
    g = jax.nn.sigmoid(xg) @ g_up
    if v_gate is not None:
        v = v + (v_first - v) * v_gate
    kk = (k * k_k).astype(f32).reshape(B, S, H, N)
    kk = kk / jnp.maximum(jnp.sqrt(jnp.sum(kk * kk, axis=-1, keepdims=True)), 1e-12)
    k_eff = k.astype(f32) * (1.0 + (a - 1.0) * k_a)

    def heads(t):
        return t.astype(f32).reshape(B, S, H, N)

    rh, kh, vh, wh, ah = heads(r), heads(k_eff), heads(v), heads(decay), heads(a)
    out = rwkv7_scan(rh, wh, kh, vh, kk, ah)
    mean = jnp.mean(out, axis=-1, keepdims=True)
    var = jnp.mean(jnp.square(out - mean), axis=-1, keepdims=True)
    out = ((out - mean) * lax.rsqrt(var + RW_LNX_EPS)).reshape(B, S, RW_WIDTH) * lnx_w + lnx_b
    bonus = (jnp.sum(rh * kh * r_k, axis=-1, keepdims=True) * vh).reshape(B, S, RW_WIDTH)
    o = ((out + bonus) * g.astype(f32)).astype(u.dtype)
    return o, v


def moba_attention(q, k, v):
    B, S, H, hd = q.shape
    nb = -(-S // MB_BLOCK)
    s_pad = nb * MB_BLOCK
    pad = ((0, 0), (0, 0), (0, s_pad - S), (0, 0))
    qh = (q * hd ** -0.5).transpose(0, 2, 1, 3)
    kp = jnp.pad(k.transpose(0, 2, 1, 3), pad)
    vp = jnp.pad(v.transpose(0, 2, 1, 3), pad)
    kb = kp.reshape(B, H, nb, MB_BLOCK, hd)
    vb = vp.reshape(B, H, nb, MB_BLOCK, hd)
    k_mean = jnp.mean(kb.astype(jnp.float32), axis=3).astype(k.dtype)
    top_k = min(MB_TOPK, max(nb - 1, 1))
    b_idx = jnp.arange(B)[:, None, None, None]
    h_idx = jnp.arange(H)[None, :, None, None]
    blk_ids = jnp.arange(nb)
    own_offsets = jnp.arange(MB_BLOCK)

    def chunk(c):
        q0 = c * MB_QCHUNK
        own = q0 // MB_BLOCK
        qc = lax.dynamic_slice_in_dim(qh, q0, MB_QCHUNK, axis=2)
        q_pos = q0 + jnp.arange(MB_QCHUNK)
        gate = jnp.einsum('bhqd,bhnd->bhqn', qc, k_mean).astype(jnp.float32)
        gate = jnp.where(blk_ids < own, gate, MASK_VALUE)
        _, idx = lax.top_k(gate, top_k)
        sel_ok = idx < own
        k_sel = kb[b_idx, h_idx, idx]
        v_sel = vb[b_idx, h_idx, idx]
        s_sel = jnp.einsum('bhqd,bhqjkd->bhqjk', qc, k_sel).astype(jnp.float32)
        s_sel = jnp.where(sel_ok[..., None], s_sel, MASK_VALUE).reshape(B, H, MB_QCHUNK, top_k * MB_BLOCK)
        k_own = lax.dynamic_slice_in_dim(kp, own * MB_BLOCK, MB_BLOCK, axis=2)
        v_own = lax.dynamic_slice_in_dim(vp, own * MB_BLOCK, MB_BLOCK, axis=2)
        k_pos = own * MB_BLOCK + own_offsets
        s_own = jnp.einsum('bhqd,bhkd->bhqk', qc, k_own).astype(jnp.float32)
        s_own = jnp.where(k_pos[None, :] <= q_pos[:, None], s_own, MASK_VALUE)
        p = jax.nn.softmax(jnp.concatenate([s_sel, s_own], axis=-1), axis=-1).astype(v.dtype)
        p_sel = p[..., :top_k * MB_BLOCK].reshape(B, H, MB_QCHUNK, top_k, MB_BLOCK)
        p_own = p[..., top_k * MB_BLOCK:]
        return (jnp.einsum('bhqjk,bhqjkd->bhqd', p_sel, v_sel)
                + jnp.einsum('bhqk,bhkd->bhqd', p_own, v_own))

    out = lax.map(chunk, jnp.arange(S // MB_QCHUNK))
    return out.transpose(1, 0, 3, 2, 4).reshape(B, S, H * hd)


def swa_sink_attention(q, k, v, sinks):
    B, S, HQ, hd = q.shape
    HKV = k.shape[2]
    G = HQ // HKV
    W = SW_WINDOW
    nblk = S // W
    qb = (q * hd ** -0.5).reshape(B, nblk, W, HKV, G, hd)

    def with_prev(t):
        tb = t.reshape(B, nblk, W, HKV, hd)
        prev = jnp.pad(tb, ((0, 0), (1, 0), (0, 0), (0, 0), (0, 0)))[:, :-1]
        return jnp.concatenate([prev, tb], axis=2)

    kk = with_prev(k)
    vv = with_prev(v)
    s = jnp.einsum('bnqhgd,bnkhd->bnhgqk', qb, kk).astype(jnp.float32)
    q_rel = jnp.arange(W)[:, None] + W
    k_rel = jnp.arange(2 * W)[None, :]
    dist = q_rel - k_rel
    band = (dist >= 0) & (dist < W)
    has_prev = (jnp.arange(nblk) > 0)[:, None, None]
    mask = band[None] & (has_prev | (k_rel >= W)[None])
    s = jnp.where(mask[None, :, None, None], s, MASK_VALUE)
    sink = jnp.broadcast_to(sinks.astype(jnp.float32).reshape(HKV, G)[None, None, :, :, None, None],
                            s.shape[:-1] + (1,))
    p = jax.nn.softmax(jnp.concatenate([s, sink], axis=-1), axis=-1)[..., :-1].astype(v.dtype)
    o = jnp.einsum('bnhgqk,bnkhd->bnqhgd', p, vv)
    return o.reshape(B, S, HQ * hd)


def memory_cross_attention(h, mem_n, wq, wk, wv, wo):
    B, S, _ = h.shape
    M = mem_n.shape[1]
    q = (h @ wq).reshape(B, S, XA_HEADS, XA_HEAD_DIM) * XA_HEAD_DIM ** -0.5
    k = (mem_n @ wk).reshape(B, M, XA_HEADS, XA_HEAD_DIM)
    v = (mem_n @ wv).reshape(B, M, XA_HEADS, XA_HEAD_DIM)
    s = jnp.einsum('bshd,bmhd->bhsm', q, k).astype(jnp.float32)
    p = jax.nn.softmax(s, axis=-1).astype(v.dtype)
    o = jnp.einsum('bhsm,bmhd->bshd', p, v).reshape(B, S, XA_WIDTH)
    return o @ wo


def squared_relu_mlp(h, w_up, w_down):
    return jnp.square(jax.nn.relu(h @ w_up)) @ w_down


def setup_inputs(seed: int = 0) -> dict:
    key = jax.random.key(seed)
    keys = iter(jax.random.split(key, 48))
    L = DEPTH
    D = D_MODEL
    f32 = jnp.float32

    def dense(shape, fan_in, scale=1.0):
        return jax.random.normal(next(keys), shape, f32) * (scale * fan_in ** -0.5)

    def gain(shape):
        return 1.0 + 0.02 * jax.random.normal(next(keys), shape, f32)

    def noise(shape, scale):
        return scale * jax.random.normal(next(keys), shape, f32)

    def unif(shape, lo, hi):
        return jax.random.uniform(next(keys), shape, f32, lo, hi)

    x = jax.random.normal(next(keys), (BATCH, SEQ, D), f32)
    mem = jax.random.normal(next(keys), (BATCH, MEM_LEN, D), f32)
    offset = jax.random.randint(next(keys), (BATCH, 1), 0, 4096, jnp.int32)
    positions = (jnp.arange(SEQ, dtype=jnp.int32)[None, :] + offset).astype(jnp.int32)
    return {
        'x': x,
        'mem': mem,
        'positions': positions,
        'norm_mix_pre': gain((L, D)),
        'norm_mix_post': gain((L, D)),
        'norm_xattn_pre': gain((L, D)),
        'norm_xattn_post': gain((L, D)),
        'norm_mem': gain((L, D)),
        'norm_mlp_pre': gain((L, D)),
        'norm_mlp_post': gain((L, D)),
        'w_in': dense((L, D, IN_COLS), D),
        'rw_mu': unif((L, RW_COLS), 0.0, 1.0),
        'rw_w0': unif((L, RW_WIDTH), -6.0, -1.0),
        'rw_w_up': dense((L, RW_DECAY_LORA, RW_WIDTH), RW_DECAY_LORA, 0.5),
        'rw_a0': noise((L, RW_WIDTH), 0.1),
        'rw_a_up': dense((L, RW_AAA_LORA, RW_WIDTH), RW_AAA_LORA),
        'rw_g_up': dense((L, RW_GATE_LORA, RW_WIDTH), RW_GATE_LORA),
        'rw_k_k': 0.85 + noise((L, RW_WIDTH), 0.02),
        'rw_k_a': 1.0 + noise((L, RW_WIDTH), 0.02),
        'rw_r_k': noise((L, RW_HEADS, HEAD_DIM), 0.1),
        'rw_lnx_w': gain((L, RW_WIDTH)),
        'rw_lnx_b': noise((L, RW_WIDTH), 0.01),
        'rw_vres_down': dense((L - 1, D, RW_MV_LORA), D),
        'rw_vres_mu': unif((L - 1, RW_MV_LORA), 0.0, 1.0),
        'rw_v0': 1.0 + noise((L - 1, RW_WIDTH), 0.1),
        'rw_vres_up': dense((L - 1, RW_MV_LORA, RW_WIDTH), RW_MV_LORA),
        'sw_sinks': noise((L, SW_Q_HEADS), 1.0),
        'w_branch': dense((L, N_BRANCH, BRANCH_WIDTH, D), BRANCH_WIDTH),
        'w_out': dense((L, D, D), D),
        'w_xq': dense((L, D, XA_WIDTH), D),
        'w_xk': dense((L, D, XA_WIDTH), D),
        'w_xv': dense((L, D, XA_WIDTH), D),
        'w_xo': dense((L, XA_WIDTH, D), XA_WIDTH),
        'w_up': dense((L, D, D_FF), D),
        'w_down': dense((L, D_FF, D), D_FF),
    }


def reference(x, mem, positions, norm_mix_pre, norm_mix_post, norm_xattn_pre, norm_xattn_post,
              norm_mem, norm_mlp_pre, norm_mlp_post, w_in, rw_mu, rw_w0, rw_w_up, rw_a0, rw_a_up,
              rw_g_up, rw_k_k, rw_k_a, rw_r_k, rw_lnx_w, rw_lnx_b, rw_vres_down, rw_vres_mu, rw_v0,
              rw_vres_up, sw_sinks, w_branch, w_out, w_xq, w_xk, w_xv, w_xo, w_up, w_down):
    B, S, D = x.shape
    cos, sin = rope_tables(positions)
    col_splits = [RW_COLS, RW_COLS + MB_COLS, RW_COLS + MB_COLS + SW_COLS]
    v_first = None
    for l in range(DEPTH):
        h = rms_norm(x, norm_mix_pre[l])
        u = h @ w_in[l]
        u_rw, u_mb, u_sw, u_gate = jnp.split(u, col_splits, axis=-1)
        if l == 0:
            v_gate = None
        else:
            vm = token_shift_lerp(h @ rw_vres_down[l - 1], rw_vres_mu[l - 1])
            v_gate = jax.nn.sigmoid(rw_v0[l - 1] + vm @ rw_vres_up[l - 1])
        o_rw, v_rw = rwkv7_branch(u_rw, rw_mu[l], rw_w0[l], rw_w_up[l], rw_a0[l], rw_a_up[l],
                                  rw_g_up[l], rw_k_k[l], rw_k_a[l], rw_r_k[l], rw_lnx_w[l],
                                  rw_lnx_b[l], v_first, v_gate)
        if l == 0:
            v_first = v_rw
        mq, mk, mv = jnp.split(u_mb, 3, axis=-1)
        mq = apply_rope(mq.reshape(B, S, MB_HEADS, HEAD_DIM), cos, sin)
        mk = apply_rope(mk.reshape(B, S, MB_HEADS, HEAD_DIM), cos, sin)
        o_mb = moba_attention(mq, mk, mv.reshape(B, S, MB_HEADS, HEAD_DIM))
        sq, sk, sv = jnp.split(u_sw, [SW_WIDTH, SW_WIDTH + SW_KV_WIDTH], axis=-1)
        sq = apply_rope(sq.reshape(B, S, SW_Q_HEADS, HEAD_DIM), cos, sin)
        sk = apply_rope(sk.reshape(B, S, SW_KV_HEADS, HEAD_DIM), cos, sin)
        o_sw = swa_sink_attention(sq, sk, sv.reshape(B, S, SW_KV_HEADS, HEAD_DIM), sw_sinks[l])
        branches = jnp.stack([o_rw, o_mb, o_sw], axis=2)
        proj = jnp.einsum('bsnc,ncd->bsnd', branches, w_branch[l])
        gates = jax.nn.sigmoid(u_gate.reshape(B, S, N_BRANCH, D))
        y = jnp.sum(gates * proj, axis=2) @ w_out[l]
        x = x + rms_norm(y, norm_mix_post[l])
        h = rms_norm(x, norm_xattn_pre[l])
        m = rms_norm(mem, norm_mem[l])
        xa = memory_cross_attention(h, m, w_xq[l], w_xk[l], w_xv[l], w_xo[l])
        x = x + rms_norm(xa, norm_xattn_post[l])
        h = rms_norm(x, norm_mlp_pre[l])
        x = x + rms_norm(squared_relu_mlp(h, w_up[l], w_down[l]), norm_mlp_post[l])
    return x
```

```cpp
#include <hip/hip_runtime.h>
#include <cstdio>
#include <cstdint>
#include <cmath>
namespace nv {
constexpr int S = 2048, D = 1024, NB = 8, INC = 7168, RWC = 1792, MBC = 1536, SWC = 768, FF = 4096, ML = 256;

__device__ __forceinline__ float wsum(float v) {
#pragma unroll
    for (int o = 1; o < 64; o <<= 1) v += __shfl_xor(v, o);
    return v;
}
__device__ __forceinline__ float wmax(float v) {
#pragma unroll
    for (int o = 1; o < 64; o <<= 1) v = fmaxf(v, __shfl_xor(v, o));
    return v;
}
__device__ __forceinline__ float sigm(float x) { return 1.f / (1.f + expf(-x)); }

__global__ void k_rmsnorm(const float* __restrict__ in, const float* __restrict__ g, float* __restrict__ out, int rows) {
    int row = blockIdx.x * 4 + (threadIdx.x >> 6), lane = threadIdx.x & 63;
    if (row >= rows) return;
    const float* p = in + (size_t)row * D; float v[16]; float s = 0.f;
#pragma unroll
    for (int j = 0; j < 16; ++j) { v[j] = p[lane + 64 * j]; s += v[j] * v[j]; }
    s = wsum(s); float rs = rsqrtf(s * (1.f / D) + 1e-6f);
#pragma unroll
    for (int j = 0; j < 16; ++j) out[(size_t)row * D + lane + 64 * j] = v[j] * rs * g[lane + 64 * j];
}
__global__ void k_addnorm(float* __restrict__ x, const float* __restrict__ y, const float* __restrict__ g, int rows) {
    int row = blockIdx.x * 4 + (threadIdx.x >> 6), lane = threadIdx.x & 63;
    if (row >= rows) return;
    const float* p = y + (size_t)row * D; float v[16]; float s = 0.f;
#pragma unroll
    for (int j = 0; j < 16; ++j) { v[j] = p[lane + 64 * j]; s += v[j] * v[j]; }
    s = wsum(s); float rs = rsqrtf(s * (1.f / D) + 1e-6f);
#pragma unroll
    for (int j = 0; j < 16; ++j) x[(size_t)row * D + lane + 64 * j] += v[j] * rs * g[lane + 64 * j];
}
__global__ void __launch_bounds__(256) k_gemm(const float* __restrict__ A, int lda, const float* __restrict__ B, int ldb, float* __restrict__ C, int ldc, int M, int N, int K) {
    __shared__ float As[16][68]; __shared__ float Bs[16][68];
    const int tx = threadIdx.x & 15, ty = threadIdx.x >> 4, m0 = blockIdx.y * 64, n0 = blockIdx.x * 64;
    float acc[4][4];
#pragma unroll
    for (int i = 0; i < 4; ++i)
#pragma unroll
        for (int j = 0; j < 4; ++j) acc[i][j] = 0.f;
    for (int k0 = 0; k0 < K; k0 += 16) {
#pragma unroll
        for (int e = 0; e < 4; ++e) { int idx = threadIdx.x + 256 * e; int r = idx >> 4, c = idx & 15; As[c][r] = A[(size_t)(m0 + r) * lda + k0 + c]; }
#pragma unroll
        for (int e = 0; e < 4; ++e) { int idx = threadIdx.x + 256 * e; int r = idx >> 6, c = idx & 63; Bs[r][c] = (n0 + c < N) ? B[(size_t)(k0 + r) * ldb + n0 + c] : 0.f; }
        __syncthreads();
#pragma unroll
        for (int kk = 0; kk < 16; ++kk) {
            float a[4], b[4];
#pragma unroll
            for (int i = 0; i < 4; ++i) { a[i] = As[kk][ty * 4 + i]; b[i] = Bs[kk][tx * 4 + i]; }
#pragma unroll
            for (int i = 0; i < 4; ++i)
#pragma unroll
                for (int j = 0; j < 4; ++j) acc[i][j] += a[i] * b[j];
        }
        __syncthreads();
    }
#pragma unroll
    for (int i = 0; i < 4; ++i)
#pragma unroll
        for (int j = 0; j < 4; ++j) { int c = n0 + tx * 4 + j; if (c < N) C[(size_t)(m0 + ty * 4 + i) * ldc + c] = acc[i][j]; }
}
__global__ void k_ropetab(const int* __restrict__ pos, float2* __restrict__ cs) {
    int idx = blockIdx.x * 256 + threadIdx.x; if (idx >= S * 32) return;
    int t = idx >> 5, i = idx & 31; double ang = (double)pos[t] * pow(10000.0, -(double)i / 32.0);
    cs[idx] = make_float2((float)cos(ang), (float)sin(ang));
}
__global__ void k_rope(float* __restrict__ p, int ld, int nh, const float2* __restrict__ cs) {
    int idx = blockIdx.x * 256 + threadIdx.x; if (idx >= S * nh * 32) return;
    int i = idx & 31, h = (idx >> 5) % nh, t = idx / (32 * nh);
    float* q = p + (size_t)t * ld + h * 64; float2 c = cs[t * 32 + i]; float a = q[i], b = q[i + 32];
    q[i] = a * c.x - b * c.y; q[i + 32] = b * c.x + a * c.y;
}
__global__ void k_shift(const float* __restrict__ u, int ldu, const float* __restrict__ mu, float* __restrict__ us, int C) {
    int idx = blockIdx.x * 256 + threadIdx.x; if (idx >= S * C) return;
    int t = idx / C, c = idx % C; float cur = u[(size_t)t * ldu + c], prev = t > 0 ? u[(size_t)(t - 1) * ldu + c] : 0.f;
    us[(size_t)t * C + c] = cur + mu[c] * (prev - cur);
}
__global__ void k_map(const float* __restrict__ in, int ldi, float* __restrict__ out, int C, int mode) {
    int idx = blockIdx.x * 256 + threadIdx.x; if (idx >= S * C) return;
    int t = idx / C, c = idx % C; float v = in[(size_t)t * ldi + c];
    out[idx] = mode == 0 ? tanhf(v) : sigm(v);
}
__global__ void k_rwprep(const float* __restrict__ us, const float* __restrict__ wl, const float* __restrict__ al, const float* __restrict__ vgl,
                         const float* __restrict__ w0, const float* __restrict__ a0, const float* __restrict__ v0, float* __restrict__ vfirst, int layer,
                         float* __restrict__ W, float* __restrict__ Aa, float* __restrict__ V) {
    int idx = blockIdx.x * 256 + threadIdx.x; if (idx >= S * 512) return;
    int t = idx >> 9, c = idx & 511;
    float z = w0[c] + wl[idx]; float nz = -z; float sp = nz > 20.f ? nz : log1pf(expf(nz)); float wlog = -sp - 0.5f;
    W[idx] = expf(-expf(wlog));
    Aa[idx] = sigm(a0[c] + al[idx]);
    float v = us[(size_t)t * RWC + 1024 + c];
    if (layer == 0) vfirst[idx] = v; else { float vg = sigm(v0[c] + vgl[idx]); v = v + (vfirst[idx] - v) * vg; }
    V[idx] = v;
}
__global__ void k_rwkk(const float* __restrict__ us, const float* __restrict__ Aa, const float* __restrict__ k_k, const float* __restrict__ k_a,
                       float* __restrict__ KK, float* __restrict__ Bb, float* __restrict__ KE) {
    int idx = blockIdx.x * 256 + threadIdx.x; if (idx >= S * 8) return;
    int t = idx >> 3, h = idx & 7; const float* k = us + (size_t)t * RWC + 512 + h * 64; float n2 = 0.f;
    for (int i = 0; i < 64; ++i) { float x = k[i] * k_k[h * 64 + i]; n2 += x * x; }
    float inv = 1.f / fmaxf(sqrtf(n2), 1e-12f);
    for (int i = 0; i < 64; ++i) { int c = h * 64 + i; size_t o = (size_t)t * 512 + c; float a = Aa[o]; float kkv = k[i] * k_k[c] * inv; KK[o] = kkv; Bb[o] = kkv * a; KE[o] = k[i] * (1.f + (a - 1.f) * k_a[c]); }
}
__global__ void __launch_bounds__(64) k_rwscan(const float* __restrict__ us, const float* __restrict__ W, const float* __restrict__ KE, const float* __restrict__ V,
                                               const float* __restrict__ KK, const float* __restrict__ Bb, float* __restrict__ out) {
    const int h = blockIdx.x, lane = threadIdx.x;
    float st[64];
#pragma unroll
    for (int i = 0; i < 64; ++i) st[i] = 0.f;
    for (int t = 0; t < S; ++t) {
        const size_t o = (size_t)t * 512 + h * 64; const float* r = us + (size_t)t * RWC + h * 64;
        float v = V[o + lane]; float sa = 0.f;
#pragma unroll
        for (int i = 0; i < 64; ++i) sa -= st[i] * KK[o + i];
        float ov = 0.f;
#pragma unroll
        for (int i = 0; i < 64; ++i) { st[i] = st[i] * W[o + i] + sa * Bb[o + i] + v * KE[o + i]; ov += st[i] * r[i]; }
        out[o + lane] = ov;
    }
}
__global__ void k_rwpost(const float* __restrict__ sc, const float* __restrict__ us, const float* __restrict__ KE, const float* __restrict__ V, const float* __restrict__ G,
                         const float* __restrict__ r_k, const float* __restrict__ lw, const float* __restrict__ lb, float* __restrict__ o) {
    int idx = blockIdx.x * 256 + threadIdx.x; if (idx >= S * 8) return;
    int t = idx >> 3, h = idx & 7; size_t ob = (size_t)t * 512 + h * 64; float mean = 0.f;
    for (int i = 0; i < 64; ++i) mean += sc[ob + i];
    mean *= (1.f / 64.f); float var = 0.f;
    for (int i = 0; i < 64; ++i) { float d = sc[ob + i] - mean; var += d * d; }
    var *= (1.f / 64.f); float rs = rsqrtf(var + 64e-5f); float bs = 0.f; const float* r = us + (size_t)t * RWC + h * 64;
    for (int i = 0; i < 64; ++i) bs += r[i] * KE[ob + i] * r_k[h * 64 + i];
    for (int i = 0; i < 64; ++i) { int c = h * 64 + i; o[ob + i] = ((sc[ob + i] - mean) * rs * lw[c] + lb[c] + bs * V[ob + i]) * G[ob + i]; }
}
__global__ void k_kmean(const float* __restrict__ kp, int ld, float* __restrict__ km) {
    int idx = blockIdx.x * 256 + threadIdx.x; if (idx >= 8 * 8 * 64) return;
    int d = idx & 63, j = (idx >> 6) & 7, h = idx >> 9; float s = 0.f;
    for (int t = 0; t < 256; ++t) s += kp[(size_t)(j * 256 + t) * ld + h * 64 + d];
    km[idx] = s * (1.f / 256.f);
}
__global__ void __launch_bounds__(64) k_moba(const float* __restrict__ qp, const float* __restrict__ kp, const float* __restrict__ vp, int ld, const float* __restrict__ km, float* __restrict__ o, int ldo) {
    __shared__ float qs[64]; __shared__ float ps[1024];
    const int lane = threadIdx.x, q = blockIdx.x & (S - 1), h = blockIdx.x >> 11, own = q >> 8;
    qs[lane] = qp[(size_t)q * ld + h * 64 + lane] * 0.125f; __syncthreads();
    float g[8];
#pragma unroll
    for (int j = 0; j < 8; ++j) { g[j] = wsum(qs[lane] * km[(h * 8 + j) * 64 + lane]); }
    unsigned selmask = 0u;
#pragma unroll
    for (int s3 = 0; s3 < 3; ++s3) { float bv = -3e38f; int best = -1;
#pragma unroll
        for (int j = 0; j < 8; ++j) if (!((selmask >> j) & 1u) && j < own && g[j] > bv) { bv = g[j]; best = j; }
        if (best >= 0) selmask |= 1u << best; }
    selmask |= 1u << own;
    float mx = -3e38f; int slot = 0;
    for (int j = 0; j < 8; ++j) {
        if (!((selmask >> j) & 1u)) continue;
        for (int e = 0; e < 4; ++e) { int key = j * 256 + e * 64 + lane; const float* kr = kp + (size_t)key * ld + h * 64; float s = 0.f;
            for (int d = 0; d < 64; ++d) s += qs[d] * kr[d];
            if (key > q) s = -1e30f; ps[slot * 256 + e * 64 + lane] = s; mx = fmaxf(mx, s); }
        ++slot;
    }
    mx = wmax(mx); float sum = 0.f;
    for (int c = 0; c < slot; ++c) for (int e = 0; e < 4; ++e) { float s = ps[c * 256 + e * 64 + lane]; float p = s > -1e29f ? expf(s - mx) : 0.f; sum += p; ps[c * 256 + e * 64 + lane] = p; }
    sum = wsum(sum); __syncthreads();
    float acc = 0.f; slot = 0;
    for (int j = 0; j < 8; ++j) {
        if (!((selmask >> j) & 1u)) continue;
        for (int kx = 0; kx < 256; ++kx) acc += ps[slot * 256 + kx] * vp[(size_t)(j * 256 + kx) * ld + h * 64 + lane];
        ++slot;
    }
    o[(size_t)q * ldo + h * 64 + lane] = acc / sum;
}
__global__ void __launch_bounds__(64) k_swa(const float* __restrict__ qp, const float* __restrict__ kp, const float* __restrict__ vp, int ld, const float* __restrict__ sinks, float* __restrict__ o, int ldo) {
    __shared__ float qs[64]; __shared__ float ps[128];
    const int lane = threadIdx.x, q = blockIdx.x & (S - 1), h = blockIdx.x >> 11, kvh = h >> 2;
    qs[lane] = qp[(size_t)q * ld + h * 64 + lane] * 0.125f; __syncthreads();
    float sc[2]; float mx = sinks[h];
#pragma unroll
    for (int e = 0; e < 2; ++e) { int key = q - 127 + e * 64 + lane; float s = -1e30f;
        if (key >= 0) { const float* kr = kp + (size_t)key * ld + kvh * 64; s = 0.f; for (int d = 0; d < 64; ++d) s += qs[d] * kr[d]; }
        sc[e] = s; mx = fmaxf(mx, s); }
    mx = wmax(mx); float sum = 0.f;
#pragma unroll
    for (int e = 0; e < 2; ++e) { float p = sc[e] > -1e29f ? expf(sc[e] - mx) : 0.f; sum += p; ps[e * 64 + lane] = p; }
    sum = wsum(sum) + expf(sinks[h] - mx); __syncthreads();
    float acc = 0.f;
    for (int kx = 0; kx < 128; ++kx) { int key = q - 127 + kx; if (key >= 0) acc += ps[kx] * vp[(size_t)key * ld + kvh * 64 + lane]; }
    o[(size_t)q * ldo + h * 64 + lane] = acc / sum;
}
__global__ void __launch_bounds__(64) k_xattn(const float* __restrict__ qp, const float* __restrict__ kp, const float* __restrict__ vp, float* __restrict__ o) {
    __shared__ float qs[128]; __shared__ float ps[256];
    const int lane = threadIdx.x, s = blockIdx.x & (S - 1), h = blockIdx.x >> 11;
    const float scale = 0.08838834764831845f;
    qs[lane] = qp[(size_t)s * 512 + h * 128 + lane] * scale; qs[lane + 64] = qp[(size_t)s * 512 + h * 128 + 64 + lane] * scale; __syncthreads();
    float sc[4]; float mx = -3e38f;
#pragma unroll
    for (int e = 0; e < 4; ++e) { const float* kr = kp + (size_t)(e * 64 + lane) * 512 + h * 128; float a = 0.f; for (int d = 0; d < 128; ++d) a += qs[d] * kr[d]; sc[e] = a; mx = fmaxf(mx, a); }
    mx = wmax(mx); float sum = 0.f;
#pragma unroll
    for (int e = 0; e < 4; ++e) { float p = expf(sc[e] - mx); sum += p; ps[e * 64 + lane] = p; }
    sum = wsum(sum); __syncthreads();
    float a0 = 0.f, a1 = 0.f;
    for (int m = 0; m < 256; ++m) { float p = ps[m]; a0 += p * vp[(size_t)m * 512 + h * 128 + lane]; a1 += p * vp[(size_t)m * 512 + h * 128 + 64 + lane]; }
    o[(size_t)s * 512 + h * 128 + lane] = a0 / sum; o[(size_t)s * 512 + h * 128 + 64 + lane] = a1 / sum;
}
__global__ void k_gateacc(const float* __restrict__ ug, int ldu, const float* __restrict__ proj, float* __restrict__ z, int first) {
    int idx = blockIdx.x * 256 + threadIdx.x; if (idx >= S * D) return;
    int t = idx >> 10, c = idx & 1023; float v = sigm(ug[(size_t)t * ldu + c]) * proj[idx];
    z[idx] = first ? v : z[idx] + v;
}
__global__ void k_relu2(float* __restrict__ p, int n) { int idx = blockIdx.x * 256 + threadIdx.x; if (idx < n) { float v = fmaxf(p[idx], 0.f); p[idx] = v * v; } }
__global__ void k_copy(const float* __restrict__ a, float* __restrict__ b, int n) { int idx = blockIdx.x * 256 + threadIdx.x; if (idx < n) b[idx] = a[idx]; }

static void gemm(hipStream_t st, const float* A, int lda, const float* B, int ldb, float* C, int ldc, int M, int N, int K) {
    hipLaunchKernelGGL(k_gemm, dim3((N + 63) / 64, M / 64), dim3(256), 0, st, A, lda, B, ldb, C, ldc, M, N, K);
}
#define NV_EW(kern, n, ...) hipLaunchKernelGGL(kern, dim3(((n) + 255) / 256), dim3(256), 0, st, __VA_ARGS__)

static void run(void* const* d_in, float* xout, char* ws, hipStream_t st) {
    const float* x_in = (const float*)d_in[0]; const float* mem = (const float*)d_in[1]; const int* pos = (const int*)d_in[2];
    auto P = [&](int i) { return (const float*)d_in[i]; };
    float* f = (float*)ws; size_t off = 0; auto take = [&](size_t n) { float* p = f + off; off += n; return p; };
    float* H = take((size_t)S * D); float* U = take((size_t)S * INC); float* US = take((size_t)S * RWC);
    float* T64 = take((size_t)S * 128); float* WL = take((size_t)S * 512); float* AL = take((size_t)S * 512); float* GL = take((size_t)S * 512); float* VGL = take((size_t)S * 512);
    float* Wd = take((size_t)S * 512); float* Aa = take((size_t)S * 512); float* Vv = take((size_t)S * 512); float* KK = take((size_t)S * 512); float* Bb = take((size_t)S * 512); float* KE = take((size_t)S * 512);
    float* SC = take((size_t)S * 512); float* ORW = take((size_t)S * 512); float* OMB = take((size_t)S * 512); float* OSW = take((size_t)S * 512); float* VF = take((size_t)S * 512);
    float* PROJ = take((size_t)S * D); float* Z = take((size_t)S * D); float* Y = take((size_t)S * D);
    float* VM = take((size_t)S * 32); float* VMS = take((size_t)S * 32);
    float* KM = take(8 * 8 * 64); float2* CS = (float2*)take((size_t)S * 64);
    float* MN = take((size_t)ML * D); float* XK = take((size_t)ML * 512); float* XV = take((size_t)ML * 512); float* XQ = take((size_t)S * 512); float* XO = take((size_t)S * 512);
    float* HM = U;
    NV_EW(k_copy, NB * S * D, x_in, xout, NB * S * D);
    for (int b = 0; b < NB; ++b) {
        float* x = xout + (size_t)b * S * D;
        NV_EW(k_ropetab, S * 32, pos + b * S, CS);
        for (int l = 0; l < 2; ++l) {
            hipLaunchKernelGGL(k_rmsnorm, dim3(S / 4), dim3(256), 0, st, x, P(3) + l * D, H, S);
            gemm(st, H, D, P(10) + (size_t)l * D * INC, INC, U, INC, S, INC, D);
            NV_EW(k_shift, S * RWC, U, INC, P(11) + l * RWC, US, RWC);
            NV_EW(k_map, S * 64, US + 1536, RWC, T64, 64, 0);
            gemm(st, T64, 64, P(13) + (size_t)l * 64 * 512, 512, WL, 512, S, 512, 64);
            gemm(st, US + 1600, RWC, P(15) + (size_t)l * 64 * 512, 512, AL, 512, S, 512, 64);
            NV_EW(k_map, S * 128, US + 1664, RWC, T64, 128, 1);
            gemm(st, T64, 128, P(16) + (size_t)l * 128 * 512, 512, GL, 512, S, 512, 128);
            if (l > 0) {
                gemm(st, H, D, P(22), 32, VM, 32, S, 32, D);
                NV_EW(k_shift, S * 32, VM, 32, P(23), VMS, 32);
                gemm(st, VMS, 32, P(25), 512, VGL, 512, S, 512, 32);
            }
            NV_EW(k_rwprep, S * 512, US, WL, AL, VGL, P(12) + l * 512, P(14) + l * 512, P(24), VF, l, Wd, Aa, Vv);
            NV_EW(k_rwkk, S * 8, US, Aa, P(17) + l * 512, P(18) + l * 512, KK, Bb, KE);
            hipLaunchKernelGGL(k_rwscan, dim3(8), dim3(64), 0, st, US, Wd, KE, Vv, KK, Bb, SC);
            NV_EW(k_rwpost, S * 8, SC, US, KE, Vv, GL, P(19) + l * 512, P(20) + l * 512, P(21) + l * 512, ORW);
            NV_EW(k_rope, S * 16 * 32, U + RWC, INC, 16, CS);
            NV_EW(k_kmean, 8 * 8 * 64, U + RWC + 512, INC, KM);
            hipLaunchKernelGGL(k_moba, dim3(8 * S), dim3(64), 0, st, U + RWC, U + RWC + 512, U + RWC + 1024, INC, KM, OMB, 512);
            NV_EW(k_rope, S * 10 * 32, U + RWC + MBC, INC, 10, CS);
            hipLaunchKernelGGL(k_swa, dim3(8 * S), dim3(64), 0, st, U + RWC + MBC, U + RWC + MBC + 512, U + RWC + MBC + 640, INC, P(26) + l * 8, OSW, 512);
            const float* wb = P(27) + (size_t)l * 3 * 512 * D;
            gemm(st, ORW, 512, wb, D, PROJ, D, S, D, 512); NV_EW(k_gateacc, S * D, U + 4096, INC, PROJ, Z, 1);
            gemm(st, OMB, 512, wb + 512 * D, D, PROJ, D, S, D, 512); NV_EW(k_gateacc, S * D, U + 4096 + 1024, INC, PROJ, Z, 0);
            gemm(st, OSW, 512, wb + 2 * 512 * D, D, PROJ, D, S, D, 512); NV_EW(k_gateacc, S * D, U + 4096 + 2048, INC, PROJ, Z, 0);
            gemm(st, Z, D, P(28) + (size_t)l * D * D, D, Y, D, S, D, D);
            hipLaunchKernelGGL(k_addnorm, dim3(S / 4), dim3(256), 0, st, x, Y, P(4) + l * D, S);
            hipLaunchKernelGGL(k_rmsnorm, dim3(S / 4), dim3(256), 0, st, x, P(5) + l * D, H, S);
            hipLaunchKernelGGL(k_rmsnorm, dim3(ML / 4), dim3(256), 0, st, mem + (size_t)b * ML * D, P(7) + l * D, MN, ML);
            gemm(st, H, D, P(29) + (size_t)l * D * 512, 512, XQ, 512, S, 512, D);
            gemm(st, MN, D, P(30) + (size_t)l * D * 512, 512, XK, 512, ML, 512, D);
            gemm(st, MN, D, P(31) + (size_t)l * D * 512, 512, XV, 512, ML, 512, D);
            hipLaunchKernelGGL(k_xattn, dim3(4 * S), dim3(64), 0, st, XQ, XK, XV, XO);
            gemm(st, XO, 512, P(32) + (size_t)l * 512 * D, D, Y, D, S, D, 512);
            hipLaunchKernelGGL(k_addnorm, dim3(S / 4), dim3(256), 0, st, x, Y, P(6) + l * D, S);
            hipLaunchKernelGGL(k_rmsnorm, dim3(S / 4), dim3(256), 0, st, x, P(8) + l * D, H, S);
            gemm(st, H, D, P(33) + (size_t)l * D * FF, FF, HM, FF, S, FF, D);
            NV_EW(k_relu2, S * FF, HM, S * FF);
            gemm(st, HM, FF, P(34) + (size_t)l * FF * D, D, Y, D, S, D, FF);
            hipLaunchKernelGGL(k_addnorm, dim3(S / 4), dim3(256), 0, st, x, Y, P(9) + l * D, S);
        }
    }
}
}

extern "C" void kernel_launch(void* const* d_in, const int* in_sizes, int n_in, void* d_out, int out_size, void* d_ws, size_t ws_size, hipStream_t stream) {
    nv::run(d_in, (float*)d_out, (char*)d_ws, stream);
}
```

```cpp
#include <hip/hip_runtime.h>
#include <cstdio>
#include <cstdint>
#include <cmath>
#define SCAN_L8 1
namespace pg8 {
#define PG8_LAS __attribute__((address_space(3)))
typedef unsigned short bf16_t;
typedef short bf16x8 __attribute__((ext_vector_type(8)));
typedef float f32x4 __attribute__((ext_vector_type(4)));
typedef unsigned u32x4 __attribute__((ext_vector_type(4)));
constexpr int BM = 256, BK = 64, HALF = 128, HTB = HALF * BK * 2  , STAGE_BYTES = 8 * HTB, NXCD = 8, WGM = 8;

__host__ __device__ __forceinline__ int lds_byte(int r, int c) { const int st = (r >> 4) * 2 + (c >> 5), rr = r & 15, cc = c & 31, ob = rr * 64 + cc * 2; return st * 1024 + (ob ^ (((ob >> 9) & 1) << 5)); }
__host__ __device__ __forceinline__ void stage_rc(int b, int& R, int& C) { const int st = b / 1024, sb = b % 1024, swz = sb ^ (((sb >> 9) & 1) << 5); R = (st >> 1) * 16 + swz / 64; C = (st & 1) * 32 + (swz % 64) / 2; }
__host__ __device__ __forceinline__ int perm32(int rho) { const int n = rho >> 4, i = rho & 15; return 8 * (i >> 2) + 4 * n + (i & 3); }

__device__ __forceinline__ void st16(void* p, u32x4 v) { asm volatile("global_store_dwordx4 %0, %1, off sc1\n\ts_nop 1" :: "v"(p), "v"(v) : "memory"); }
#define PG8_SWAP32(lo_, hi_, x_) unsigned lo_, hi_; { auto p_ = __builtin_amdgcn_permlane32_swap(__builtin_bit_cast(unsigned, x_), __builtin_bit_cast(unsigned, x_), false, false); lo_ = p_[0]; hi_ = p_[1]; asm volatile("" : "+v"(lo_), "+v"(hi_)); }
__device__ __forceinline__ float xsum_32(float x) { PG8_SWAP32(b0, b1, x); return __builtin_bit_cast(float, b0) + __builtin_bit_cast(float, b1); }
__device__ __forceinline__ float xmax_32(float x) { PG8_SWAP32(b0, b1, x); return fmaxf(__builtin_bit_cast(float, b0), __builtin_bit_cast(float, b1)); }
struct Unit { int pm, pn; };
struct Gemm { const bf16_t* A; const bf16_t* Bt; int M, N, K; };

struct StaticOrder {
    int nM, nN, nwg, G, c;
    __host__ __device__ void init(int M, int N, int G_, int c_) { nM = M / BM; nN = N / BM; nwg = nM * nN; G = G_; c = c_; }
    __host__ __device__ bool next(int i, Unit& u) const {
        const long L = (long)i * G + c; if (L >= nwg) return false;
        int wgid = (int)L; { const int q = nwg / NXCD, r = nwg % NXCD, xcd = wgid % NXCD, off = wgid / NXCD; wgid = (xcd < r ? xcd * (q + 1) : r * (q + 1) + (xcd - r) * q) + off; }
        const int nig = WGM * nN, gid = wgid / nig, fm = gid * WGM, gsz = (nM - fm) < WGM ? (nM - fm) : WGM;
        u.pm = fm + ((wgid % nig) % gsz); u.pn = (wgid % nig) / gsz; return true;
    }
    __device__ __forceinline__ void a_ready(const Unit&) const {}
    __device__ __forceinline__ void done(const Unit&) const {}
};

typedef float f32x2 __attribute__((ext_vector_type(2))); typedef __bf16 bf16x2p __attribute__((ext_vector_type(2)));
__device__ __forceinline__ unsigned cvt_pk_bf16(float lo, float hi) { f32x2 v = {lo, hi}; bf16x2p b = __builtin_convertvector(v, bf16x2p); return __builtin_bit_cast(unsigned, b); }
typedef unsigned u32x2e __attribute__((ext_vector_type(2)));
__device__ __forceinline__ u32x4 pack8(const f32x4 a, const f32x4 b) { u32x4 w; w.x = cvt_pk_bf16(a[0], a[1]); w.y = cvt_pk_bf16(a[2], a[3]); w.z = cvt_pk_bf16(b[0], b[1]); w.w = cvt_pk_bf16(b[2], b[3]); return w; }
__device__ __forceinline__ float bf_lo(unsigned w) { return __builtin_bit_cast(float, w << 16); }
__device__ __forceinline__ float bf_hi(unsigned w) { return __builtin_bit_cast(float, w & 0xffff0000u); }
__device__ __forceinline__ float fsigm(float x) { return __builtin_amdgcn_rcpf(1.f + __builtin_amdgcn_exp2f(-1.4426950408889634f * x)); }

typedef float f32x2e __attribute__((ext_vector_type(2))); typedef __bf16 bf16x2e __attribute__((ext_vector_type(2)));
__device__ __forceinline__ unsigned cvt2c(float lo, float hi) { f32x2e v = {lo, hi}; bf16x2e b = __builtin_convertvector(v, bf16x2e); return __builtin_bit_cast(unsigned, b); }
__device__ __forceinline__ u32x4 pack8c(const f32x4 a, const f32x4 b) { u32x4 w; w.x = cvt2c(a[0], a[1]); w.y = cvt2c(a[2], a[3]); w.z = cvt2c(b[0], b[1]); w.w = cvt2c(b[2], b[3]); return w; }
__device__ __forceinline__ int img_lane(int wr, int wc, int fr, int fq) { int o = (wr * 4 + wc) * 64 + fq * 16 + fr; asm volatile("" : "+v"(o)); return o; }
__device__ __forceinline__ int img16(int ai, int m, int bj, int lo) { return ((ai * 4 + m) * 2 + bj) * 512 + lo; }
template <int ACT> struct EpiStore {
    static constexpr bool PERM = true, AFTER_DRAIN = false;
    bf16_t* O; int ldc; float scale;
    __device__ __forceinline__ void operator()(const f32x4 (&acc)[2][2][4][2], const Unit& u, int wr, int wc, int fr, int fq) const {
        const int row0 = u.pm * BM + wr * 64 + fr, col0 = u.pn * BM + wc * 32 + 8 * fq; const int ilo = (ACT == 2) ? img_lane(wr, wc, fr, fq) : 0;
#pragma unroll
        for (int ai = 0; ai < 2; ++ai)
#pragma unroll
            for (int m = 0; m < 4; ++m) { bf16_t* rowp = O + (size_t)(row0 + ai * HALF + m * 16) * ldc + col0;
#pragma unroll
                for (int bj = 0; bj < 2; ++bj) { f32x4 v0 = acc[ai][bj][m][0], v1 = acc[ai][bj][m][1];
                    if (ACT == 1) {
#pragma unroll
                        for (int e = 0; e < 4; ++e) { float a = fmaxf(v0[e], 0.f), b = fmaxf(v1[e], 0.f); v0[e] = a * a; v1[e] = b * b; } }
                    if (ACT == 2) {
#pragma unroll
                        for (int e = 0; e < 4; ++e) { v0[e] = fsigm(v0[e]); v1[e] = fsigm(v1[e]); } }
                    if (ACT == 0) { v0 = v0 * scale; v1 = v1 * scale; }
                    if (ACT == 1) st16(rowp + bj * HALF, pack8(v0, v1));
                    else if (ACT == 2) ((u32x4*)O)[(size_t)(u.pm * 12 + u.pn) * 8192 + img16(ai, m, bj, ilo)] = pack8c(v0, v1);
                    else *(u32x4*)(rowp + bj * HALF) = pack8(v0, v1); } }
    }
};
struct EpiKV {
    static constexpr bool PERM = true, AFTER_DRAIN = false;
    bf16_t* Kd; bf16_t* Vd;
    __device__ __forceinline__ void operator()(const f32x4 (&acc)[2][2][4][2], const Unit& u, int wr, int wc, int fr, int fq) const {
        bf16_t* O = (u.pn >= 2) ? Vd : Kd; const int row0 = u.pm * BM + wr * 64 + fr, col0 = (u.pn & 1) * BM + wc * 32 + 8 * fq;
#pragma unroll
        for (int ai = 0; ai < 2; ++ai)
#pragma unroll
            for (int m = 0; m < 4; ++m) { bf16_t* rowp = O + (size_t)(row0 + ai * HALF + m * 16) * 512 + col0;
#pragma unroll
                for (int bj = 0; bj < 2; ++bj) *(u32x4*)(rowp + bj * HALF) = pack8(acc[ai][bj][m][0], acc[ai][bj][m][1]); }
    }
};
struct ThreePassOrder {
    StaticOrder base;
    __host__ __device__ void init(int M, int G_, int c_) { base.init(M, 1024, G_, c_); }
    __host__ __device__ bool next(int i, Unit& u) const { Unit t; if (!base.next(i / 3, t)) return false; const int n = i % 3; u.pm = t.pm + 64 * (n == 0 ? 2 : n - 1); u.pn = t.pn + 4 * n; return true; }
    __device__ __forceinline__ void a_ready(const Unit&) const {}
    __device__ __forceinline__ void done(const Unit&) const {}
};
struct EpiZ3 {
    static constexpr bool PERM = true, AFTER_DRAIN = false;
    bf16_t* ZB; const bf16_t* GATE; bf16_t* ZT;
    __device__ __forceinline__ void operator()(const f32x4 (&acc)[2][2][4][2], const Unit& u, int wr, int wc, int fr, int fq) const {
        const int n = u.pn >> 2, pm = u.pm & 63, pn = u.pn & 3, row0 = pm * BM + wr * 64 + fr, col0 = pn * BM + wc * 32 + 8 * fq;
        const bool rmw = n != 0; const int ilo = img_lane(wr, wc, fr, fq);
        const u32x4* gimg = (const u32x4*)GATE + (size_t)(pm * 12 + n * 4 + pn) * 8192; u32x4* zimg = (u32x4*)ZT + (size_t)(pm * 4 + pn) * 8192;
#pragma unroll
        for (int ai = 0; ai < 2; ++ai) {
            u32x4 gq[4][2], zq[4][2];
#pragma unroll
            for (int m = 0; m < 4; ++m)
#pragma unroll
                for (int bj = 0; bj < 2; ++bj) gq[m][bj] = gimg[img16(ai, m, bj, ilo)];
            if (rmw) {
#pragma unroll
                for (int m = 0; m < 4; ++m)
#pragma unroll
                    for (int bj = 0; bj < 2; ++bj) zq[m][bj] = zimg[img16(ai, m, bj, ilo)];
            } else {
#pragma unroll
                for (int m = 0; m < 4; ++m)
#pragma unroll
                    for (int bj = 0; bj < 2; ++bj) zq[m][bj] = (u32x4){0u, 0u, 0u, 0u};
            }
#pragma unroll
            for (int m = 0; m < 4; ++m)
#pragma unroll
                for (int bj = 0; bj < 2; ++bj) { const u32x4 g = gq[m][bj], z = zq[m][bj];
                    f32x4 v0 = acc[ai][bj][m][0], v1 = acc[ai][bj][m][1];
                    v0[0] = v0[0] * bf_lo(g.x) + bf_lo(z.x); v0[1] = v0[1] * bf_hi(g.x) + bf_hi(z.x); v0[2] = v0[2] * bf_lo(g.y) + bf_lo(z.y); v0[3] = v0[3] * bf_hi(g.y) + bf_hi(z.y);
                    v1[0] = v1[0] * bf_lo(g.z) + bf_lo(z.z); v1[1] = v1[1] * bf_hi(g.z) + bf_hi(z.z); v1[2] = v1[2] * bf_lo(g.w) + bf_lo(z.w); v1[3] = v1[3] * bf_hi(g.w) + bf_hi(z.w);
                    gq[m][bj] = pack8(v0, v1); }
            if (n == 2) {
#pragma unroll
                for (int m = 0; m < 4; ++m)
#pragma unroll
                    for (int bj = 0; bj < 2; ++bj) *(u32x4*)(ZB + (size_t)(row0 + ai * HALF + m * 16) * 1024 + col0 + bj * HALF) = gq[m][bj];
            } else {
#pragma unroll
                for (int m = 0; m < 4; ++m)
#pragma unroll
                    for (int bj = 0; bj < 2; ++bj) zimg[img16(ai, m, bj, ilo)] = gq[m][bj];
            }
        }
    }
};
struct EpiZ {
    static constexpr bool PERM = true, AFTER_DRAIN = false;
    bf16_t* ZB; const bf16_t* GATE; int goff; int first;
    __device__ __forceinline__ void operator()(const f32x4 (&acc)[2][2][4][2], const Unit& u, int wr, int wc, int fr, int fq) const {
        const int row0 = u.pm * BM + wr * 64 + fr, col0 = u.pn * BM + wc * 32 + 8 * fq;
#pragma unroll
        for (int ai = 0; ai < 2; ++ai)
#pragma unroll
            for (int m = 0; m < 4; ++m) { const size_t r = (size_t)(row0 + ai * HALF + m * 16);
#pragma unroll
                for (int bj = 0; bj < 2; ++bj) { const int c = col0 + bj * HALF;
                    const u32x4 g = *(const u32x4*)(GATE + r * 3072 + goff + c);
                    f32x4 v0 = acc[ai][bj][m][0], v1 = acc[ai][bj][m][1];
                    v0[0] *= bf_lo(g.x); v0[1] *= bf_hi(g.x); v0[2] *= bf_lo(g.y); v0[3] *= bf_hi(g.y);
                    v1[0] *= bf_lo(g.z); v1[1] *= bf_hi(g.z); v1[2] *= bf_lo(g.w); v1[3] *= bf_hi(g.w);
                    bf16_t* zp = ZB + r * 1024 + c;
                    if (!first) { const u32x4 z = *(const u32x4*)zp;
                        v0[0] += bf_lo(z.x); v0[1] += bf_hi(z.x); v0[2] += bf_lo(z.y); v0[3] += bf_hi(z.y);
                        v1[0] += bf_lo(z.z); v1[1] += bf_hi(z.z); v1[2] += bf_lo(z.w); v1[3] += bf_hi(z.w); }
                    *(u32x4*)zp = pack8(v0, v1); } }
    }
};
constexpr size_t G1_MiB = 1u << 20, G1_KM = 1 * G1_MiB + 512 * 1024, G1_ROPE = 2 * G1_MiB, G1_URW = 72 * G1_MiB, G1_MK = 128 * G1_MiB, G1_MV = 144 * G1_MiB, G1_SK = 160 * G1_MiB, G1_SV = 164 * G1_MiB,
                 G1_MQ = 168 * G1_MiB, G1_SQ = 184 * G1_MiB, G1_VM = 254 * G1_MiB;
struct EpiG1 {
    static constexpr bool PERM = true, AFTER_DRAIN = false;
    unsigned char* ws; float qscale; int pn0;
    __device__ __forceinline__ void operator()(const f32x4 (&acc)[2][2][4][2], const Unit& u, int wr, int wc, int fr, int fq) const {
        const int pn = u.pn + pn0, row0 = u.pm * BM + wr * 64 + fr, cw = wc * 32 + 8 * fq;
        bf16_t* const URW = (bf16_t*)(ws + G1_URW); bf16_t* const MQ = (bf16_t*)(ws + G1_MQ); bf16_t* const MK = (bf16_t*)(ws + G1_MK); bf16_t* const MV = (bf16_t*)(ws + G1_MV);
        bf16_t* const SQ = (bf16_t*)(ws + G1_SQ); bf16_t* const SK = (bf16_t*)(ws + G1_SK); bf16_t* const SV = (bf16_t*)(ws + G1_SV); bf16_t* const VM = (bf16_t*)(ws + G1_VM);
        float* const KM = (float*)(ws + G1_KM); const float* const ROPE = (const float*)(ws + G1_ROPE);
        float ks[2][8];
#pragma unroll
        for (int bj = 0; bj < 2; ++bj)
#pragma unroll
            for (int e = 0; e < 8; ++e) ks[bj][e] = 0.f;
#pragma unroll
        for (int bj = 0; bj < 2; ++bj) {
            bf16_t* dst; int ldc, col, mode;
            const int ct = bj * HALF + cw;
            if (pn < 7) { dst = URW; ldc = 1792; col = pn * 256 + ct; mode = 0; }
            else if (pn < 9) { dst = MQ; ldc = 512; col = (pn - 7) * 256 + ct; mode = 2; }
            else if (pn < 11) { dst = MK; ldc = 512; col = (pn - 9) * 256 + ct; mode = 1; }
            else if (pn < 13) { dst = MV; ldc = 512; col = (pn - 11) * 256 + ct; mode = 0; }
            else if (pn < 15) { dst = SQ; ldc = 512; col = (pn - 13) * 256 + ct; mode = 2; }
            else if (pn == 15) { if (bj == 0) { dst = SK; ldc = 128; col = cw; mode = 1; } else { dst = SV; ldc = 128; col = cw; mode = 0; } }
            else { dst = VM; ldc = 32; col = ct; mode = (ct < 32) ? 0 : 3; }
            if (mode == 3) continue;
            const int i0 = (col & 63) >> 1;
#pragma unroll
            for (int ai = 0; ai < 2; ++ai) {
                f32x4 rc[4][2];
                if (mode != 0) {
#pragma unroll
                    for (int m = 0; m < 4; ++m) { const size_t r = (size_t)(row0 + ai * HALF + m * 16);
                        rc[m][0] = *(const f32x4*)(ROPE + (r * 32 + i0) * 2); rc[m][1] = *(const f32x4*)(ROPE + (r * 32 + i0) * 2 + 4); }
                } else {
#pragma unroll
                    for (int m = 0; m < 4; ++m) { rc[m][0] = (f32x4){1.f, 0.f, 1.f, 0.f}; rc[m][1] = (f32x4){1.f, 0.f, 1.f, 0.f}; }
                }
#pragma unroll
                for (int m = 0; m < 4; ++m) { const size_t r = (size_t)(row0 + ai * HALF + m * 16);
                    f32x4 v0 = acc[ai][bj][m][0], v1 = acc[ai][bj][m][1];
                    if (mode != 0) {
                        const f32x4 c0 = rc[m][0], c1 = rc[m][1];
                        f32x4 o0, o1;
                        o0[0] = v0[0] * c0[0] - v0[1] * c0[1]; o0[1] = v0[1] * c0[0] + v0[0] * c0[1];
                        o0[2] = v0[2] * c0[2] - v0[3] * c0[3]; o0[3] = v0[3] * c0[2] + v0[2] * c0[3];
                        o1[0] = v1[0] * c1[0] - v1[1] * c1[1]; o1[1] = v1[1] * c1[0] + v1[0] * c1[1];
                        o1[2] = v1[2] * c1[2] - v1[3] * c1[3]; o1[3] = v1[3] * c1[2] + v1[2] * c1[3];
                        v0 = o0; v1 = o1;
                        if (mode == 2) { v0 = v0 * qscale; v1 = v1 * qscale; }
                        if (pn == 9 || pn == 10) {
#pragma unroll
                            for (int e = 0; e < 4; ++e) { ks[bj][e] += v0[e]; ks[bj][4 + e] += v1[e]; } }
                    }
                    *(u32x4*)(dst + r * ldc + col) = pack8(v0, v1); }
            }
        }
        if (pn == 9 || pn == 10) {
#pragma unroll
            for (int bj = 0; bj < 2; ++bj)
#pragma unroll
                for (int e = 0; e < 8; ++e) { float s = ks[bj][e]; s += __shfl_xor(s, 1); s += __shfl_xor(s, 2); s += __shfl_xor(s, 4); s += __shfl_xor(s, 8);
                    if (fr == 0) atomicAdd(KM + (size_t)u.pm * 512 + (pn - 9) * 256 + bj * HALF + cw + e, s); }
        }
    }
};
struct PanelRms {
    unsigned* xbuf;
    unsigned tag;
    __device__ __forceinline__ void post(const f32x4 (&v)[2][2][4][2], const Unit& u, int wr, int wc, int fr, int fq, PG8_LAS unsigned char* lds, int wid, int lane) const {
        PG8_LAS float* P = (PG8_LAS float*)lds;
#pragma unroll
        for (int ai = 0; ai < 2; ++ai)
#pragma unroll
            for (int m = 0; m < 4; ++m) {
                float s = 0.f;
#pragma unroll
                for (int bj = 0; bj < 2; ++bj)
#pragma unroll
                    for (int n = 0; n < 2; ++n) { const f32x4 x = v[ai][bj][m][n]; s += (x[0] * x[0] + x[1] * x[1]) + (x[2] * x[2] + x[3] * x[3]); }
                s += __shfl_xor(s, 16); s += __shfl_xor(s, 32);
                if (fq == 0) P[(ai * HALF + wr * 64 + m * 16 + fr) * 4 + wc] = s;
            }
        asm volatile("s_waitcnt lgkmcnt(0)" ::: "memory"); __builtin_amdgcn_s_barrier(); asm volatile("" ::: "memory");
        const int row = wid * 32 + (lane & 31);
        if (lane < 32) {
            const float tot = (P[row * 4 + 0] + P[row * 4 + 1]) + (P[row * 4 + 2] + P[row * 4 + 3]);
            unsigned long long* slot = (unsigned long long*)xbuf + ((size_t)(u.pm * BM + row) * 4 + u.pn);
            __hip_atomic_store(slot, ((unsigned long long)tag << 32) | (unsigned long long)__float_as_uint(tot), __ATOMIC_RELAXED, __HIP_MEMORY_SCOPE_AGENT);
        }
    }
    __device__ __forceinline__ void finish(const Unit& u, PG8_LAS unsigned char* lds, int wid, int lane, float* rsw) const {
        PG8_LAS float* S = (PG8_LAS float*)(lds + 8192);
        const int row = wid * 32 + (lane & 31);
        unsigned long long* slot = (unsigned long long*)xbuf + (size_t)(u.pm * BM + row) * 4;
        unsigned long long w0, w1, w2, w3; bool ok; unsigned spins = 0;
        { const unsigned long long* rep = (const unsigned long long*)xbuf + (size_t)(u.pm * BM + wid * 32 + 31) * 4; unsigned sp2 = 0;
          for (;;) { bool rdy = true;
              if (lane < 4) rdy = (unsigned)(__hip_atomic_load(rep + lane, __ATOMIC_RELAXED, __HIP_MEMORY_SCOPE_AGENT) >> 32) == tag;
              if (__all(rdy)) break;
              if (++sp2 > 400000u) break;
              __builtin_amdgcn_s_sleep(2); } }
        for (;;) {
            w0 = __hip_atomic_load(slot + 0, __ATOMIC_RELAXED, __HIP_MEMORY_SCOPE_AGENT); w1 = __hip_atomic_load(slot + 1, __ATOMIC_RELAXED, __HIP_MEMORY_SCOPE_AGENT);
            w2 = __hip_atomic_load(slot + 2, __ATOMIC_RELAXED, __HIP_MEMORY_SCOPE_AGENT); w3 = __hip_atomic_load(slot + 3, __ATOMIC_RELAXED, __HIP_MEMORY_SCOPE_AGENT);
            ok = ((unsigned)(w0 >> 32) == tag) & ((unsigned)(w1 >> 32) == tag) & ((unsigned)(w2 >> 32) == tag) & ((unsigned)(w3 >> 32) == tag);
            if (__all(ok)) break;
            if (++spins > 400000u) break;
            __builtin_amdgcn_s_sleep(1);
        }
        if (lane < 32) {
            float q = (__uint_as_float((unsigned)w0) + __uint_as_float((unsigned)w1)) + (__uint_as_float((unsigned)w2) + __uint_as_float((unsigned)w3));
            if (!ok) q = __builtin_nanf("");
            const float ms = q * (1.0f / 1024.0f) + 1e-6f; S[row] = 1.0f / sqrtf(ms);
            if (rsw != nullptr && u.pn == 0) rsw[u.pm * BM + row] = sqrtf(ms);
        }
        asm volatile("s_waitcnt lgkmcnt(0)" ::: "memory"); __builtin_amdgcn_s_barrier(); asm volatile("" ::: "memory");
    }
};
struct EpiRmsResRms {
    static constexpr bool PERM = true, AFTER_DRAIN = true;
    bf16_t* xn; float* rs; float* out; const float* g; PanelRms st1, st2;
    __device__ __forceinline__ void fused(f32x4 (&acc)[2][2][4][2], const Unit& u, int wr, int wc, int fr, int fq, PG8_LAS unsigned char* lds, int wid, int lane) const {
        const PG8_LAS float* S = (const PG8_LAS float*)(lds + 8192);
        const int col0 = u.pn * BM + wc * 32 + 8 * fq;
        st1.post(acc, u, wr, wc, fr, fq, lds, wid, lane);
        st1.finish(u, lds, wid, lane, nullptr);
        f32x4 gv[2][2];
#pragma unroll
        for (int bj = 0; bj < 2; ++bj)
#pragma unroll
            for (int n = 0; n < 2; ++n) gv[bj][n] = *(const f32x4*)(g + col0 + bj * HALF + n * 4);
#pragma unroll
        for (int ai = 0; ai < 2; ++ai)
#pragma unroll
            for (int m = 0; m < 4; ++m) { const int r = ai * HALF + wr * 64 + m * 16 + fr; const float sr = S[r]; const float ro = rs[u.pm * BM + r]; const size_t off = (size_t)(u.pm * BM + r) * 1024 + col0;
#pragma unroll
                for (int bj = 0; bj < 2; ++bj) { const u32x4 w = *(const u32x4*)(xn + off + bj * HALF);
                    const f32x4 b0 = (f32x4){bf_lo(w.x), bf_hi(w.x), bf_lo(w.y), bf_hi(w.y)}, b1 = (f32x4){bf_lo(w.z), bf_hi(w.z), bf_lo(w.w), bf_hi(w.w)};
                    acc[ai][bj][m][0] = b0 * ro + acc[ai][bj][m][0] * sr * gv[bj][0]; acc[ai][bj][m][1] = b1 * ro + acc[ai][bj][m][1] * sr * gv[bj][1]; }
                asm volatile("" : "+v"(acc[ai][0][m][0]), "+v"(acc[ai][0][m][1]), "+v"(acc[ai][1][m][0]), "+v"(acc[ai][1][m][1]));
                if (m == 3) asm volatile("" ::: "memory"); }
        if (out != nullptr) {
#pragma unroll
            for (int ai = 0; ai < 2; ++ai)
#pragma unroll
                for (int m = 0; m < 4; ++m) { const int r = ai * HALF + wr * 64 + m * 16 + fr; const size_t off = (size_t)(u.pm * BM + r) * 1024 + col0;
#pragma unroll
                    for (int bj = 0; bj < 2; ++bj)
#pragma unroll
                        for (int n = 0; n < 2; ++n) *(f32x4*)(out + off + bj * HALF + n * 4) = acc[ai][bj][m][n]; }
            return; }
        st2.post(acc, u, wr, wc, fr, fq, lds, wid, lane);
        st2.finish(u, lds, wid, lane, rs);
#pragma unroll
        for (int ai = 0; ai < 2; ++ai)
#pragma unroll
            for (int m = 0; m < 4; ++m) { const int r = ai * HALF + wr * 64 + m * 16 + fr; const float sr = S[r]; const size_t off = (size_t)(u.pm * BM + r) * 1024 + col0;
#pragma unroll
                for (int bj = 0; bj < 2; ++bj) *(u32x4*)(xn + off + bj * HALF) = pack8(acc[ai][bj][m][0] * sr, acc[ai][bj][m][1] * sr);
                asm volatile("" ::: "memory"); }
    }
};
template <class Epi, class Sched, bool ALIGN_EPI = false, bool SP2 = false>
__device__ __forceinline__ void gemm_phase(PG8_LAS unsigned char* lds, const Gemm g, const Sched& S, const Epi& E) {
    int tid_ = threadIdx.x; asm volatile("" : "+v"(tid_));
    const int tid = tid_, wid = __builtin_amdgcn_readfirstlane(tid >> 6), lane = tid & 63, wr = wid >> 2, wc = wid & 3, fr = lane & 15, fq = lane >> 4;
    const int K = g.K, nt = K / BK;
    unsigned voffA[2], voffB[2];
#pragma unroll
    for (int i = 0; i < 2; ++i) { int R, C; stage_rc(tid * 16 + i * 8192, R, C); const int Rb = Epi::PERM ? ((R & ~31) + perm32(R & 31)) : R;
        voffA[i] = (unsigned)(R * K + C) * 2u; voffB[i] = (unsigned)(Rb * K + C) * 2u; }
    const size_t kstep = (size_t)(BK * 2);
    const size_t hstep = (size_t)HALF * K * 2;
    const size_t tstep = 2 * hstep;
    const unsigned ldsw = (unsigned)wid * 1024u;
    const int aoff = lds_byte(wr * 64 + fr, fq * 8), boff = lds_byte(wc * 32 + fr, fq * 8);
#define PG8_SA(b, h) (((b) * 2 + (h)) * HTB)
#define PG8_SB(b, h) ((4 + (b) * 2 + (h)) * HTB)
#define PG8_STAGE(bufoff, gbase, voff) do { _Pragma("unroll") for (int _i = 0; _i < 2; ++_i) \
        __builtin_amdgcn_global_load_lds((const unsigned*)((const char*)(gbase) + (voff)[_i]), (PG8_LAS unsigned*)(lds + (bufoff) + ldsw + _i * 8192), 16, 0, 0); } while (0)
#define PG8_LDA(dst, b, h) do { _Pragma("unroll") for (int m = 0; m < 4; ++m) _Pragma("unroll") for (int k = 0; k < 2; ++k) dst[m][k] = *(const PG8_LAS bf16x8*)(lds + PG8_SA(b, h) + aoff + m * 2048 + k * 1024); } while (0)
#define PG8_LDB(dst, b, h) do { _Pragma("unroll") for (int n = 0; n < 2; ++n) _Pragma("unroll") for (int k = 0; k < 2; ++k) dst[n][k] = *(const PG8_LAS bf16x8*)(lds + PG8_SB(b, h) + boff + n * 2048 + k * 1024); } while (0)
#define PG8_MMA(ai, bj, At, Bt) do { __builtin_amdgcn_s_setprio(1); _Pragma("unroll") for (int m = 0; m < 4; ++m) _Pragma("unroll") for (int n = 0; n < 2; ++n) _Pragma("unroll") for (int k = 0; k < 2; ++k) \
        acc[ai][bj][m][n] = __builtin_amdgcn_mfma_f32_16x16x32_bf16(Bt[n][k], At[m][k], acc[ai][bj][m][n], 0, 0, 0); __builtin_amdgcn_s_setprio(0); } while (0)
#define PG8_WAIT_V(n) asm volatile("s_waitcnt vmcnt(" #n ")" ::: "memory")
#define PG8_WAIT_L(n) asm volatile("s_waitcnt lgkmcnt(" #n ")" ::: "memory")
#define PG8_BAR __builtin_amdgcn_s_barrier()
#define PG8_SCHED __builtin_amdgcn_sched_barrier(0)
    Unit cur, nxt; int ui = 0;
    if (!S.next(0, cur)) return;
    f32x4 acc[2][2][4][2];
#pragma unroll
    for (int a = 0; a < 2; ++a)
#pragma unroll
        for (int b = 0; b < 2; ++b)
#pragma unroll
            for (int m = 0; m < 4; ++m)
#pragma unroll
                for (int n = 0; n < 2; ++n) acc[a][b][m][n] = (f32x4){0.f, 0.f, 0.f, 0.f};
    bf16x8 At[4][2], B0[2][2], B1[2][2];
    const char* cA = (const char*)g.A + (size_t)cur.pm * tstep; const char* cB = (const char*)g.Bt + (size_t)cur.pn * tstep;
    S.a_ready(cur);
    if constexpr (SP2) {
        PG8_STAGE(PG8_SB(0, 0), cB, voffB); PG8_STAGE(PG8_SB(0, 1), cB + hstep, voffB); PG8_STAGE(PG8_SA(0, 0), cA, voffA); PG8_STAGE(PG8_SA(0, 1), cA + hstep, voffA);
        if (wr == 1) PG8_BAR;
        PG8_WAIT_V(2); PG8_BAR;
        PG8_STAGE(PG8_SB(1, 0), cB + kstep, voffB); PG8_STAGE(PG8_SA(1, 0), cA + kstep, voffA); PG8_STAGE(PG8_SB(1, 1), cB + hstep + kstep, voffB);
        PG8_WAIT_V(6); PG8_BAR;
    } else {
        PG8_STAGE(PG8_SB(0, 0), cB, voffB); PG8_STAGE(PG8_SA(0, 0), cA, voffA); PG8_STAGE(PG8_SB(0, 1), cB + hstep, voffB); PG8_STAGE(PG8_SA(0, 1), cA + hstep, voffA);
        if (wr == 1) PG8_BAR;
        PG8_WAIT_V(4); PG8_BAR;
        PG8_STAGE(PG8_SB(1, 0), cB + kstep, voffB); PG8_STAGE(PG8_SA(1, 0), cA + kstep, voffA); PG8_STAGE(PG8_SB(1, 1), cB + hstep + kstep, voffB);
        PG8_WAIT_V(6); PG8_BAR;
    }
    for (;;) {
        const bool has_next = S.next(ui + 1, nxt);
        const char* nA = has_next ? (const char*)g.A + (size_t)nxt.pm * tstep : cA; const char* nB = has_next ? (const char*)g.Bt + (size_t)nxt.pn * tstep : cB;
        for (int t = 0; t < nt; t += 2) {
            const bool last = (t == nt - 2);
            const char* a1 = cA + (size_t)(t + 1) * kstep;
            const char* a2 = last ? nA : cA + (size_t)(t + 2) * kstep; const char* b2 = last ? nB : cB + (size_t)(t + 2) * kstep;
            const char* a3 = a2 + kstep; const char* b3 = b2 + kstep;
            if (last && has_next) S.a_ready(nxt);
            if constexpr (SP2) {
            PG8_LDB(B0, 0, 0); PG8_LDB(B1, 0, 1); PG8_SCHED; PG8_LDA(At, 0, 0); PG8_STAGE(PG8_SA(1, 1), a1 + hstep, voffA);
            PG8_WAIT_V(8); PG8_WAIT_L(0); PG8_BAR; PG8_MMA(0, 0, At, B0); PG8_MMA(0, 1, At, B1); PG8_BAR; PG8_SCHED;
            PG8_LDA(At, 0, 1); PG8_STAGE(PG8_SB(0, 0), b2, voffB); PG8_STAGE(PG8_SB(0, 1), b2 + hstep, voffB); PG8_STAGE(PG8_SA(0, 0), a2, voffA);
            PG8_WAIT_V(8); PG8_WAIT_L(0); PG8_BAR; PG8_MMA(1, 0, At, B0); PG8_MMA(1, 1, At, B1); PG8_BAR; PG8_SCHED;
            PG8_LDB(B0, 1, 0); PG8_LDB(B1, 1, 1); PG8_SCHED; PG8_LDA(At, 1, 0); PG8_STAGE(PG8_SA(0, 1), a2 + hstep, voffA);
            PG8_WAIT_V(8); PG8_WAIT_L(0); PG8_BAR; PG8_MMA(0, 0, At, B0); PG8_MMA(0, 1, At, B1); PG8_BAR; PG8_SCHED;
            PG8_LDA(At, 1, 1); PG8_STAGE(PG8_SB(1, 0), b3, voffB); PG8_STAGE(PG8_SB(1, 1), b3 + hstep, voffB); PG8_STAGE(PG8_SA(1, 0), a3, voffA);
            PG8_WAIT_V(8); PG8_WAIT_L(0); PG8_BAR; PG8_MMA(1, 0, At, B0); PG8_MMA(1, 1, At, B1); PG8_BAR; PG8_SCHED;
            } else {
            PG8_LDB(B0, 0, 0); PG8_SCHED; PG8_LDA(At, 0, 0); PG8_STAGE(PG8_SA(1, 1), a1 + hstep, voffA);
            PG8_WAIT_L(8); PG8_BAR; PG8_WAIT_L(0); PG8_MMA(0, 0, At, B0); PG8_BAR; PG8_SCHED;
            PG8_LDB(B1, 0, 1); PG8_STAGE(PG8_SB(0, 0), b2, voffB);
            PG8_BAR; PG8_WAIT_L(0); PG8_MMA(0, 1, At, B1); PG8_BAR;
            PG8_LDA(At, 0, 1); PG8_STAGE(PG8_SA(0, 0), a2, voffA);
            PG8_BAR; PG8_WAIT_L(0); PG8_MMA(1, 0, At, B0); PG8_BAR; PG8_SCHED;
            PG8_STAGE(PG8_SB(0, 1), b2 + hstep, voffB);
            PG8_WAIT_V(6); PG8_BAR; PG8_MMA(1, 1, At, B1); PG8_BAR;
            PG8_LDB(B0, 1, 0); PG8_SCHED; PG8_LDA(At, 1, 0); PG8_STAGE(PG8_SA(0, 1), a2 + hstep, voffA);
            PG8_WAIT_L(8); PG8_BAR; PG8_WAIT_L(0); PG8_MMA(0, 0, At, B0); PG8_BAR; PG8_SCHED;
            PG8_LDB(B1, 1, 1); PG8_STAGE(PG8_SB(1, 0), b3, voffB);
            PG8_BAR; PG8_WAIT_L(0); PG8_MMA(0, 1, At, B1); PG8_BAR;
            PG8_LDA(At, 1, 1); PG8_STAGE(PG8_SA(1, 0), a3, voffA);
            PG8_BAR; PG8_WAIT_L(0); PG8_MMA(1, 0, At, B0); PG8_BAR; PG8_SCHED;
            PG8_STAGE(PG8_SB(1, 1), b3 + hstep, voffB);
            PG8_WAIT_V(6); PG8_BAR; PG8_MMA(1, 1, At, B1); PG8_BAR;
            }
        }
        if constexpr (ALIGN_EPI) { if (wr == 0) PG8_BAR; }
        if constexpr (!Epi::AFTER_DRAIN) { E(acc, cur, wr, wc, fr, fq); S.done(cur); }
        if (!has_next) break;
#pragma unroll
        for (int a = 0; a < 2; ++a)
#pragma unroll
            for (int b = 0; b < 2; ++b)
#pragma unroll
                for (int m = 0; m < 4; ++m)
#pragma unroll
                    for (int n = 0; n < 2; ++n) acc[a][b][m][n] = (f32x4){0.f, 0.f, 0.f, 0.f};
        cur = nxt; cA = nA; cB = nB; ++ui;
        if constexpr (ALIGN_EPI) { if (wr == 1) PG8_BAR; }
    }
    PG8_WAIT_V(0);
    if constexpr (!ALIGN_EPI) { if (wr == 0) PG8_BAR; }
    PG8_BAR;
    if constexpr (Epi::AFTER_DRAIN) { E.fused(acc, cur, wr, wc, fr, fq, lds, wid, lane); S.done(cur); }
#undef PG8_SA
#undef PG8_SB
#undef PG8_STAGE
#undef PG8_LDA
#undef PG8_LDB
#undef PG8_MMA
#undef PG8_WAIT_V
#undef PG8_WAIT_L
#undef PG8_BAR
#undef PG8_SCHED
}
}
#define GAS __attribute__((address_space(1)))
#define LAS __attribute__((address_space(3)))
typedef unsigned short bf16;
typedef unsigned v4u __attribute__((ext_vector_type(4)));
typedef float f32x4 __attribute__((ext_vector_type(4)));
typedef short bf16x8 __attribute__((ext_vector_type(8)));
typedef GAS unsigned gu32;
typedef GAS unsigned long long gu64;
#define RLX_AGENT __ATOMIC_RELAXED, __HIP_MEMORY_SCOPE_AGENT
#define LDS_WAIT() asm volatile("s_waitcnt lgkmcnt(0)" ::: "memory")
#define VM_WAIT() asm volatile("s_waitcnt vmcnt(0)" ::: "memory")
__device__ __forceinline__ unsigned long long rt() { return __builtin_amdgcn_s_memrealtime(); }
__device__ __forceinline__ unsigned f2bf(float f) { unsigned u = __builtin_bit_cast(unsigned, f); return (u + 0x7fffu + ((u >> 16) & 1u)) >> 16; }
__device__ __forceinline__ unsigned pk2(float lo, float hi) { return f2bf(lo) | (f2bf(hi) << 16); }

#define XB_TMO      128
#define XB_XCNT(j)  (256  + 64 * (j))
#define XB_XSUB(j)  (1280 + 64 * (j))
#define XB_XGEN(j)  (2304 + 64 * (j))
#define XB_TOP      3328
#define XB_TOPGEN   3392
#define XCD_BAR_WORDS 3456
#define XB_SPIN_CAP (1u << 18)

__device__ __forceinline__ unsigned xb_ld(unsigned* p)              { return __hip_atomic_load(p, __ATOMIC_RELAXED, __HIP_MEMORY_SCOPE_AGENT); }
__device__ __forceinline__ unsigned xb_add(unsigned* p, unsigned v) { return __hip_atomic_fetch_add(p, v, __ATOMIC_RELAXED, __HIP_MEMORY_SCOPE_AGENT); }
__device__ __forceinline__ unsigned xb_xcc_id() { return (unsigned)__builtin_amdgcn_s_getreg((3 << 11) | 20) & 0xFu; }
#define XB_SPIN(cond, bar) do { unsigned _sp = 0; while (cond) { __builtin_amdgcn_s_sleep(1); \
    if ((++_sp & 255u) == 0u) { if (xb_ld(&(bar)[XB_TMO])) break; if (_sp > XB_SPIN_CAP) { atomicAdd(&(bar)[XB_TMO], 1u); break; } } } } while (0)

struct XcdBarrier {
    unsigned* bar; unsigned x;
    volatile LAS unsigned* st;
};

__device__ __forceinline__ XcdBarrier xcd_barrier_post(unsigned* bar, volatile LAS unsigned* st) {
    XcdBarrier b; b.bar = bar; b.x = xb_xcc_id(); b.st = st;
    if (threadIdx.x == 0) (void)xb_add(&bar[XB_XCNT(b.x)], 1u);
    return b;
}
__device__ __forceinline__ void xcd_barrier_complete(unsigned* bar, unsigned x, unsigned& nloc, unsigned& nx) {
    const unsigned G = gridDim.x * gridDim.y * gridDim.z;
    unsigned sum, cnt, mine, sp = 0u;
    for (;;) {
        sum = 0u; cnt = 0u; mine = 0u;
#pragma unroll
        for (unsigned j = 0; j < 16; ++j) { const unsigned c = xb_ld(&bar[XB_XCNT(j)]); sum += c; cnt += (c > 0u) ? 1u : 0u; mine = (j == x) ? c : mine; }
        if (sum == G) break;
        __builtin_amdgcn_s_sleep(1);
        if ((++sp & 255u) == 0u) { if (xb_ld(&bar[XB_TMO])) break; if (sp > XB_SPIN_CAP) { atomicAdd(&bar[XB_TMO], 1u); break; } }
    }
    nloc = mine > 0u ? mine : 1u; nx = cnt > 0u ? cnt : 1u;
}

__device__ __forceinline__ void xcd_barrier(const XcdBarrier& b) {
    asm volatile("s_waitcnt vmcnt(0)" ::: "memory");
    __syncthreads();
    if (threadIdx.x == 0) {
        unsigned* bar = b.bar;
        __builtin_amdgcn_s_waitcnt(0);
        unsigned nloc = b.st[0], nx = b.st[1];
        if (nloc == 0u) { xcd_barrier_complete(bar, b.x, nloc, nx); b.st[0] = nloc; b.st[1] = nx; }
        const unsigned old = xb_add(&bar[XB_XSUB(b.x)], 1u);
        const unsigned gen = old / nloc;
        if (old + 1u == (gen + 1u) * nloc) {
            __builtin_amdgcn_fence(__ATOMIC_RELEASE, "agent");
            asm volatile("s_waitcnt vmcnt(0)" ::: "memory");
            const unsigned og = xb_add(&bar[XB_TOP], 1u);
            const unsigned tg = og / nx;
            if (og + 1u == (tg + 1u) * nx) xb_add(&bar[XB_TOPGEN], 1u);
            else XB_SPIN(xb_ld(&bar[XB_TOPGEN]) == tg, bar);
            __builtin_amdgcn_fence(__ATOMIC_ACQUIRE, "agent");
            xb_add(&bar[XB_XGEN(b.x)], 1u);
            asm volatile("s_waitcnt vmcnt(0)" ::: "memory");
        } else {
            XB_SPIN(xb_ld(&bar[XB_XGEN(b.x)]) == gen, bar);
            __builtin_amdgcn_fence(__ATOMIC_ACQUIRE, "agent");
            asm volatile("s_waitcnt vmcnt(0)" ::: "memory");
        }
    }
    __syncthreads();
}
constexpr int NWAVES = 8, NT = NWAVES * 64;
constexpr int BATCH = 8, SEQ = 2048, DM = 1024, M = BATCH * SEQ, MEMLEN = 256, MM = BATCH * MEMLEN, FFD = 4096;
constexpr int INC = 7168, RWC = 1792;
constexpr float LOG2E = 1.4426950408889634f;
constexpr float QS64 = 0.125f * LOG2E;
constexpr float QS128 = 0.08838834764831845f * LOG2E;
constexpr size_t MiB = 1u << 20;
constexpr size_t WS_CTL = 0, CTL_ZERO_BYTES = 1536 * 1024;
constexpr size_t WS_XB = 512 * 1024;
constexpr int CW_PANEL = 16384, PANEL_BANK = 64 * 64;
constexpr size_t WS_KM = 1 * MiB + 512 * 1024;
constexpr size_t WS_RS = 1 * MiB + 768 * 1024;
constexpr size_t WS_ROPE = 2 * MiB;
constexpr size_t WS_WA = 6 * MiB;
constexpr size_t WS_WBR = 34 * MiB + MiB / 2, WS_WOUT = 37 * MiB + MiB / 2;
constexpr size_t WS_VFIRST = 16 * MiB;
constexpr size_t WS_MEMKV = 112 * MiB;
constexpr size_t WS_WAB = 32 * MiB;
constexpr size_t WS_XN = 40 * MiB;
constexpr size_t WS_URW = 72 * MiB;
constexpr size_t WS_MK = 128 * MiB, WS_MV = 144 * MiB, WS_SK = 160 * MiB, WS_SV = 164 * MiB;
constexpr size_t WS_GATE = 72 * MiB;
constexpr size_t WS_Y = 72 * MiB;
constexpr size_t WS_QX = 136 * MiB;
constexpr size_t WS_HMID = 72 * MiB;
constexpr size_t WS_MQ = 168 * MiB, WS_SQ = 184 * MiB, WS_ORW = 200 * MiB;
constexpr size_t WS_G = 216 * MiB, WS_BV = 232 * MiB;
constexpr size_t WS_WXQ = 15 * MiB  , WS_WXO = 217 * MiB, WS_WUP = 218 * MiB, WS_WDN = 226 * MiB;
constexpr size_t WS_MN = 104 * MiB, WS_WKV = 108 * MiB;
constexpr size_t WS_WG = 248 * MiB;
constexpr size_t WS_VM = 254 * MiB;
constexpr size_t WS_END = 256 * MiB;
constexpr int CW_BAR = 1024;

constexpr int LDS_BYTES = 147456, LDSCTL_OFF = LDS_BYTES - 1024, MISC_OFF = LDSCTL_OFF + 320;

struct Params {
    const float* in[35]; float* out; unsigned char* ws;
};

struct Frame {
    LAS unsigned char* lds; int wave, G, bid;
};
__device__ __forceinline__ int tid_now() { int t = threadIdx.x; asm volatile("" : "+v"(t)); return t; }

__device__ __forceinline__ float wave_sum(float v) {
#pragma unroll
    for (int o = 1; o < 64; o <<= 1) v += __shfl_xor(v, o);
    return v;
}
__device__ __forceinline__ float row16_sum(float v) {
    v += __builtin_bit_cast(float, __builtin_amdgcn_update_dpp(0, __builtin_bit_cast(int, v), 0x128, 0xf, 0xf, false));
    v += __builtin_bit_cast(float, __builtin_amdgcn_update_dpp(0, __builtin_bit_cast(int, v), 0x124, 0xf, 0xf, false));
    v += __builtin_bit_cast(float, __builtin_amdgcn_update_dpp(0, __builtin_bit_cast(int, v), 0x122, 0xf, 0xf, false));
    v += __builtin_bit_cast(float, __builtin_amdgcn_update_dpp(0, __builtin_bit_cast(int, v), 0x121, 0xf, 0xf, false));
    return v;
}
__device__ __forceinline__ float bfl(unsigned w) { return __builtin_bit_cast(float, w << 16); }
__device__ __forceinline__ float bfh(unsigned w) { return __builtin_bit_cast(float, w & 0xffff0000u); }
__device__ __forceinline__ float bf1(bf16 h) { return __builtin_bit_cast(float, (unsigned)h << 16); }
__device__ __forceinline__ float sigm(float x) { return 1.f / (1.f + __expf(-x)); }
typedef float f32x2_g __attribute__((ext_vector_type(2))); typedef __bf16 bf16x2_g __attribute__((ext_vector_type(2)));
__device__ __forceinline__ unsigned cvt_pk(float lo, float hi) { f32x2_g v = {lo, hi}; bf16x2_g b = __builtin_convertvector(v, bf16x2_g); return __builtin_bit_cast(unsigned, b); }
__device__ __forceinline__ bf16 cvt_1(float x) { return (bf16)(cvt_pk(x, 0.f) & 0xffffu); }

template <class RowMap>
__device__ __forceinline__ void transpose_store_g(const f32x4 (&v)[8], const float (&gv)[8], int K, bf16* WT, RowMap rowmap, LAS float* scr, int kb, int nb, int lane) {
    const int k0 = 64 * kb, n0 = 32 * nb, kr = lane >> 3, n4 = (lane & 7) * 4;
#pragma unroll
    for (int i = 0; i < 8; ++i) { const int kk = 8 * i + kr; const f32x4 x = v[i] * gv[i];
        LAS float* d = scr + kk * 33 + n4; d[0] = x.x; d[1] = x.y; d[2] = x.z; d[3] = x.w; }
    LDS_WAIT(); asm volatile("" ::: "memory");
    const int c = lane & 7;
#pragma unroll
    for (int j = 0; j < 4; ++j) { const int n = (lane >> 3) + 8 * j; const LAS float* s = scr + (8 * c) * 33 + n;
        v4u o; o.x = cvt_pk(s[0 * 33], s[1 * 33]); o.y = cvt_pk(s[2 * 33], s[3 * 33]); o.z = cvt_pk(s[4 * 33], s[5 * 33]); o.w = cvt_pk(s[6 * 33], s[7 * 33]);
        const int dr = rowmap(n0 + n);
        *(GAS v4u*)(WT + (size_t)dr * K + k0 + 8 * c) = o; }
    LDS_WAIT(); asm volatile("" ::: "memory");
}
template <class RowMap>
__device__ __forceinline__ void transpose_store(const f32x4 (&v)[8], int K, const float* gain, bf16* WT, RowMap rowmap, LAS float* scr, int kb, int nb, int lane) {
    const int k0 = 64 * kb, n0 = 32 * nb, kr = lane >> 3, n4 = (lane & 7) * 4;
#pragma unroll
    for (int i = 0; i < 8; ++i) { const int kk = 8 * i + kr; f32x4 x = v[i]; if (gain) x = x * gain[k0 + kk];
        LAS float* d = scr + kk * 33 + n4; d[0] = x.x; d[1] = x.y; d[2] = x.z; d[3] = x.w; }
    LDS_WAIT(); asm volatile("" ::: "memory");
    const int c = lane & 7;
#pragma unroll
    for (int j = 0; j < 4; ++j) { const int n = (lane >> 3) + 8 * j; const LAS float* s = scr + (8 * c) * 33 + n;
        v4u o; o.x = cvt_pk(s[0 * 33], s[1 * 33]); o.y = cvt_pk(s[2 * 33], s[3 * 33]); o.z = cvt_pk(s[4 * 33], s[5 * 33]); o.w = cvt_pk(s[6 * 33], s[7 * 33]);
        const int dr = rowmap(n0 + n);
        *(GAS v4u*)(WT + (size_t)dr * K + k0 + 8 * c) = o; }
    LDS_WAIT(); asm volatile("" ::: "memory");
}
template <class RowMap>
__device__ __forceinline__ void transpose_item2(const float* W, int ldw, int c0, int K, const float* gain, bf16* WT, RowMap rowmap, LAS float* scr, int kb1, int nb1, int kb2, int nb2, bool has2, int lane) {
    const int kr = lane >> 3, n4 = (lane & 7) * 4;
    f32x4 v1[8], v2[8];
#pragma unroll
    for (int i = 0; i < 8; ++i) v1[i] = *(const GAS f32x4*)(W + (size_t)(64 * kb1 + 8 * i + kr) * ldw + c0 + 32 * nb1 + n4);
#pragma unroll
    for (int i = 0; i < 8; ++i) v2[i] = *(const GAS f32x4*)(W + (size_t)(64 * kb2 + 8 * i + kr) * ldw + c0 + 32 * nb2 + n4);
    transpose_store(v1, K, gain, WT, rowmap, scr, kb1, nb1, lane);
    if (has2) transpose_store(v2, K, gain, WT, rowmap, scr, kb2, nb2, lane);
}
struct MapWAB { __device__ __forceinline__ int operator()(int n) const; };
struct MapId { int off; __device__ __forceinline__ int operator()(int n) const { return off + n; } };
struct CvItem { const float* W; int ldw; int K; const float* gain; bf16* WT; int roff; int kb, nb; int rmode = 0; };
struct MapCv { int mode, roff; __device__ __forceinline__ int operator()(int n) const; };
__device__ __forceinline__ void transpose_pair(const CvItem& a, const CvItem& b, bool has2, LAS float* scr, int lane) {
    const int kr = lane >> 3, n4 = (lane & 7) * 4;
    f32x4 v1[8], v2[8];
#pragma unroll
    for (int i = 0; i < 8; ++i) v1[i] = *(const GAS f32x4*)(a.W + (size_t)(64 * a.kb + 8 * i + kr) * a.ldw + 32 * a.nb + n4);
#pragma unroll
    for (int i = 0; i < 8; ++i) v2[i] = *(const GAS f32x4*)(b.W + (size_t)(64 * b.kb + 8 * i + kr) * b.ldw + 32 * b.nb + n4);
    float g1[8], g2[8];
#pragma unroll
    for (int i = 0; i < 8; ++i) { g1[i] = a.gain ? a.gain[64 * a.kb + 8 * i + kr] : 1.f; g2[i] = b.gain ? b.gain[64 * b.kb + 8 * i + kr] : 1.f; }
    transpose_store_g(v1, g1, a.K, a.WT, MapCv{a.rmode, a.roff}, scr, a.kb, a.nb, lane);
    if (has2) transpose_store_g(v2, g2, b.K, b.WT, MapCv{b.rmode, b.roff}, scr, b.kb, b.nb, lane);
}
__device__ __forceinline__ void transpose_quad(const CvItem& a, const CvItem& b, const CvItem& c, const CvItem& d, int n, LAS float* scr, int lane) {
    const int kr = lane >> 3, n4 = (lane & 7) * 4;
    f32x4 v1[8], v2[8], v3[8], v4[8];
#pragma unroll
    for (int i = 0; i < 8; ++i) v1[i] = *(const GAS f32x4*)(a.W + (size_t)(64 * a.kb + 8 * i + kr) * a.ldw + 32 * a.nb + n4);
#pragma unroll
    for (int i = 0; i < 8; ++i) v2[i] = *(const GAS f32x4*)(b.W + (size_t)(64 * b.kb + 8 * i + kr) * b.ldw + 32 * b.nb + n4);
#pragma unroll
    for (int i = 0; i < 8; ++i) v3[i] = *(const GAS f32x4*)(c.W + (size_t)(64 * c.kb + 8 * i + kr) * c.ldw + 32 * c.nb + n4);
#pragma unroll
    for (int i = 0; i < 8; ++i) v4[i] = *(const GAS f32x4*)(d.W + (size_t)(64 * d.kb + 8 * i + kr) * d.ldw + 32 * d.nb + n4);
    transpose_store(v1, a.K, a.gain, a.WT, MapCv{a.rmode, a.roff}, scr, a.kb, a.nb, lane);
    if (n > 1) transpose_store(v2, b.K, b.gain, b.WT, MapCv{b.rmode, b.roff}, scr, b.kb, b.nb, lane);
    if (n > 2) transpose_store(v3, c.K, c.gain, c.WT, MapCv{c.rmode, c.roff}, scr, c.kb, c.nb, lane);
    if (n > 3) transpose_store(v4, d.K, d.gain, d.WT, MapCv{d.rmode, d.roff}, scr, d.kb, d.nb, lane);
}
struct MapWA { __device__ __forceinline__ int operator()(int n) const {
    const bool rp = (n >= 1792 && n < 2816) || (n >= 3328 && n < 3968);
    if (!rp) return n; const int hb = n & ~63, d = n & 63; return hb + ((d < 32) ? 2 * d : 2 * (d - 32) + 1); } };

constexpr int PA_COLS = 3072;
__device__ __forceinline__ int MapWAB::operator()(int n) const { return MapWA{}(n + PA_COLS) - PA_COLS; }
__device__ __forceinline__ int MapCv::operator()(int n) const { return mode == 1 ? MapWA{}(n) : (mode == 2 ? MapWAB{}(n) : roff + n); }
template <class RowMap>
__device__ __forceinline__ void convert_matrix(const Frame& F, const float* W, int ldw, int c0, int K, int N, const float* gain, bf16* WT, RowMap rm, int wg0 = 0, int nwg = 0) {
    LAS float* scr = (LAS float*)(F.lds + F.wave * 16384); const int lane = tid_now() & 63;
    const int gw = (F.bid - wg0) * NWAVES + F.wave, NGW = (nwg ? nwg : F.G) * NWAVES, nblk = N / 32, nit = (K / 64) * nblk;
    for (int it = gw; it < nit; it += 2 * NGW) { const int it2 = it + NGW; const bool has2 = it2 < nit; const int i2 = has2 ? it2 : it;
        transpose_item2(W, ldw, c0, K, gain, WT, rm, scr, it / nblk, it % nblk, i2 / nblk, i2 % nblk, has2, lane); }
}

__device__ __forceinline__ void norm_row_to_bf16(const float* xrow, bf16* orow, int lane, float* rsout = nullptr) {
    const GAS f32x4* xr = (const GAS f32x4*)xrow + lane; f32x4 v[4]; float s = 0.f;
#pragma unroll
    for (int j = 0; j < 4; ++j) { v[j] = xr[64 * j]; s += (v[j].x * v[j].x + v[j].y * v[j].y) + (v[j].z * v[j].z + v[j].w * v[j].w); }
    const float ms = wave_sum(s) * (1.f / DM) + 1e-6f; const float rs = 1.f / sqrtf(ms);
    if (rsout != nullptr && lane == 0) *rsout = sqrtf(ms);
    GAS unsigned long long* o8 = (GAS unsigned long long*)orow + lane;
#pragma unroll
    for (int j = 0; j < 4; ++j) o8[64 * j] = (unsigned long long)pk2(v[j].x * rs, v[j].y * rs) | ((unsigned long long)pk2(v[j].z * rs, v[j].w * rs) << 32);
}
__device__ __forceinline__ void norm_rows4_to_bf16(const float* X, bf16* O, float* rsv, int r0, int rstep, int nrows, int lane) {
    f32x4 v[4][4]; int rr[4];
#pragma unroll
    for (int k = 0; k < 4; ++k) { rr[k] = r0 + k * rstep; const int rc = rr[k] < nrows ? rr[k] : r0; const GAS f32x4* xr = (const GAS f32x4*)(X + (size_t)rc * DM) + lane;
#pragma unroll
        for (int j = 0; j < 4; ++j) v[k][j] = xr[64 * j]; }
#pragma unroll
    for (int k = 0; k < 4; ++k) { float s = 0.f;
#pragma unroll
        for (int j = 0; j < 4; ++j) s += (v[k][j].x * v[k][j].x + v[k][j].y * v[k][j].y) + (v[k][j].z * v[k][j].z + v[k][j].w * v[k][j].w);
        const float ms = wave_sum(s) * (1.f / DM) + 1e-6f; const float rs = 1.f / sqrtf(ms);
        if (rr[k] < nrows) { if (lane == 0) rsv[rr[k]] = sqrtf(ms);
            GAS unsigned long long* o8 = (GAS unsigned long long*)(O + (size_t)rr[k] * DM) + lane;
#pragma unroll
            for (int j = 0; j < 4; ++j) o8[64 * j] = (unsigned long long)pk2(v[k][j].x * rs, v[k][j].y * rs) | ((unsigned long long)pk2(v[k][j].z * rs, v[k][j].w * rs) << 32); } }
}
__device__ __forceinline__ void row_phase(const Frame& F, bf16* xn, float* rsv, const bf16* y, const float* g, float* out) {
    const int gw = F.bid * NWAVES + F.wave, NGW = F.G * NWAVES, lane = tid_now() & 63;
    for (int r = gw; r < M; r += NGW) {
        const GAS unsigned long long* y8 = (const GAS unsigned long long*)(y + (size_t)r * DM) + lane; GAS unsigned long long* x8 = (GAS unsigned long long*)(xn + (size_t)r * DM) + lane; const f32x4* g4 = (const f32x4*)g + lane;
        f32x4 yv[4]; float s = 0.f; const float ro = rsv[r];
#pragma unroll
        for (int j = 0; j < 4; ++j) { const unsigned long long w = y8[64 * j]; const unsigned lo = (unsigned)w, hi = (unsigned)(w >> 32); yv[j] = (f32x4){bfl(lo), bfh(lo), bfl(hi), bfh(hi)};
            s += (yv[j].x * yv[j].x + yv[j].y * yv[j].y) + (yv[j].z * yv[j].z + yv[j].w * yv[j].w); }
        const float rs = 1.f / sqrtf(wave_sum(s) * (1.f / DM) + 1e-6f); float s2 = 0.f; f32x4 xv[4];
#pragma unroll
        for (int j = 0; j < 4; ++j) { const unsigned long long w = x8[64 * j]; const unsigned lo = (unsigned)w, hi = (unsigned)(w >> 32);
            xv[j] = (f32x4){bfl(lo), bfh(lo), bfl(hi), bfh(hi)} * ro + yv[j] * rs * g4[64 * j]; s2 += (xv[j].x * xv[j].x + xv[j].y * xv[j].y) + (xv[j].z * xv[j].z + xv[j].w * xv[j].w); }
        if (out != nullptr) { GAS f32x4* xo = (GAS f32x4*)(out + (size_t)r * DM) + lane;
#pragma unroll
            for (int j = 0; j < 4; ++j) xo[64 * j] = xv[j]; }
        else { const float ms = wave_sum(s2) * (1.f / DM) + 1e-6f; const float rs2 = 1.f / sqrtf(ms); if (lane == 0) rsv[r] = sqrtf(ms);
#pragma unroll
            for (int j = 0; j < 4; ++j) x8[64 * j] = (unsigned long long)pk2(xv[j].x * rs2, xv[j].y * rs2) | ((unsigned long long)pk2(xv[j].z * rs2, xv[j].w * rs2) << 32); }
    }
}

__device__ __forceinline__ void vm_phase(const Frame& F, const bf16* XNp, const bf16* WT  , bf16* VMp) {
    const int tid = tid_now(), lane = tid & 63, fr = lane & 15, fq = lane >> 4, rt = F.wave >> 1, ct = F.wave & 1;
    for (int blk = F.bid; blk < M / 64; blk += F.G) {
        const bf16* ap = XNp + (size_t)(blk * 64 + rt * 16 + fr) * DM + fq * 8; const bf16* bp = WT + (size_t)(ct * 16 + fr) * DM + fq * 8;
        f32x4 acc = (f32x4){0.f, 0.f, 0.f, 0.f};
#pragma unroll 8
        for (int ks = 0; ks < 32; ++ks) acc = __builtin_amdgcn_mfma_f32_16x16x32_bf16(*(const bf16x8*)(ap + ks * 32), *(const bf16x8*)(bp + ks * 32), acc, 0, 0, 0);
#pragma unroll
        for (int j = 0; j < 4; ++j) VMp[(size_t)(blk * 64 + rt * 16 + fq * 4 + j) * 32 + ct * 16 + fr] = cvt_1(acc[j]);
    }
}

__device__ __forceinline__ void sub_barrier(unsigned* cnt, unsigned n) {
    asm volatile("s_waitcnt vmcnt(0)" ::: "memory"); __syncthreads();
    if (threadIdx.x == 0) {
        __builtin_amdgcn_fence(__ATOMIC_RELEASE, "agent"); asm volatile("s_waitcnt vmcnt(0)" ::: "memory");
        __hip_atomic_fetch_add(cnt, 1u, __ATOMIC_RELAXED, __HIP_MEMORY_SCOPE_AGENT);
        unsigned spins = 0;
        while (__hip_atomic_load(cnt, __ATOMIC_RELAXED, __HIP_MEMORY_SCOPE_AGENT) < n) { __builtin_amdgcn_s_sleep(4); if (++spins > (1u << 22)) break; }
        __builtin_amdgcn_fence(__ATOMIC_ACQUIRE, "agent"); asm volatile("s_waitcnt vmcnt(0)" ::: "memory");
    }
    __syncthreads();
}
namespace at {
using bf16x8 = __attribute__((ext_vector_type(8))) short;
using s16x4 = __attribute__((ext_vector_type(4))) short;
using f32x16 = __attribute__((ext_vector_type(16))) float;
using u32x4 = __attribute__((ext_vector_type(4))) unsigned;
typedef short v4i16_t __attribute__((ext_vector_type(4)));
typedef __attribute__((address_space(3))) const char* lds_cptr;
typedef __attribute__((address_space(3))) char* lds_ptr;
__device__ __forceinline__ int crow(int r, int hi) { return (r & 3) + 8 * (r >> 2) + 4 * hi; }
__device__ __forceinline__ void glds16(const void* gsrc, unsigned lds_dst) { unsigned keep;
    asm volatile("s_mov_b32 %0, m0\n\ts_mov_b32 m0, %2\n\ts_nop 0\n\tglobal_load_lds_dwordx4 %1, off\n\ts_mov_b32 m0, %0" : "=&s"(keep) : "v"(gsrc), "s"(lds_dst) : "memory"); }
typedef float f32x2_t __attribute__((ext_vector_type(2))); typedef __bf16 bf16x2_t __attribute__((ext_vector_type(2)));
__device__ __forceinline__ unsigned cvtpk(float lo, float hi) { f32x2_t v = {lo, hi}; bf16x2_t b = __builtin_convertvector(v, bf16x2_t); return __builtin_bit_cast(unsigned, b); }
__device__ __forceinline__ s16x4 vtr(lds_cptr p) { return __builtin_bit_cast(s16x4, __builtin_amdgcn_ds_read_tr16_b64_v4i16((__attribute__((address_space(3))) v4i16_t*)p)); }
#define AT_WAIT_BAR() asm volatile("s_waitcnt vmcnt(0) lgkmcnt(0)\n\ts_barrier" ::: "memory")

template <int HD, int NS> struct Lay {
    static constexpr int NCH = HD / 8, SLOT = 64 * HD * 2, LDS_K = 0, LDS_V = NS * SLOT, LDS_WS = 2 * NS * SLOT, LDS_OST = LDS_WS + 8 * 64 * 4, BYTES = LDS_OST + 8 * 32 * HD * 2;
};
struct Ten { const bf16* Q; int qp; const bf16* K; const bf16* V; int kvp; bf16* O; int op; };

template <int HD, int MODE>
__device__ __forceinline__ void attn_unit(const Ten& T, int q0, int kt0, int nt, float sink_l2, const float* kmsum  , lds_ptr shm) {
    constexpr int NS = (HD == 64) ? 4 : 2;
    using L = Lay<HD, NS>;
    constexpr int ND = HD / 16, NO = HD / 32;
    const int tid = tid_now(), lane = tid & 63, r32 = lane & 31, hi = lane >> 5; const int wid = __builtin_amdgcn_readfirstlane(tid >> 6);
    const unsigned lds0 = (unsigned)(uintptr_t)shm;
    __attribute__((address_space(3))) float* wsf = (__attribute__((address_space(3))) float*)(shm + L::LDS_WS) + wid * 64;
    const int qb = q0 >> 8;
    const int NTILES = (MODE == 0) ? 4 * (qb + 1) : nt;
    auto tile_of = [&](int s) -> int { if (MODE == 0) return (s < 4) ? 4 * qb + s : s - 4; return kt0 + s; };
    auto dma = [&](int s, int slot) {
        const int kt = tile_of(s);
#pragma unroll
        for (int c = wid; c < L::NCH; c += 8) {
            const bf16* ksrc = T.K + (size_t)(kt * 64 + lane) * T.kvp + c * 8;
            glds16(ksrc, (unsigned)__builtin_amdgcn_readfirstlane(lds0 + L::LDS_K + slot * L::SLOT + c * 1024));
            const bf16* vsrc = T.V + (size_t)(kt * 64 + 16 * (c & 3) + (lane >> 2)) * T.kvp + (c >> 2) * 32 + (lane & 3) * 8;
            glds16(vsrc, (unsigned)__builtin_amdgcn_readfirstlane(lds0 + L::LDS_V + slot * L::SLOT + c * 1024));
        }
    };
    dma(0, 0);
    if (NS == 4) { if (1 < NTILES) dma(1, 1); if (2 < NTILES) dma(2, 2); }
    const bf16* Qw = T.Q + (size_t)(q0 + wid * 32) * T.qp;
    bf16x8 qr[ND];
#pragma unroll
    for (int d0 = 0; d0 < ND; ++d0) qr[d0] = *reinterpret_cast<const bf16x8*>(&Qw[(size_t)r32 * T.qp + d0 * 16 + hi * 8]);
    const int qrel = wid * 32 + r32;
    unsigned selbits = 0xffu;
    if (MODE == 0 && qb > 3) {
        { __attribute__((address_space(3))) float* kml = (__attribute__((address_space(3))) float*)(shm + L::LDS_WS);
          kml[tid] = kmsum[(size_t)(tid >> 6) * 512 + (tid & 63)];
          asm volatile("s_waitcnt vmcnt(0) lgkmcnt(0)\n\ts_barrier" ::: "memory"); }
        const __attribute__((address_space(3))) float* kml = (const __attribute__((address_space(3))) float*)(shm + L::LDS_WS);
        float g[7];
#pragma unroll
        for (int j = 0; j < 7; ++j) { g[j] = 0.f;
            if (j < qb) { float a = 0.f;
#pragma unroll
                for (int d0 = 0; d0 < ND; ++d0) { const __attribute__((address_space(3))) float* kp = kml + j * 64 + d0 * 16 + hi * 8; const f32x4 k0 = *(const __attribute__((address_space(3))) f32x4*)kp, k1 = *(const __attribute__((address_space(3))) f32x4*)(kp + 4);
                    const bf16x8 qq = qr[d0];
                    a += bf1((bf16)qq[0]) * k0[0] + bf1((bf16)qq[1]) * k0[1] + bf1((bf16)qq[2]) * k0[2] + bf1((bf16)qq[3]) * k0[3]
                       + bf1((bf16)qq[4]) * k1[0] + bf1((bf16)qq[5]) * k1[1] + bf1((bf16)qq[6]) * k1[2] + bf1((bf16)qq[7]) * k1[3]; }
                a = pg8::xsum_32(a); g[j] = a; } }
        selbits = 0u;
#pragma unroll
        for (int j = 0; j < 7; ++j) { int rank = 0;
#pragma unroll
            for (int i = 0; i < 7; ++i) if (i != j && i < qb) rank += (g[i] > g[j] || (g[i] == g[j] && i < j)) ? 1 : 0;
            if (j < qb && rank < 3) selbits |= 1u << j; }
    }
    float mhat = (MODE == 1) ? sink_l2 : 0.f, l_reg = (MODE == 1 && hi == 0) ? 1.f : 0.f;
    f32x16 o[NO];
#pragma unroll
    for (int d = 0; d < NO; ++d) o[d] = f32x16{};
    f32x16 negm;
#pragma unroll
    for (int r = 0; r < 16; ++r) negm[r] = -mhat;
    const lds_cptr shm3 = (lds_cptr)shm;
    for (int s = 0; s < NTILES; ++s) {
        const int slot = s & (NS - 1);
        if (NS == 4) {
            const int rem = NTILES - 1 - s;
            if (rem >= 2) asm volatile("s_waitcnt vmcnt(4) lgkmcnt(0)\n\ts_barrier" ::: "memory");
            else if (rem == 1) asm volatile("s_waitcnt vmcnt(2) lgkmcnt(0)\n\ts_barrier" ::: "memory");
            else AT_WAIT_BAR();
            if (s + 3 < NTILES) dma(s + 3, (s + 3) & 3);
        } else {
            AT_WAIT_BAR();
            if (s + 1 < NTILES) dma(s + 1, slot ^ 1);
        }
        int tclass = 2;
        if (MODE == 0) { if (s < 4) { const int klo_t = 64 * s, khi_t = 64 * s + 63, rlo = wid * 32, rhi = wid * 32 + 31; tclass = (klo_t > rhi) ? 0 : (khi_t <= rlo ? 2 : 1); }
                         else { const bool sel = ((selbits >> ((s - 4) >> 2)) & 1u) != 0u; tclass = __all(sel) ? 2 : (__any(sel) ? 1 : 0); } }
        else if (MODE == 1) { const int klo_t = 64 * (kt0 + s) - q0, khi_t = klo_t + 63, rlo = wid * 32, rhi = wid * 32 + 31;
                              tclass = (klo_t > rhi || khi_t < rlo - 127) ? 0 : ((khi_t <= rlo && klo_t >= rhi - 127) ? 2 : 1); }
        if (tclass == 0) continue;
        f32x16 p0 = negm, p1 = negm;
        const lds_cptr kb = shm3 + L::LDS_K + slot * L::SLOT + hi * 1024 + r32 * 16;
#pragma unroll
        for (int d0 = 0; d0 < ND; ++d0) {
            const bf16x8 b0 = *(const __attribute__((address_space(3))) bf16x8*)(kb + d0 * 2048);
            const bf16x8 b1 = *(const __attribute__((address_space(3))) bf16x8*)(kb + d0 * 2048 + 512);
            p0 = __builtin_amdgcn_mfma_f32_32x32x16_bf16(b0, qr[d0], p0, 0, 0, 0);
            p1 = __builtin_amdgcn_mfma_f32_32x32x16_bf16(b1, qr[d0], p1, 0, 0, 0);
        }
        if (MODE != 2 && tclass == 1) {
            int klo, khi, kbase;
            if (MODE == 0) { if (s < 4) { kbase = 64 * s; klo = -1000000; khi = qrel; } else { kbase = -1000000; klo = -2000000; khi = ((selbits >> ((s - 4) >> 2)) & 1u) ? 0 : -2000000; } }
            else { kbase = 64 * (kt0 + s) - q0; klo = qrel - 127; khi = qrel; }
            const int kb4 = kbase + 4 * hi;
#pragma unroll
            for (int r = 0; r < 16; ++r) { const int kv = kb4 + (r & 3) + 8 * (r >> 2);
                if (kv > khi || kv < klo) p0[r] = -INFINITY;
                if (kv + 32 > khi || kv + 32 < klo) p1[r] = -INFINITY; }
        }
        float rm = p0[0];
#pragma unroll
        for (int r = 1; r < 16; ++r) rm = fmaxf(rm, p0[r]);
#pragma unroll
        for (int r = 0; r < 16; ++r) rm = fmaxf(rm, p1[r]);
        rm = pg8::xmax_32(rm);
        bool resc = false;
        if (__any(rm > 6.f)) { const float dl = fmaxf(rm, 0.f); mhat += dl;
#pragma unroll
            for (int r = 0; r < 16; ++r) { p0[r] -= dl; p1[r] -= dl; negm[r] = -mhat; }
            const float f = __builtin_amdgcn_exp2f(-dl); l_reg *= f; if (hi == 0) wsf[r32] = f; resc = true; }
        float sacc = 0.f;
#pragma unroll
        for (int r = 0; r < 16; ++r) { p0[r] = __builtin_amdgcn_exp2f(p0[r]); p1[r] = __builtin_amdgcn_exp2f(p1[r]); sacc += p0[r] + p1[r]; }
        l_reg += sacc;
        if (resc) {
#pragma unroll
            for (int r = 0; r < 16; ++r) { const float f = wsf[crow(r, hi)];
#pragma unroll
                for (int d = 0; d < NO; ++d) o[d][r] *= f; }
        }
        u32x4 pw[4];
        pw[0] = (u32x4){cvtpk(p0[0], p0[1]), cvtpk(p0[2], p0[3]), cvtpk(p0[4], p0[5]), cvtpk(p0[6], p0[7])};
        pw[1] = (u32x4){cvtpk(p0[8], p0[9]), cvtpk(p0[10], p0[11]), cvtpk(p0[12], p0[13]), cvtpk(p0[14], p0[15])};
        pw[2] = (u32x4){cvtpk(p1[0], p1[1]), cvtpk(p1[2], p1[3]), cvtpk(p1[4], p1[5]), cvtpk(p1[6], p1[7])};
        pw[3] = (u32x4){cvtpk(p1[8], p1[9]), cvtpk(p1[10], p1[11]), cvtpk(p1[12], p1[13]), cvtpk(p1[14], p1[15])};
        const lds_cptr vp = shm3 + L::LDS_V + slot * L::SLOT + ((lane >> 4) & 1) * 32 + (lane & 3) * 8 + (4 * hi + ((lane & 15) >> 2)) * 64;
#pragma unroll
        for (int d0 = 0; d0 < NO; ++d0)
#pragma unroll
            for (int ks = 0; ks < 4; ++ks) { const s16x4 lo = vtr(vp + d0 * 4096 + ks * 1024), hh = vtr(vp + d0 * 4096 + ks * 1024 + 512);
                const bf16x8 vf = (bf16x8){lo[0], lo[1], lo[2], lo[3], hh[0], hh[1], hh[2], hh[3]};
                o[d0] = __builtin_amdgcn_mfma_f32_32x32x16_bf16(__builtin_bit_cast(bf16x8, pw[ks]), vf, o[d0], 0, 0, 0); }
    }
    l_reg = pg8::xsum_32(l_reg);
    if (hi == 0) wsf[32 + r32] = l_reg;
    asm volatile("s_waitcnt lgkmcnt(0)" ::: "memory");
    float rli[16];
#pragma unroll
    for (int r = 0; r < 16; ++r) rli[r] = 1.f / wsf[32 + crow(r, hi)];
    bf16* Ow = T.O + (size_t)(q0 + wid * 32) * T.op;
    { __attribute__((address_space(3))) bf16* stg = (__attribute__((address_space(3))) bf16*)(shm + L::LDS_OST) + wid * 32 * HD;
#pragma unroll
      for (int r = 0; r < 16; ++r) { const int orow = crow(r, hi);
#pragma unroll
          for (int d0 = 0; d0 < NO; ++d0) stg[orow * HD + d0 * 32 + r32] = (bf16)(cvtpk(o[d0][r] * rli[r], 0.f) & 0xffffu); }
      asm volatile("s_waitcnt lgkmcnt(0)" ::: "memory");
      constexpr int CPR = HD / 8, RPI = 64 / CPR;
#pragma unroll
      for (int i = 0; i < 32 / RPI; ++i) { const int row = i * RPI + lane / CPR, ch = lane % CPR; const u32x4 v = *(const __attribute__((address_space(3))) u32x4*)(stg + row * HD + ch * 8);
          *(u32x4*)(Ow + (size_t)row * T.op + ch * 8) = v; } }
    asm volatile("s_waitcnt vmcnt(0) lgkmcnt(0)\n\ts_barrier" ::: "memory");
}
}
namespace rw {
using bf16x8 = __attribute__((ext_vector_type(8))) short;
typedef float f4 __attribute__((ext_vector_type(4)));
typedef unsigned u4 __attribute__((ext_vector_type(4)));
typedef unsigned u2 __attribute__((ext_vector_type(2)));
#define RW_LAS __attribute__((address_space(3)))
struct Args { const bf16* URW; const bf16* LIN; bf16* VFIRST; bf16* ORW; bf16* G; bf16* BV;
              const float *mu, *w0, *w_up, *a0, *a_up, *g_up, *k_k, *k_a, *r_k, *vmu, *v0, *v_up; int layer; };
#ifndef NREP_PREP
#define NREP_PREP 1
#endif
#ifndef NREP_D
#define NREP_D 1
#endif
constexpr int CH = 32;
constexpr int O_STG = 0, O_VST = 40960, O_WS = 49152, O_AS = 57344, O_WUT = 65536, O_AUT = 74752, O_GUT = 83968, O_VUT = 92672, O_END = 95232;
constexpr int LINC = 288;
constexpr int SXW = 72, SXG = 136, SXV = 40;
__device__ __forceinline__ unsigned pkbf(float lo, float hi) { return pk2(lo, hi); }
#define RW_BAR() do { asm volatile("s_waitcnt lgkmcnt(0)" ::: "memory"); __builtin_amdgcn_s_barrier(); asm volatile("" ::: "memory"); } while (0)

__device__ __forceinline__ float fsig(float x) { return __builtin_amdgcn_rcpf(1.f + __builtin_amdgcn_exp2f(-1.4426950408889634f * x)); }
__device__ __forceinline__ float ftanh(float x) { return 1.f - 2.f * __builtin_amdgcn_rcpf(1.f + __builtin_amdgcn_exp2f(2.8853900817779268f * x)); }
__device__ __forceinline__ void lerp8(const u4 cur, const u4 prv, const float* mup, float* x) {
    const f4 m0 = *(const f4*)(mup), m1 = *(const f4*)(mup + 4);
    x[0] = bfl(cur.x) + m0[0] * (bfl(prv.x) - bfl(cur.x)); x[1] = bfh(cur.x) + m0[1] * (bfh(prv.x) - bfh(cur.x));
    x[2] = bfl(cur.y) + m0[2] * (bfl(prv.y) - bfl(cur.y)); x[3] = bfh(cur.y) + m0[3] * (bfh(prv.y) - bfh(cur.y));
    x[4] = bfl(cur.z) + m1[0] * (bfl(prv.z) - bfl(cur.z)); x[5] = bfh(cur.z) + m1[1] * (bfh(prv.z) - bfh(cur.z));
    x[6] = bfl(cur.w) + m1[2] * (bfl(prv.w) - bfl(cur.w)); x[7] = bfh(cur.w) + m1[3] * (bfh(prv.w) - bfh(cur.w)); }
__device__ __forceinline__ void lin_phase(const Frame& F, const bf16* URW, const bf16* VM, const float* mu, const float* vmu, int layer, bf16* LIN) {
    const int gt = F.bid * NT + tid_now(), GT = F.G * NT;
    for (int it = gt; it < M * 32; it += 2 * GT) { const int it2 = (it + GT < M * 32) ? it + GT : it;
        const int rowa = it >> 5, ca = it & 31, rowb = it2 >> 5, cb = it2 & 31; const int cola = 1536 + 8 * ca, colb = 1536 + 8 * cb;
        const bool fa = (rowa & (SEQ - 1)) == 0, fb = (rowb & (SEQ - 1)) == 0;
        const u4 cura = *(const u4*)(URW + (size_t)rowa * RWC + cola), curb = *(const u4*)(URW + (size_t)rowb * RWC + colb);
        u4 prva = *(const u4*)(URW + (size_t)(fa ? rowa : rowa - 1) * RWC + cola), prvb = *(const u4*)(URW + (size_t)(fb ? rowb : rowb - 1) * RWC + colb);
        if (fa) prva = (u4){0u, 0u, 0u, 0u}; if (fb) prvb = (u4){0u, 0u, 0u, 0u};
#pragma unroll
        for (int h = 0; h < 2; ++h) { const u4 cur = h ? curb : cura, prv = h ? prvb : prva; const int c8 = h ? cb : ca, col = h ? colb : cola, row = h ? rowb : rowa;
            float x[8]; lerp8(cur, prv, mu + col, x);
            if (c8 < 8) {
#pragma unroll
                for (int e = 0; e < 8; ++e) x[e] = ftanh(x[e]); }
            else if (c8 >= 16) {
#pragma unroll
                for (int e = 0; e < 8; ++e) x[e] = fsig(x[e]); }
            if (h == 0 || it2 != it) *(u4*)(LIN + (size_t)row * LINC + c8 * 8) = (u4){cvt_pk(x[0], x[1]), cvt_pk(x[2], x[3]), cvt_pk(x[4], x[5]), cvt_pk(x[6], x[7])}; }
    }
    for (int it = gt; it < M * 4; it += GT) { const int row = it >> 2, c4 = it & 3; const bool first = (row & (SEQ - 1)) == 0; u4 o = (u4){0u, 0u, 0u, 0u};
        if (layer > 0) { const int col = c4 * 8; const u4 cur = *(const u4*)(VM + (size_t)row * 32 + col); u4 prv = (u4){0u, 0u, 0u, 0u}; if (!first) prv = *(const u4*)(VM + (size_t)(row - 1) * 32 + col);
            float x[8]; lerp8(cur, prv, vmu + col, x); o = (u4){cvt_pk(x[0], x[1]), cvt_pk(x[2], x[3]), cvt_pk(x[4], x[5]), cvt_pk(x[6], x[7])}; }
        *(u4*)(LIN + (size_t)row * LINC + 256 + c4 * 8) = o; }
}
struct Raw { bf16x8 la0, la1, la2, la3, lg0, lg1, lg2, lg3; u2 rc, kc, rp, kp; unsigned short vb0, vb1, vb2, vb3, vb4, vf0, vf1, vf2, vf3; };
__device__ __forceinline__ void scan_unit(const Args& A, int u, RW_LAS unsigned char* lds) {
    const int tid = tid_now(), lane = tid & 63; const int wid = __builtin_amdgcn_readfirstlane(tid >> 6);
    const int b = u >> 4, h = (u >> 1) & 7, half = u & 1; const size_t rowbase = (size_t)b * SEQ; const int hc = h * 64, vcb = h * 64 + half * 32;
    RW_LAS float* STG = (RW_LAS float*)(lds + O_STG); RW_LAS float* VST = (RW_LAS float*)(lds + O_VST);
    RW_LAS float* WS = (RW_LAS float*)(lds + O_WS); RW_LAS float* AS = (RW_LAS float*)(lds + O_AS);
    RW_LAS bf16* WUT = (RW_LAS bf16*)(lds + O_WUT); RW_LAS bf16* AUT = (RW_LAS bf16*)(lds + O_AUT); RW_LAS bf16* GUT = (RW_LAS bf16*)(lds + O_GUT); RW_LAS bf16* VUT = (RW_LAS bf16*)(lds + O_VUT);
    for (int idx = tid; idx < 4096; idx += NT) { const int k = idx >> 6, n = idx & 63;
        WUT[n * SXW + k] = cvt_1(A.w_up[(size_t)k * 512 + hc + n]); AUT[n * SXW + k] = cvt_1(A.a_up[(size_t)k * 512 + hc + n]); }
    for (int idx = tid; idx < 4096; idx += NT) { const int k = idx >> 5, n = idx & 31; GUT[n * SXG + k] = cvt_1(A.g_up[(size_t)k * 512 + vcb + n]); }
    if (A.layer > 0) for (int idx = tid; idx < 1024; idx += NT) { const int k = idx >> 5, n = idx & 31; VUT[n * SXV + k] = cvt_1(A.v_up[(size_t)k * 512 + vcb + n]); }
    const int q = tid & 15, tq = tid >> 4, k4 = 4 * q, fr = lane & 15, fq = lane >> 4;
    const f4 c_kk = *(const f4*)(A.k_k + hc + k4), c_ka = *(const f4*)(A.k_a + hc + k4), c_rk = *(const f4*)(A.r_k + hc + k4);
    const f4 mu_r = *(const f4*)(A.mu + hc + k4), mu_k = *(const f4*)(A.mu + 512 + hc + k4);
    const int vrt = wid & 1, vct = (wid >> 1) & 1, vvc = vct * 16 + fr, vcol = 1024 + vcb + vvc;
    const float muv = A.mu[vcol], v0c = (A.layer > 0) ? A.v0[vcb + vvc] : 0.f;
    const int lrt = wid & 1, lch = (wid >> 1) * 16 + fr; const float w0c = A.w0[hc + lch], a0c = A.a0[hc + lch];
    f4 S = (f4){0.f, 0.f, 0.f, 0.f};
    Raw R;
    auto load_raw = [&](int t0) {
        { const bf16* lp = A.LIN + (rowbase + t0 + lrt * 16 + fr) * LINC + fq * 8;
          R.la0 = *(const bf16x8*)(lp); R.la1 = *(const bf16x8*)(lp + 32); R.la2 = *(const bf16x8*)(lp + 64); R.la3 = *(const bf16x8*)(lp + 96); }
        { const bf16* gp = A.LIN + (rowbase + t0 + vrt * 16 + fr) * LINC + fq * 8;
          const int gc0 = (wid < 4) ? 128 : 256, gst = (wid < 4) ? 32 : 0;
          R.lg0 = *(const bf16x8*)(gp + gc0); R.lg1 = *(const bf16x8*)(gp + gc0 + gst); R.lg2 = *(const bf16x8*)(gp + gc0 + 2 * gst); R.lg3 = *(const bf16x8*)(gp + gc0 + 3 * gst); }
        { const size_t row = rowbase + t0 + tq;
          R.rc = *(const u2*)(A.URW + row * RWC + hc + k4); R.kc = *(const u2*)(A.URW + row * RWC + 512 + hc + k4); R.rp = (u2){0u, 0u}; R.kp = R.rp;
          if (t0 + tq > 0) { R.rp = *(const u2*)(A.URW + (row - 1) * RWC + hc + k4); R.kp = *(const u2*)(A.URW + (row - 1) * RWC + 512 + hc + k4); } }
        if (wid >= 4) { const int tb = vrt * 16 + fq * 4; const size_t row = rowbase + t0 + tb;
            R.vb0 = (t0 + tb > 0) ? A.URW[(row - 1) * RWC + vcol] : (unsigned short)0;
            R.vb1 = A.URW[(row + 0) * RWC + vcol]; R.vb2 = A.URW[(row + 1) * RWC + vcol]; R.vb3 = A.URW[(row + 2) * RWC + vcol]; R.vb4 = A.URW[(row + 3) * RWC + vcol];
            if (A.layer > 0) { R.vf0 = A.VFIRST[(row + 0) * 512 + vcb + vvc]; R.vf1 = A.VFIRST[(row + 1) * 512 + vcb + vvc]; R.vf2 = A.VFIRST[(row + 2) * 512 + vcb + vvc]; R.vf3 = A.VFIRST[(row + 3) * 512 + vcb + vvc]; } }
    };
    auto prep = [&](int t0) {
        RW_LAS float* VSTw = VST + ((t0 >> 5) & 1) * 1024;
        { f4 aw = (f4){0.f, 0.f, 0.f, 0.f}, aa = aw;
          { const bf16x8 wb0 = *(const RW_LAS bf16x8*)(WUT + lch * SXW + fq * 8), ab0 = *(const RW_LAS bf16x8*)(AUT + lch * SXW + fq * 8);
            const bf16x8 wb1 = *(const RW_LAS bf16x8*)(WUT + lch * SXW + 32 + fq * 8), ab1 = *(const RW_LAS bf16x8*)(AUT + lch * SXW + 32 + fq * 8);
            aw = __builtin_amdgcn_mfma_f32_16x16x32_bf16(R.la0, wb0, aw, 0, 0, 0); aw = __builtin_amdgcn_mfma_f32_16x16x32_bf16(R.la1, wb1, aw, 0, 0, 0);
            aa = __builtin_amdgcn_mfma_f32_16x16x32_bf16(R.la2, ab0, aa, 0, 0, 0); aa = __builtin_amdgcn_mfma_f32_16x16x32_bf16(R.la3, ab1, aa, 0, 0, 0); }
#pragma unroll
          for (int j = 0; j < 4; ++j) { const int tok = lrt * 16 + fq * 4 + j;
              WS[tok * 64 + lch] = __builtin_amdgcn_exp2f(-0.8750404f * fsig(w0c + aw[j]));
              AS[tok * 64 + lch] = fsig(a0c + aa[j]); }
          if (wid < 4) { f4 ag = (f4){0.f, 0.f, 0.f, 0.f};
            { const RW_LAS bf16* gp_ = GUT + vvc * SXG + fq * 8;
              ag = __builtin_amdgcn_mfma_f32_16x16x32_bf16(R.lg0, *(const RW_LAS bf16x8*)(gp_), ag, 0, 0, 0); ag = __builtin_amdgcn_mfma_f32_16x16x32_bf16(R.lg1, *(const RW_LAS bf16x8*)(gp_ + 32), ag, 0, 0, 0);
              ag = __builtin_amdgcn_mfma_f32_16x16x32_bf16(R.lg2, *(const RW_LAS bf16x8*)(gp_ + 64), ag, 0, 0, 0); ag = __builtin_amdgcn_mfma_f32_16x16x32_bf16(R.lg3, *(const RW_LAS bf16x8*)(gp_ + 96), ag, 0, 0, 0); }
#pragma unroll
            for (int j = 0; j < 4; ++j) { const int tok = vrt * 16 + fq * 4 + j; A.G[(rowbase + t0 + tok) * 512 + vcb + vvc] = cvt_1(ag[j]); } }
          else { f4 av = (f4){0.f, 0.f, 0.f, 0.f};
            if (A.layer > 0) { const bf16x8 vb = *(const RW_LAS bf16x8*)(VUT + vvc * SXV + fq * 8); av = __builtin_amdgcn_mfma_f32_16x16x32_bf16(R.lg0, vb, av, 0, 0, 0); }
            const unsigned short vbs[5] = {R.vb0, R.vb1, R.vb2, R.vb3, R.vb4}; const unsigned short vfs[4] = {R.vf0, R.vf1, R.vf2, R.vf3};
#pragma unroll
            for (int j = 0; j < 4; ++j) { const int tok = vrt * 16 + fq * 4 + j; const size_t row = rowbase + t0 + tok;
                const float cur = bf1(vbs[1 + j]), prv = bf1(vbs[j]); float v = cur + muv * (prv - cur);
                if (A.layer == 0) A.VFIRST[row * 512 + vcb + vvc] = cvt_1(v);
                else { const float vf = bf1(vfs[j]), vg = fsig(v0c + av[j]); v = v + (vf - v) * vg; }
                VSTw[tok * 32 + vvc] = v; } } }
        RW_BAR();
        { const size_t row = rowbase + t0 + tq; const u2 rc = R.rc, kc = R.kc, rp = R.rp, kp = R.kp;
          f4 r, k;
          r[0] = bfl(rc.x) + mu_r[0] * (bfl(rp.x) - bfl(rc.x)); r[1] = bfh(rc.x) + mu_r[1] * (bfh(rp.x) - bfh(rc.x)); r[2] = bfl(rc.y) + mu_r[2] * (bfl(rp.y) - bfl(rc.y)); r[3] = bfh(rc.y) + mu_r[3] * (bfh(rp.y) - bfh(rc.y));
          k[0] = bfl(kc.x) + mu_k[0] * (bfl(kp.x) - bfl(kc.x)); k[1] = bfh(kc.x) + mu_k[1] * (bfh(kp.x) - bfh(kc.x)); k[2] = bfl(kc.y) + mu_k[2] * (bfl(kp.y) - bfl(kc.y)); k[3] = bfh(kc.y) + mu_k[3] * (bfh(kp.y) - bfh(kc.y));
          const f4 a = *(const RW_LAS f4*)(AS + tq * 64 + k4), w = *(const RW_LAS f4*)(WS + tq * 64 + k4);
          f4 kk = k * c_kk; float n2 = row16_sum(kk[0] * kk[0] + kk[1] * kk[1] + kk[2] * kk[2] + kk[3] * kk[3]);
          const float inv = fminf(__builtin_amdgcn_rsqf(n2), 1e12f); kk = kk * inv;
          const f4 bb = kk * a; f4 ke;
#pragma unroll
          for (int e = 0; e < 4; ++e) ke[e] = k[e] * (1.f + (a[e] - 1.f) * c_ka[e]);
          const float bon = row16_sum(r[0] * ke[0] * c_rk[0] + r[1] * ke[1] * c_rk[1] + r[2] * ke[2] * c_rk[2] + r[3] * ke[3] * c_rk[3]);
          RW_LAS float* sp = STG + tq * 320 + k4;
          *(RW_LAS f4*)(sp) = r; *(RW_LAS f4*)(sp + 64) = w; *(RW_LAS f4*)(sp + 128) = ke; *(RW_LAS f4*)(sp + 192) = kk; *(RW_LAS f4*)(sp + 256) = bb;
          const float v0 = VSTw[tq * 32 + 2 * q], v1 = VSTw[tq * 32 + 2 * q + 1];
          *(unsigned*)(A.BV + row * 512 + vcb + 2 * q) = cvt_pk(bon * v0, bon * v1); }
        RW_BAR();
    };
    load_raw(0);
    RW_BAR();
    prep(0);
    const int rho = tid >> 4;
    for (int t0 = 0; t0 < SEQ; t0 += CH) {
        if (t0 + CH < SEQ) load_raw(t0 + CH);
        float olo = 0.f, ohi = 0.f;
        { const RW_LAS float* sp = STG + k4; const RW_LAS float* vp = VST + ((t0 >> 5) & 1) * 1024 + rho;
          f4 r = *(const RW_LAS f4*)(sp), w = *(const RW_LAS f4*)(sp + 64), ke = *(const RW_LAS f4*)(sp + 128), kk = *(const RW_LAS f4*)(sp + 192), bb = *(const RW_LAS f4*)(sp + 256); float v = vp[0];
#pragma unroll
          for (int t = 0; t < CH; ++t) {
              f4 rn = r, wn = w, ken = ke, kkn = kk, bbn = bb; float vn = v;
              if (t + 1 < CH) { const RW_LAS float* sn = sp + (t + 1) * 320; rn = *(const RW_LAS f4*)(sn); wn = *(const RW_LAS f4*)(sn + 64); ken = *(const RW_LAS f4*)(sn + 128); kkn = *(const RW_LAS f4*)(sn + 192); bbn = *(const RW_LAS f4*)(sn + 256); vn = vp[(t + 1) * 32]; }
              const float sa = -row16_sum(__builtin_fmaf(S[3], kk[3], __builtin_fmaf(S[2], kk[2], __builtin_fmaf(S[1], kk[1], S[0] * kk[0]))));
              S = S * w + (bb * sa + ke * v);
              const float ov = row16_sum(__builtin_fmaf(S[3], r[3], __builtin_fmaf(S[2], r[2], __builtin_fmaf(S[1], r[1], S[0] * r[0]))));
              if (t < 16) olo = (q == t) ? ov : olo; else ohi = (q == t - 16) ? ov : ohi;
              r = rn; w = wn; ke = ken; kk = kkn; bb = bbn; v = vn; } }
        A.ORW[(rowbase + t0 + q) * 512 + vcb + rho] = cvt_1(olo); A.ORW[(rowbase + t0 + 16 + q) * 512 + vcb + rho] = cvt_1(ohi);
        if (t0 + CH < SEQ) prep(t0 + CH);
    }
    RW_BAR();
}
constexpr int L_STG = 0, L_VST = 81920, L_WS = 90112, L_AS = 98304, L_WUT = 106496, L_AUT = 115712, L_GUT = 124928, L_VUT = 133632, L_END = 136192;
static_assert(L_END <= 146432 - 1024, "scan LDS map");
__device__ __forceinline__ float half8_sum(float v) {
    v += __builtin_bit_cast(float, __builtin_amdgcn_update_dpp(0, __builtin_bit_cast(int, v), 0x141, 0xf, 0xf, false));
    v += __builtin_bit_cast(float, __builtin_amdgcn_update_dpp(0, __builtin_bit_cast(int, v), 0xB1, 0xf, 0xf, false));
    v += __builtin_bit_cast(float, __builtin_amdgcn_update_dpp(0, __builtin_bit_cast(int, v), 0x4E, 0xf, 0xf, false));
    return v;
}
__device__ __forceinline__ void scan_unit_l8(const Args& A, int u, RW_LAS unsigned char* lds) {
    const int tid = tid_now(), lane = tid & 63; const int wid = __builtin_amdgcn_readfirstlane(tid >> 6);
    const int b = u >> 4, h = (u >> 1) & 7, half = u & 1; const size_t rowbase = (size_t)b * SEQ; const int hc = h * 64, vcb = h * 64 + half * 32;
    RW_LAS float* STG = (RW_LAS float*)(lds + L_STG); RW_LAS float* VST = (RW_LAS float*)(lds + L_VST);
    RW_LAS float* WS = (RW_LAS float*)(lds + L_WS); RW_LAS float* AS = (RW_LAS float*)(lds + L_AS);
    RW_LAS bf16* WUT = (RW_LAS bf16*)(lds + L_WUT); RW_LAS bf16* AUT = (RW_LAS bf16*)(lds + L_AUT); RW_LAS bf16* GUT = (RW_LAS bf16*)(lds + L_GUT); RW_LAS bf16* VUT = (RW_LAS bf16*)(lds + L_VUT);
    for (int idx = tid; idx < 4096; idx += NT) { const int k = idx >> 6, n = idx & 63;
        WUT[n * SXW + k] = cvt_1(A.w_up[(size_t)k * 512 + hc + n]); AUT[n * SXW + k] = cvt_1(A.a_up[(size_t)k * 512 + hc + n]); }
    for (int idx = tid; idx < 4096; idx += NT) { const int k = idx >> 5, n = idx & 31; GUT[n * SXG + k] = cvt_1(A.g_up[(size_t)k * 512 + vcb + n]); }
    if (A.layer > 0) for (int idx = tid; idx < 1024; idx += NT) { const int k = idx >> 5, n = idx & 31; VUT[n * SXV + k] = cvt_1(A.v_up[(size_t)k * 512 + vcb + n]); }
    RW_BAR();
    const int fr = lane & 15, fq = lane >> 4;
    if (wid >= 4) {
        const int pw = wid - 4, ptid = tid - 256, q = ptid & 15, k4 = 4 * q, rt = pw & 1, cth = pw >> 1;
        const f4 c_kk = *(const f4*)(A.k_k + hc + k4), c_ka = *(const f4*)(A.k_a + hc + k4), c_rk = *(const f4*)(A.r_k + hc + k4);
        const f4 mu_r = *(const f4*)(A.mu + hc + k4), mu_k = *(const f4*)(A.mu + 512 + hc + k4);
        const int vvc = cth * 16 + fr, vcol = 1024 + vcb + vvc; const float muv = A.mu[vcol], v0c = (A.layer > 0) ? A.v0[vcb + vvc] : 0.f;
        const int ch0 = cth * 16 + fr, ch1 = ch0 + 32; const float w0c0 = A.w0[hc + ch0], a0c0 = A.a0[hc + ch0], w0c1 = A.w0[hc + ch1], a0c1 = A.a0[hc + ch1];
        bf16x8 la0, la1, la2, la3, lg0, lg1, lg2, lg3, lv; u2 rc0, kc0, rp0, kp0, rc1, kc1, rp1, kp1; unsigned short vb0, vb1, vb2, vb3, vb4, vf0, vf1, vf2, vf3;
        auto load_raw = [&](int t0) {
            const bf16* lp = A.LIN + (rowbase + t0 + rt * 16 + fr) * LINC + fq * 8;
            la0 = *(const bf16x8*)(lp); la1 = *(const bf16x8*)(lp + 32); la2 = *(const bf16x8*)(lp + 64); la3 = *(const bf16x8*)(lp + 96);
            lg0 = *(const bf16x8*)(lp + 128); lg1 = *(const bf16x8*)(lp + 160); lg2 = *(const bf16x8*)(lp + 192); lg3 = *(const bf16x8*)(lp + 224); lv = *(const bf16x8*)(lp + 256);
            { const int tq = ptid >> 4; const size_t row = rowbase + t0 + tq; const size_t prow = (t0 + tq > 0) ? row - 1 : row; const bool z_ = (t0 + tq == 0);
              rc0 = *(const u2*)(A.URW + row * RWC + hc + k4); kc0 = *(const u2*)(A.URW + row * RWC + 512 + hc + k4);
              const u2 rp_ = *(const u2*)(A.URW + prow * RWC + hc + k4), kp_ = *(const u2*)(A.URW + prow * RWC + 512 + hc + k4);
              rp0 = (u2){z_ ? 0u : rp_.x, z_ ? 0u : rp_.y}; kp0 = (u2){z_ ? 0u : kp_.x, z_ ? 0u : kp_.y};
              rc1 = *(const u2*)(A.URW + (row + 16) * RWC + hc + k4); kc1 = *(const u2*)(A.URW + (row + 16) * RWC + 512 + hc + k4);
              rp1 = *(const u2*)(A.URW + (row + 15) * RWC + hc + k4); kp1 = *(const u2*)(A.URW + (row + 15) * RWC + 512 + hc + k4); }
            { const int tb = rt * 16 + fq * 4; const size_t row = rowbase + t0 + tb; const size_t prow = (t0 + tb > 0) ? row - 1 : row;
              { const unsigned short v_ = A.URW[prow * RWC + vcol]; vb0 = (t0 + tb == 0) ? (unsigned short)0 : v_; }
              vb1 = A.URW[(row + 0) * RWC + vcol]; vb2 = A.URW[(row + 1) * RWC + vcol]; vb3 = A.URW[(row + 2) * RWC + vcol]; vb4 = A.URW[(row + 3) * RWC + vcol];
              const bf16* fp = (A.layer > 0) ? A.VFIRST + row * 512 + vcb + vvc : A.URW + row * RWC + vcol; const int fs = (A.layer > 0) ? 512 : RWC;
              vf0 = fp[0]; vf1 = fp[fs]; vf2 = fp[2 * fs]; vf3 = fp[3 * fs]; }
        };
        auto prepB = [&](int t0, int nb) {
            RW_LAS float* VSTw = VST + nb * 1024;
            { f4 aw0 = (f4){0.f, 0.f, 0.f, 0.f}, aa0 = aw0, aw1 = aw0, aa1 = aw0;
              { const RW_LAS bf16* wp = WUT + ch0 * SXW + fq * 8; const RW_LAS bf16* ap = AUT + ch0 * SXW + fq * 8;
                aw0 = __builtin_amdgcn_mfma_f32_16x16x32_bf16(la0, *(const RW_LAS bf16x8*)(wp), aw0, 0, 0, 0); aw0 = __builtin_amdgcn_mfma_f32_16x16x32_bf16(la1, *(const RW_LAS bf16x8*)(wp + 32), aw0, 0, 0, 0);
                aa0 = __builtin_amdgcn_mfma_f32_16x16x32_bf16(la2, *(const RW_LAS bf16x8*)(ap), aa0, 0, 0, 0); aa0 = __builtin_amdgcn_mfma_f32_16x16x32_bf16(la3, *(const RW_LAS bf16x8*)(ap + 32), aa0, 0, 0, 0);
                aw1 = __builtin_amdgcn_mfma_f32_16x16x32_bf16(la0, *(const RW_LAS bf16x8*)(wp + 32 * SXW), aw1, 0, 0, 0); aw1 = __builtin_amdgcn_mfma_f32_16x16x32_bf16(la1, *(const RW_LAS bf16x8*)(wp + 32 * SXW + 32), aw1, 0, 0, 0);
                aa1 = __builtin_amdgcn_mfma_f32_16x16x32_bf16(la2, *(const RW_LAS bf16x8*)(ap + 32 * SXW), aa1, 0, 0, 0); aa1 = __builtin_amdgcn_mfma_f32_16x16x32_bf16(la3, *(const RW_LAS bf16x8*)(ap + 32 * SXW + 32), aa1, 0, 0, 0); }
#pragma unroll
              for (int j = 0; j < 4; ++j) { const int tok = rt * 16 + fq * 4 + j;
                  WS[tok * 64 + ch0] = __builtin_amdgcn_exp2f(-0.8750404f * fsig(w0c0 + aw0[j])); AS[tok * 64 + ch0] = fsig(a0c0 + aa0[j]);
                  WS[tok * 64 + ch1] = __builtin_amdgcn_exp2f(-0.8750404f * fsig(w0c1 + aw1[j])); AS[tok * 64 + ch1] = fsig(a0c1 + aa1[j]); } }
            { f4 ag = (f4){0.f, 0.f, 0.f, 0.f}; const RW_LAS bf16* gp_ = GUT + vvc * SXG + fq * 8;
              ag = __builtin_amdgcn_mfma_f32_16x16x32_bf16(lg0, *(const RW_LAS bf16x8*)(gp_), ag, 0, 0, 0); ag = __builtin_amdgcn_mfma_f32_16x16x32_bf16(lg1, *(const RW_LAS bf16x8*)(gp_ + 32), ag, 0, 0, 0);
              ag = __builtin_amdgcn_mfma_f32_16x16x32_bf16(lg2, *(const RW_LAS bf16x8*)(gp_ + 64), ag, 0, 0, 0); ag = __builtin_amdgcn_mfma_f32_16x16x32_bf16(lg3, *(const RW_LAS bf16x8*)(gp_ + 96), ag, 0, 0, 0);
#pragma unroll
              for (int j = 0; j < 4; ++j) A.G[(rowbase + t0 + rt * 16 + fq * 4 + j) * 512 + vcb + vvc] = cvt_1(ag[j]); }
            { f4 av = (f4){0.f, 0.f, 0.f, 0.f};
              if (A.layer > 0) av = __builtin_amdgcn_mfma_f32_16x16x32_bf16(lv, *(const RW_LAS bf16x8*)(VUT + vvc * SXV + fq * 8), av, 0, 0, 0);
              const unsigned short vbs[5] = {vb0, vb1, vb2, vb3, vb4}; const unsigned short vfs[4] = {vf0, vf1, vf2, vf3};
#pragma unroll
              for (int j = 0; j < 4; ++j) { const int tok = rt * 16 + fq * 4 + j; const size_t row = rowbase + t0 + tok;
                  const float cur = bf1(vbs[1 + j]), prv = bf1(vbs[j]); float v = cur + muv * (prv - cur);
                  if (A.layer == 0) A.VFIRST[row * 512 + vcb + vvc] = cvt_1(v);
                  else { const float vf = bf1(vfs[j]), vg = fsig(v0c + av[j]); v = v + (vf - v) * vg; }
                  VSTw[tok * 32 + vvc] = v; } }
        };
        auto prepC = [&](int t0, int nb) {
            RW_LAS float* VSTw = VST + nb * 1024;
#pragma unroll
            for (int pass = 0; pass < 2; ++pass) { const int tq = (ptid >> 4) + 16 * pass; const size_t row = rowbase + t0 + tq;
                const u2 rc = pass ? rc1 : rc0, kc = pass ? kc1 : kc0, rp = pass ? rp1 : rp0, kp = pass ? kp1 : kp0; f4 r, k;
                r[0] = bfl(rc.x) + mu_r[0] * (bfl(rp.x) - bfl(rc.x)); r[1] = bfh(rc.x) + mu_r[1] * (bfh(rp.x) - bfh(rc.x)); r[2] = bfl(rc.y) + mu_r[2] * (bfl(rp.y) - bfl(rc.y)); r[3] = bfh(rc.y) + mu_r[3] * (bfh(rp.y) - bfh(rc.y));
                k[0] = bfl(kc.x) + mu_k[0] * (bfl(kp.x) - bfl(kc.x)); k[1] = bfh(kc.x) + mu_k[1] * (bfh(kp.x) - bfh(kc.x)); k[2] = bfl(kc.y) + mu_k[2] * (bfl(kp.y) - bfl(kc.y)); k[3] = bfh(kc.y) + mu_k[3] * (bfh(kp.y) - bfh(kc.y));
                const f4 a = *(const RW_LAS f4*)(AS + tq * 64 + k4), w = *(const RW_LAS f4*)(WS + tq * 64 + k4);
                f4 kk = k * c_kk; const float n2 = row16_sum(kk[0] * kk[0] + kk[1] * kk[1] + kk[2] * kk[2] + kk[3] * kk[3]);
                const float inv = fminf(__builtin_amdgcn_rsqf(n2), 1e12f); kk = kk * inv;
                const f4 bb = kk * a; f4 ke;
#pragma unroll
                for (int e = 0; e < 4; ++e) ke[e] = k[e] * (1.f + (a[e] - 1.f) * c_ka[e]);
                const float bon = row16_sum(r[0] * ke[0] * c_rk[0] + r[1] * ke[1] * c_rk[1] + r[2] * ke[2] * c_rk[2] + r[3] * ke[3] * c_rk[3]);
                RW_LAS float* sp = STG + nb * 10240 + tq * 320 + k4;
                *(RW_LAS f4*)(sp) = r; *(RW_LAS f4*)(sp + 64) = w; *(RW_LAS f4*)(sp + 128) = ke; *(RW_LAS f4*)(sp + 192) = kk; *(RW_LAS f4*)(sp + 256) = bb;
                const float v0 = VSTw[tq * 32 + 2 * q], v1 = VSTw[tq * 32 + 2 * q + 1];
                *(unsigned*)(A.BV + row * 512 + vcb + 2 * q) = cvt_pk(bon * v0, bon * v1); }
        };
        load_raw(0);
#pragma unroll 1
        for (int t0 = -CH; t0 < SEQ; t0 += CH) { const bool has_next = t0 + CH < SEQ; const int nb = ((t0 >> 5) + 1) & 1;
            if (has_next) prepB(t0 + CH, nb);
            RW_BAR();
            if (has_next) { prepC(t0 + CH, nb); if (t0 + 2 * CH < SEQ) load_raw(t0 + 2 * CH); }
            RW_BAR(); }
    } else {
        const int q8 = lane & 7, rho = wid * 8 + (lane >> 3), k8 = 8 * q8;
        typedef float f2 __attribute__((ext_vector_type(2)));
        f2 S0 = (f2){0.f, 0.f}, S1 = S0, S2 = S0, S3 = S0;
#define LO2(v_) __builtin_shufflevector(v_, v_, 0, 1)
#define HI2(v_) __builtin_shufflevector(v_, v_, 2, 3)
        RW_BAR(); RW_BAR();
        for (int t0 = 0; t0 < SEQ; t0 += CH) { const int cb = (t0 >> 5) & 1;
            float o0 = 0.f, o1 = 0.f, o2 = 0.f, o3 = 0.f;
            const RW_LAS float* sp = STG + cb * 10240 + k8; const RW_LAS float* vp = VST + cb * 1024 + rho;
            f4 ra = *(const RW_LAS f4*)(sp), rb = *(const RW_LAS f4*)(sp + 4), wa = *(const RW_LAS f4*)(sp + 64), wb = *(const RW_LAS f4*)(sp + 68), kea = *(const RW_LAS f4*)(sp + 128), keb = *(const RW_LAS f4*)(sp + 132),
               kka = *(const RW_LAS f4*)(sp + 192), kkb = *(const RW_LAS f4*)(sp + 196), bba = *(const RW_LAS f4*)(sp + 256), bbb = *(const RW_LAS f4*)(sp + 260); float v = vp[0];
#pragma unroll
            for (int t = 0; t < CH; ++t) {
                if (t == 16) RW_BAR();
                f4 ran = ra, rbn = rb, wan = wa, wbn = wb, kean = kea, kebn = keb, kkan = kka, kkbn = kkb, bban = bba, bbbn = bbb; float vn = v;
                if (t + 1 < CH) { const RW_LAS float* sn = sp + (t + 1) * 320; ran = *(const RW_LAS f4*)(sn); rbn = *(const RW_LAS f4*)(sn + 4); wan = *(const RW_LAS f4*)(sn + 64); wbn = *(const RW_LAS f4*)(sn + 68);
                    kean = *(const RW_LAS f4*)(sn + 128); kebn = *(const RW_LAS f4*)(sn + 132); kkan = *(const RW_LAS f4*)(sn + 192); kkbn = *(const RW_LAS f4*)(sn + 196); bban = *(const RW_LAS f4*)(sn + 256); bbbn = *(const RW_LAS f4*)(sn + 260);
                    vn = vp[(t + 1) * 32]; }
                f2 dA = S0 * LO2(kka); dA = S1 * HI2(kka) + dA; f2 dB = S2 * LO2(kkb); dB = S3 * HI2(kkb) + dB; const f2 d2 = dA + dB;
                const f2 Sw0 = S0 * LO2(wa) + LO2(kea) * v, Sw1 = S1 * HI2(wa) + HI2(kea) * v, Sw2 = S2 * LO2(wb) + LO2(keb) * v, Sw3 = S3 * HI2(wb) + HI2(keb) * v;
                const float sum = half8_sum(d2.x + d2.y);
                S0 = Sw0 - LO2(bba) * sum; S1 = Sw1 - HI2(bba) * sum; S2 = Sw2 - LO2(bbb) * sum; S3 = Sw3 - HI2(bbb) * sum;
                f2 eA = S0 * LO2(ra); eA = S1 * HI2(ra) + eA; f2 eB = S2 * LO2(rb); eB = S3 * HI2(rb) + eB; const f2 e2 = eA + eB;
                const float ov = half8_sum(e2.x + e2.y);
                if (t < 8) o0 = (q8 == t) ? ov : o0; else if (t < 16) o1 = (q8 == t - 8) ? ov : o1; else if (t < 24) o2 = (q8 == t - 16) ? ov : o2; else o3 = (q8 == t - 24) ? ov : o3;
                ra = ran; rb = rbn; wa = wan; wb = wbn; kea = kean; keb = kebn; kka = kkan; kkb = kkbn; bba = bban; bbb = bbbn; v = vn; }
            { bf16* op = A.ORW + (rowbase + t0 + q8) * 512 + vcb + rho; op[0] = cvt_1(o0); op[8 * 512] = cvt_1(o1); op[16 * 512] = cvt_1(o2); op[24 * 512] = cvt_1(o3); }
            RW_BAR();
        }
    }
}
__device__ __forceinline__ void post_phase(const Frame& F, bf16* ORW, const bf16* G, const bf16* BV, const float* lw, const float* lb) {
    const int tid = tid_now(); const int q = tid & 7, grp = (F.bid * NT + tid) >> 3, ngrp = (F.G * NT) >> 3;
    for (int it = grp; it < M * 8; it += 2 * ngrp) { const int it2 = it + ngrp; const bool two = it2 < M * 8;
        const size_t offa = (size_t)(it >> 3) * 512 + (it & 7) * 64 + 8 * q, offb = two ? (size_t)(it2 >> 3) * 512 + (it2 & 7) * 64 + 8 * q : offa;
        const u4 ova = *(const u4*)(ORW + offa), gva = *(const u4*)(G + offa), bva = *(const u4*)(BV + offa);
        const u4 ovb = *(const u4*)(ORW + offb), gvb = *(const u4*)(G + offb), bvb = *(const u4*)(BV + offb);
#pragma unroll
        for (int h = 0; h < 2; ++h) { const u4 ov = h ? ovb : ova, gv = h ? gvb : gva, bv = h ? bvb : bva; const int ih = h ? it2 : it; const size_t off = h ? offb : offa;
            f4 o0 = (f4){bfl(ov.x), bfh(ov.x), bfl(ov.y), bfh(ov.y)}, o1 = (f4){bfl(ov.z), bfh(ov.z), bfl(ov.w), bfh(ov.w)};
            const float mean = half8_sum((o0[0] + o0[1] + o0[2] + o0[3]) + (o1[0] + o1[1] + o1[2] + o1[3])) * (1.f / 64.f); o0 = o0 - mean; o1 = o1 - mean;
            const float var = half8_sum((o0[0] * o0[0] + o0[1] * o0[1] + o0[2] * o0[2] + o0[3] * o0[3]) + (o1[0] * o1[0] + o1[1] * o1[1] + o1[2] * o1[2] + o1[3] * o1[3])) * (1.f / 64.f);
            const float rs = __builtin_amdgcn_rsqf(var + 64e-5f);
            const int c = (ih & 7) * 64 + 8 * q; const f4 w0 = *(const f4*)(lw + c), w1 = *(const f4*)(lw + c + 4), b0 = *(const f4*)(lb + c), b1 = *(const f4*)(lb + c + 4);
            f4 r0 = o0 * rs * w0 + b0 + (f4){bfl(bv.x), bfh(bv.x), bfl(bv.y), bfh(bv.y)}, r1 = o1 * rs * w1 + b1 + (f4){bfl(bv.z), bfh(bv.z), bfl(bv.w), bfh(bv.w)};
            r0 = r0 * (f4){bfl(gv.x), bfh(gv.x), bfl(gv.y), bfh(gv.y)}; r1 = r1 * (f4){bfl(gv.z), bfh(gv.z), bfl(gv.w), bfh(gv.w)};
            if (h == 0 || two) *(u4*)(ORW + off) = (u4){cvt_pk(r0[0], r0[1]), cvt_pk(r0[2], r0[3]), cvt_pk(r1[0], r1[1]), cvt_pk(r1[2], r1[3])}; }
    }
}
}
#ifndef EN_P0
#define EN_P0 1
#endif
#ifndef EN_G1
#define EN_G1 1
#endif
#ifndef EN_SCAN
#define EN_SCAN 1
#endif
#ifndef EN_ATTN
#define EN_ATTN 1
#endif
#ifndef EN_P3
#define EN_P3 1
#endif
#ifndef EN_P4
#define EN_P4 1
#endif
#ifndef EN_REST
#define EN_REST 255
#endif
#ifndef EN_XATTN
#define EN_XATTN 1
#endif
__device__ __forceinline__ int opaque1(int v) { asm volatile("" : "+s"(v)); return v; }
#ifndef DUPMASK
#define DUPMASK 0
#endif
#define REP(bit) for (int rep_ = 0; rep_ < (((DUPMASK >> (bit)) & 1) ? opaque1(2) : 1); ++rep_)
#ifndef STOP_AFTER
#define STOP_AFTER 1000
#endif
#ifndef DIAG_BIN
#define DIAG_BIN 10.f
#endif
#ifndef DIAG_OFF
#define DIAG_OFF 0.f
#endif
#ifdef DIAG_PHASE
#define TSTAMP() do { if (F.bid == 0 && threadIdx.x == 0) ((volatile LAS unsigned long long*)(F.lds + LDSCTL_OFF + 512))[phase_no] = __builtin_amdgcn_s_memrealtime(); } while (0)
#else
#define TSTAMP() do {} while (0)
#endif
__device__ __forceinline__ CvItem tail_item(const Params& P, int l, int it, bf16* wbr, bf16* wout, bf16* wxq, bf16* wkv) {
    CvItem c;
    if (it < 768) { const int n = it >> 8, r = it & 255; c.W = P.in[27] + ((size_t)l * 3 + n) * 512 * DM; c.ldw = DM; c.K = 512; c.gain = nullptr; c.WT = wbr + (size_t)n * DM * 512; c.roff = 0; c.kb = r >> 5; c.nb = r & 31; }
    else if (it < 1280) { const int r = it - 768; c.W = P.in[28] + (size_t)l * DM * DM; c.ldw = DM; c.K = DM; c.gain = nullptr; c.WT = wout; c.roff = 0; c.kb = r >> 5; c.nb = r & 31; }
    else if (it < 1536) { const int r = it - 1280; c.W = P.in[29] + (size_t)l * DM * 512; c.ldw = 512; c.K = DM; c.gain = P.in[5] + l * DM; c.WT = wxq; c.roff = 0; c.kb = r >> 4; c.nb = r & 15; }
    else if (it < 1792) { const int r = it - 1536; c.W = P.in[30] + (size_t)l * DM * 512; c.ldw = 512; c.K = DM; c.gain = P.in[7] + l * DM; c.WT = wkv; c.roff = 0; c.kb = r >> 4; c.nb = r & 15; }
    else { const int r = it - 1792; c.W = P.in[31] + (size_t)l * DM * 512; c.ldw = 512; c.K = DM; c.gain = P.in[7] + l * DM; c.WT = wkv; c.roff = 512; c.kb = r >> 4; c.nb = r & 15; }
    return c;
}
__device__ __forceinline__ int in_items(int l) { return 3584 + (l > 0 ? 16 : 0); }
__device__ __forceinline__ CvItem in_item(const Params& P, int l, int it, bf16* wa, bf16* wab, bf16* wg) {
    CvItem c; c.ldw = INC; c.K = DM; c.gain = P.in[3] + l * DM; c.roff = 0; const float* W = P.in[10] + (size_t)l * DM * INC;
    if (it < 1536) { c.W = W; c.WT = wa; c.rmode = 1; c.kb = it / 96; c.nb = it - c.kb * 96; }
    else if (it < 2048) { const int r = it - 1536; c.W = W + PA_COLS; c.WT = wab; c.rmode = 2; c.kb = r >> 5; c.nb = r & 31; }
    else if (it < 3584) { const int r = it - 2048; c.W = W + 4096; c.WT = wg; c.rmode = 0; c.kb = r / 96; c.nb = r - c.kb * 96; }
    else { const int r = it - 3584; c.W = P.in[22]; c.ldw = 32; c.WT = wab; c.rmode = 0; c.roff = 4096 - PA_COLS; c.kb = r; c.nb = 0; }
    return c;
}
__device__ __forceinline__ CvItem late_item(const Params& P, int l, int it, bf16* wxo, bf16* wup, bf16* wdn) {
    CvItem c; c.roff = 0; c.rmode = 0;
    if (it < 256) { c.W = P.in[32] + (size_t)l * 512 * DM; c.ldw = DM; c.K = 512; c.gain = nullptr; c.WT = wxo; c.kb = it >> 5; c.nb = it & 31; }
    else if (it < 2304) { const int r = it - 256; c.W = P.in[33] + (size_t)l * DM * FFD; c.ldw = FFD; c.K = DM; c.gain = P.in[8] + l * DM; c.WT = wup; c.kb = r >> 7; c.nb = r & 127; }
    else { const int r = it - 2304; c.W = P.in[34] + (size_t)l * FFD * DM; c.ldw = DM; c.K = FFD; c.gain = nullptr; c.WT = wdn; c.kb = r >> 5; c.nb = r & 31; }
    return c;
}
__global__ void __launch_bounds__(NT, 2) fwd_megakernel(Params P) {
    extern __shared__ __attribute__((aligned(16))) unsigned char lds_raw[];
    Frame F; F.lds = (LAS unsigned char*)lds_raw; F.wave = __builtin_amdgcn_readfirstlane(threadIdx.x >> 6); F.G = gridDim.x; F.bid = blockIdx.x;
    unsigned char* ws = P.ws;
    volatile LAS unsigned* MISC = (volatile LAS unsigned*)(F.lds + MISC_OFF);
    for (int u = threadIdx.x; u < (LDS_BYTES - LDSCTL_OFF) / 4; u += NT) ((LAS unsigned*)(F.lds + LDSCTL_OFF))[u] = 0u;
    __syncthreads();
    XcdBarrier bar = xcd_barrier_post((unsigned*)(ws + WS_CTL) + CW_BAR, MISC + 8);
    int phase_no = 0; TSTAMP();
#define GRID_BAR() do { XcdBarrier b2_ = bar; asm volatile("" : "+s"(b2_.bar), "+s"(b2_.x)); xcd_barrier(b2_); ++phase_no; TSTAMP(); } while (0)
#define XN ((bf16*)(ws + WS_XN))
#define URW ((bf16*)(ws + WS_URW))
#define MQ ((bf16*)(ws + WS_MQ))
#define MK ((bf16*)(ws + WS_MK))
#define MV ((bf16*)(ws + WS_MV))
#define SQ ((bf16*)(ws + WS_SQ))
#define SK ((bf16*)(ws + WS_SK))
#define SV ((bf16*)(ws + WS_SV))
#define ORW ((bf16*)(ws + WS_ORW))
#define VM ((bf16*)(ws + WS_VM))
#define GATE ((bf16*)(ws + WS_GATE))
#define ZB ((bf16*)(P.out))
#define RS ((float*)(ws + WS_RS))
#define Y ((bf16*)(ws + WS_Y))
#define Y2 ((bf16*)(ws + WS_MQ))
#define QX ((bf16*)(ws + WS_QX))
#define HMID ((bf16*)(ws + WS_HMID))
#define WA ((bf16*)(ws + WS_WA))
#define WAB ((bf16*)(ws + WS_WAB))
#define WG ((bf16*)(ws + WS_WG))
#define WBR ((bf16*)(ws + WS_WBR))
#define WOUT ((bf16*)(ws + WS_WOUT))
#define WXQ ((bf16*)(ws + WS_WXQ))
#define WXO ((bf16*)(ws + WS_WXO))
#define WUP ((bf16*)(ws + WS_WUP))
#define WDN ((bf16*)(ws + WS_WDN))
#define MN ((bf16*)((unsigned char*)P.out + 32 * MiB))
#define WKV ((bf16*)((unsigned char*)P.out + 36 * MiB))
#define VFIRST ((bf16*)(ws + WS_VFIRST))
#define LINB ((bf16*)(ws + WS_WA))
#define GB ((bf16*)(ws + WS_G))
#define BVB ((bf16*)(ws + WS_BV))
#define KM ((float*)(ws + WS_KM))
#define ROPE ((float*)(ws + WS_ROPE))
    const int gw = F.bid * NWAVES + F.wave, NGW = F.G * NWAVES, GT = F.G * NT;
#define gtid (F.bid * NT + tid_now())

#define CONV_WA(l) do { convert_matrix(F, P.in[10] + (size_t)(l) * DM * INC, INC, 0, DM, PA_COLS, P.in[3] + (l) * DM, WA, MapWA{}); \
        convert_matrix(F, P.in[10] + (size_t)(l) * DM * INC, INC, PA_COLS, DM, 4096 - PA_COLS, P.in[3] + (l) * DM, WAB, MapWAB{}); \
        if ((l) > 0) convert_matrix(F, P.in[22], 32, 0, DM, 32, P.in[3] + (l) * DM, WAB, MapId{4096 - PA_COLS}); } while (0)
#define CONV_WG(l) convert_matrix(F, P.in[10] + (size_t)(l) * DM * INC, INC, 4096, DM, 3072, P.in[3] + (l) * DM, WG, MapId{0})

    if (EN_P0) REP(0) {
        const int lane0 = tid_now() & 63;
        for (int r = gw; r < M; r += 4 * NGW) norm_rows4_to_bf16(P.in[0], XN, RS, r, NGW, M, lane0);
        { const int* pos = (const int*)P.in[2];
          for (int i = gtid; i < M * 32; i += GT) { const int t = i >> 5, f = i & 31;
              const float invf = __builtin_amdgcn_exp2f(-(float)f * 0.41524101186092029f);
              const float ang = (float)pos[t] * invf; float rev = ang * 0.15915494309189535f; rev -= floorf(rev);
              ROPE[2 * i] = __builtin_amdgcn_cosf(rev); ROPE[2 * i + 1] = __builtin_amdgcn_sinf(rev); } }
        { const int g0_ = gtid;
#pragma unroll
          for (int k_ = 0; k_ < 4; ++k_) { const int i = g0_ + k_ * GT; if (i < 64 * 512) KM[i] = 0.f; } }
        { LAS float* scr = (LAS float*)(F.lds + F.wave * 16384); const int lane = tid_now() & 63, tot = in_items(0);
          for (int it = gw; it < tot; it += 2 * NGW) { const int it2 = it + NGW; const bool has2 = it2 < tot;
              const CvItem c1 = in_item(P, 0, it, WA, WAB, WG), c2 = in_item(P, 0, has2 ? it2 : it, WA, WAB, WG); transpose_pair(c1, c2, has2, scr, lane); } }
        { const int lane1 = tid_now() & 63; for (int r = gw; r < MM; r += NGW) norm_row_to_bf16(P.in[1] + (size_t)r * DM, MN + (size_t)r * DM, lane1); }
    }
    GRID_BAR();
    for (int l = 0; l < 2; ++l) {
        if (EN_G1) REP(1) {
          pg8::Gemm g{XN, WA, M, PA_COLS, DM}; pg8::StaticOrder S; S.init(M, PA_COLS, F.G, F.bid);
          pg8::EpiG1 E{ws, QS64, 0};
          pg8::gemm_phase<pg8::EpiG1, pg8::StaticOrder, true, true>(F.lds, g, S, E);
          if (l > 0) vm_phase(F, XN, WAB + (size_t)(4096 - PA_COLS) * DM, VM); }
        GRID_BAR();
        REP(10) rw::lin_phase(F, URW, VM, P.in[11] + l * RWC, P.in[23], l, LINB);
        GRID_BAR();
        { const int nS = F.G >> 1, nA = F.G - nS;
          if (F.bid < nS) {
            if (EN_SCAN) for (int gidx = F.bid; gidx < 128; gidx += nS) {
                rw::Args A{URW, LINB, VFIRST, ORW, GB, BVB, P.in[11] + l * RWC, P.in[12] + l * 512, P.in[13] + (size_t)l * 64 * 512, P.in[14] + l * 512, P.in[15] + (size_t)l * 64 * 512,
                           P.in[16] + (size_t)l * 128 * 512, P.in[17] + l * 512, P.in[18] + l * 512, P.in[19] + l * 512, P.in[23], P.in[24], P.in[25], l};
#ifdef SCAN_L8
                rw::scan_unit_l8(A, gidx, (RW_LAS unsigned char*)F.lds);
#else
                rw::scan_unit(A, gidx, (RW_LAS unsigned char*)F.lds);
#endif
            }
          } else {
            const int ia = F.bid - nS;
            { pg8::Gemm g{XN, WAB, M, 4096 - PA_COLS, DM}; pg8::StaticOrder S; S.init(M, 4096 - PA_COLS, nA, ia);
              pg8::EpiG1 E{ws, QS64, PA_COLS / 256};
              pg8::gemm_phase<pg8::EpiG1, pg8::StaticOrder, true, true>(F.lds, g, S, E); }
            sub_barrier((unsigned*)(ws + WS_CTL) + 512 + 64 * l, (unsigned)nA);
            if (EN_ATTN) for (int j = ia; j < 128; j += nA) {
                const int bh = j & 63, par = j >> 6, b = bh >> 3, h = bh & 7;
                for (int i = 0; i < 4; ++i) {
                    const int qb = par == 0 ? (i == 0 ? 7 : i == 1 ? 4 : i == 2 ? 3 : 0) : (i == 0 ? 6 : i == 1 ? 5 : i == 2 ? 2 : 1);
                    const size_t rb = (size_t)b * SEQ;
                    at::Ten T{MQ + rb * 512 + h * 64, 512, MK + rb * 512 + h * 64, MV + rb * 512 + h * 64, 512, MQ + rb * 512 + h * 64, 512};
                    at::attn_unit<64, 0>(T, qb * 256, 0, 0, 0.f, KM + (size_t)b * 8 * 512 + h * 64, (at::lds_ptr)F.lds);
                }
                for (int i = 0; i < 4; ++i) {
                    const int un = j * 4 + i, qb = un & 7, hq = (un >> 3) & 7, b2 = un >> 6; const size_t rb = (size_t)b2 * SEQ;
                    at::Ten T{SQ + rb * 512 + hq * 64, 512, SK + rb * 128 + (hq >> 2) * 64, SV + rb * 128 + (hq >> 2) * 64, 128, SQ + rb * 512 + hq * 64, 512};
                    const int kt0 = qb == 0 ? 0 : 4 * qb - 2, ntl = 4 * qb + 4 - kt0;
                    at::attn_unit<64, 1>(T, qb * 256, kt0, ntl, P.in[26][l * 8 + hq] * LOG2E, nullptr, (at::lds_ptr)F.lds);
                }
            }
            { LAS float* scr = (LAS float*)(F.lds + F.wave * 16384); const int lane = tid_now() & 63, nw = nA * NWAVES;
              for (int it = ia * NWAVES + F.wave; it < 2048; it += 2 * nw) { const int it2 = it + nw; const bool has2 = it2 < 2048;
                  const CvItem c1 = tail_item(P, l, it, WBR, WOUT, WXQ, WKV), c2 = tail_item(P, l, has2 ? it2 : it, WBR, WOUT, WXQ, WKV);
                  transpose_pair(c1, c2, has2, scr, lane); } }
          } }
        GRID_BAR();
        if (EN_P3) { pg8::Gemm g{XN, WG, M, 3072, DM}; pg8::StaticOrder S; S.init(M, 3072, F.G, F.bid);
          pg8::EpiStore<2> E{GATE, 3072, 1.f};
          REP(2) pg8::gemm_phase<pg8::EpiStore<2>, pg8::StaticOrder, true, true>(F.lds, g, S, E);
          rw::post_phase(F, ORW, GB, BVB, P.in[20] + l * 512, P.in[21] + l * 512);
          { const int g0_ = gtid;
#pragma unroll
          for (int k_ = 0; k_ < 4; ++k_) { const int i = g0_ + k_ * GT; if (i < 64 * 512) KM[i] = 0.f; } }     }
        GRID_BAR();
        if (EN_P4) { { pg8::Gemm g{MQ, WBR, 3 * M, 3072, 512}; pg8::ThreePassOrder S; S.init(M, F.G, F.bid);
              pg8::EpiZ3 E{ZB, GATE, (bf16*)(ws + WS_G)};
              pg8::gemm_phase<pg8::EpiZ3, pg8::ThreePassOrder, true, true>(F.lds, g, S, E); }
 }
        GRID_BAR();
        if (EN_REST & 1) {
          if (F.G == 256) {
            pg8::Gemm g{ZB, WOUT, M, DM, DM}; pg8::StaticOrder S; S.init(M, DM, F.G, F.bid);
            pg8::PanelRms s1{(unsigned*)(ws + WS_XB), (unsigned)(l * 6 + 0 + 1)}, s2{(unsigned*)(ws + WS_XB + 512 * 1024), (unsigned)(l * 6 + 1 + 1)};
            pg8::EpiRmsResRms E{XN, RS, nullptr, P.in[4] + l * DM, s1, s2};
            pg8::gemm_phase<pg8::EpiRmsResRms, pg8::StaticOrder, false, true>(F.lds, g, S, E);
          } else {
            { pg8::Gemm g{ZB, WOUT, M, DM, DM}; pg8::StaticOrder S; S.init(M, DM, F.G, F.bid);
              pg8::EpiStore<0> E{Y, DM, 1.f};
              pg8::gemm_phase<pg8::EpiStore<0>, pg8::StaticOrder, true, true>(F.lds, g, S, E); }
            GRID_BAR();
            row_phase(F, XN, RS, Y, P.in[4] + l * DM, nullptr);
          } }
        GRID_BAR();
        if (EN_REST & 4) {
          pg8::Gemm g{XN, WXQ, M, 512, DM}; pg8::StaticOrder S; S.init(M, 512, F.G, F.bid);
          pg8::EpiStore<0> E{QX, 512, QS128};
          REP(5) pg8::gemm_phase<pg8::EpiStore<0>, pg8::StaticOrder, true, true>(F.lds, g, S, E);
          { pg8::Gemm g2{MN, WKV, MM, DM, DM}; pg8::StaticOrder S2; int c2 = F.bid + 128; if (c2 >= F.G) c2 -= F.G; S2.init(MM, DM, F.G, c2);
            pg8::EpiKV E2{(bf16*)(ws + WS_MEMKV), (bf16*)(ws + WS_MEMKV + 2 * MiB)};
            pg8::gemm_phase<pg8::EpiKV, pg8::StaticOrder, true, true>(F.lds, g2, S2, E2); }
          { const bool split = (F.G == 256); const int nlate = 4352, tot = nlate + (l == 0 ? in_items(1) : 0), nI = split ? (l == 0 ? 5800 : tot) : 0;
            int first, last, w0, nwv;
            if (split && F.bid >= 160) { first = 0; last = nI; w0 = (F.bid - 160) * NWAVES + F.wave; nwv = 96 * NWAVES; }
            else { first = nI; last = tot; w0 = F.bid * NWAVES + F.wave; nwv = (split ? 160 : F.G) * NWAVES; }
            LAS float* scr = (LAS float*)(F.lds + F.wave * 16384); const int lane = tid_now() & 63;
            for (int it = first + w0; it < last; it += 2 * nwv) { const int it2r = it + nwv; const bool has2 = it2r < last; const int it2 = has2 ? it2r : it;
                const CvItem c1 = (it < nlate) ? late_item(P, l, it, WXO, WUP, WDN) : in_item(P, 1, it - nlate, WA, WAB, WG);
                const CvItem c2 = (it2 < nlate) ? late_item(P, l, it2, WXO, WUP, WDN) : in_item(P, 1, it2 - nlate, WA, WAB, WG);
                transpose_pair(c1, c2, has2, scr, lane); } } }
        GRID_BAR();
        if (EN_XATTN) REP(9) for (int un = F.bid; un < 256; un += F.G) { const int qb = un & 7, h = (un >> 3) & 3, b = un >> 5;
            const bf16* Kx = (const bf16*)(ws + WS_MEMKV) + (size_t)b * MEMLEN * 512 + h * 128; const bf16* Vx = Kx + MiB;
            bf16* Odst = (((DUPMASK >> 9) & 1) && rep_ == 0) ? (bf16*)(ws + 152 * MiB) : QX;
            at::Ten T{QX + (size_t)b * SEQ * 512 + h * 128, 512, Kx, Vx, 512, Odst + (size_t)b * SEQ * 512 + h * 128, 512};
            at::attn_unit<128, 2>(T, qb * 256, 0, 4, 0.f, nullptr, (at::lds_ptr)F.lds); }
        GRID_BAR();
        if (EN_REST & 8) {
          if (F.G == 256) {
            pg8::Gemm g{QX, WXO, M, DM, 512}; pg8::StaticOrder S; S.init(M, DM, F.G, F.bid);
            pg8::PanelRms s1{(unsigned*)(ws + WS_XB), (unsigned)(l * 6 + 2 + 1)}, s2{(unsigned*)(ws + WS_XB + 512 * 1024), (unsigned)(l * 6 + 3 + 1)};
            pg8::EpiRmsResRms E{XN, RS, nullptr, P.in[6] + l * DM, s1, s2};
            pg8::gemm_phase<pg8::EpiRmsResRms, pg8::StaticOrder, false, true>(F.lds, g, S, E);
          } else {
            { pg8::Gemm g{QX, WXO, M, DM, 512}; pg8::StaticOrder S; S.init(M, DM, F.G, F.bid);
              pg8::EpiStore<0> E{Y, DM, 1.f};
              pg8::gemm_phase<pg8::EpiStore<0>, pg8::StaticOrder, true, true>(F.lds, g, S, E); }
            GRID_BAR();
            row_phase(F, XN, RS, Y, P.in[6] + l * DM, nullptr);
          } }
        GRID_BAR();
        if (EN_REST & 32) { pg8::Gemm g{XN, WUP, M, FFD, DM}; pg8::StaticOrder S; S.init(M, FFD, F.G, F.bid);
          pg8::EpiStore<1> E{HMID, FFD, 1.f};
          REP(7) pg8::gemm_phase<pg8::EpiStore<1>, pg8::StaticOrder, true, true>(F.lds, g, S, E); }
        GRID_BAR();
        if (EN_REST & 64) {
          if (F.G == 256) {
            pg8::Gemm g{HMID, WDN, M, DM, FFD}; pg8::StaticOrder S; S.init(M, DM, F.G, F.bid);
            pg8::PanelRms s1{(unsigned*)(ws + WS_XB), (unsigned)(l * 6 + 4 + 1)}, s2{(unsigned*)(ws + WS_XB + 512 * 1024), (unsigned)(l * 6 + 5 + 1)};
            pg8::EpiRmsResRms E{XN, RS, (l == 0) ? (float*)nullptr : P.out, P.in[9] + l * DM, s1, s2};
            pg8::gemm_phase<pg8::EpiRmsResRms, pg8::StaticOrder, false, true>(F.lds, g, S, E);
          } else {
            { pg8::Gemm g{HMID, WDN, M, DM, FFD}; pg8::StaticOrder S; S.init(M, DM, F.G, F.bid);
              pg8::EpiStore<0> E{Y2, DM, 1.f};
              pg8::gemm_phase<pg8::EpiStore<0>, pg8::StaticOrder, true, true>(F.lds, g, S, E); }
            GRID_BAR();
            row_phase(F, XN, RS, Y2, P.in[9] + l * DM, (l == 0) ? (float*)nullptr : P.out);
          } }
        if (l == 0) GRID_BAR();
    }
#ifdef DIAG_PHASE
    GRID_BAR();
    if (F.bid == 0 && threadIdx.x == 0) { volatile LAS unsigned long long* ts = (volatile LAS unsigned long long*)(F.lds + LDSCTL_OFF + 512);
        const unsigned long long d = ts[DIAG_PHASE + 1] - ts[DIAG_PHASE]; const float us = (float)d * 0.01f; P.out[0] = 12.f + fminf(fmaxf((us - (float)(DIAG_BASE)) * (1.f / (float)(DIAG_STEP)), 0.f), 89.f); }
#endif
}

static int launch_mega(void* const* d_in, void* d_out, void* d_ws, hipStream_t stream) {
    static int grid = 0;
    if (grid == 0) {
        int dev = 0, cus = 0, per_cu = 0;
        if (hipGetDevice(&dev) != hipSuccess || hipDeviceGetAttribute(&cus, hipDeviceAttributeMultiprocessorCount, dev) != hipSuccess) { fprintf(stderr, "device query failed\n"); grid = -1; return -1; }
        if (hipFuncSetAttribute((const void*)fwd_megakernel, hipFuncAttributeMaxDynamicSharedMemorySize, LDS_BYTES) != hipSuccess) { fprintf(stderr, "hipFuncSetAttribute failed\n"); grid = -1; return -1; }
        if (hipOccupancyMaxActiveBlocksPerMultiprocessor(&per_cu, (const void*)fwd_megakernel, NT, LDS_BYTES) != hipSuccess || per_cu < 1) { fprintf(stderr, "occupancy query: %d\n", per_cu); per_cu = 1; }
        (void)hipGetLastError();
        grid = cus;
    }
    if (grid < 0) return -1;
    (void)hipMemsetAsync((char*)d_ws + WS_CTL, 0, CTL_ZERO_BYTES, stream);
    Params p{};
    for (int i = 0; i < 35; ++i) p.in[i] = (const float*)d_in[i];
    p.out = (float*)d_out; p.ws = (unsigned char*)d_ws;
    hipLaunchKernelGGL(fwd_megakernel, dim3(grid), dim3(NT), LDS_BYTES, stream, p);
    return 0;
}

extern "C" void kernel_launch(void* const* d_in, const int* in_sizes, int n_in, void* d_out, int out_size, void* d_ws, size_t ws_size, hipStream_t stream) {
    launch_mega(d_in, d_out, d_ws, stream);
}
```

```cpp
#include <hip/hip_runtime.h>
#include <cstdio>
#include <cstdint>
#include <cmath>
#define SCAN_L8 1
namespace pg8 {
#define PG8_LAS __attribute__((address_space(3)))
typedef unsigned short bf16_t;
typedef short bf16x8 __attribute__((ext_vector_type(8)));
typedef float f32x4 __attribute__((ext_vector_type(4)));
typedef unsigned u32x4 __attribute__((ext_vector_type(4)));
constexpr int BM = 256, BK = 64, HALF = 128, HTB = HALF * BK * 2  , STAGE_BYTES = 8 * HTB, NXCD = 8, WGM = 8;

__host__ __device__ __forceinline__ int lds_byte(int r, int c) { const int st = (r >> 4) * 2 + (c >> 5), rr = r & 15, cc = c & 31, ob = rr * 64 + cc * 2; return st * 1024 + (ob ^ (((ob >> 9) & 1) << 5)); }
__host__ __device__ __forceinline__ void stage_rc(int b, int& R, int& C) { const int st = b / 1024, sb = b % 1024, swz = sb ^ (((sb >> 9) & 1) << 5); R = (st >> 1) * 16 + swz / 64; C = (st & 1) * 32 + (swz % 64) / 2; }
__host__ __device__ __forceinline__ int perm32(int rho) { const int n = rho >> 4, i = rho & 15; return 8 * (i >> 2) + 4 * n + (i & 3); }

__device__ __forceinline__ void st16(void* p, u32x4 v) { asm volatile("global_store_dwordx4 %0, %1, off sc1\n\ts_nop 1" :: "v"(p), "v"(v) : "memory"); }
#define PG8_SWAP32(lo_, hi_, x_) unsigned lo_, hi_; { auto p_ = __builtin_amdgcn_permlane32_swap(__builtin_bit_cast(unsigned, x_), __builtin_bit_cast(unsigned, x_), false, false); lo_ = p_[0]; hi_ = p_[1]; asm volatile("" : "+v"(lo_), "+v"(hi_)); }
__device__ __forceinline__ float xsum_32(float x) { PG8_SWAP32(b0, b1, x); return __builtin_bit_cast(float, b0) + __builtin_bit_cast(float, b1); }
__device__ __forceinline__ float xmax_32(float x) { PG8_SWAP32(b0, b1, x); return fmaxf(__builtin_bit_cast(float, b0), __builtin_bit_cast(float, b1)); }
struct Unit { int pm, pn; };
struct Gemm { const bf16_t* A; const bf16_t* Bt; int M, N, K; };

struct StaticOrder {
    int nM, nN, nwg, G, c;
    __host__ __device__ void init(int M, int N, int G_, int c_) { nM = M / BM; nN = N / BM; nwg = nM * nN; G = G_; c = c_; }
    __host__ __device__ bool next(int i, Unit& u) const {
        const long L = (long)i * G + c; if (L >= nwg) return false;
        int wgid = (int)L; { const int q = nwg / NXCD, r = nwg % NXCD, xcd = wgid % NXCD, off = wgid / NXCD; wgid = (xcd < r ? xcd * (q + 1) : r * (q + 1) + (xcd - r) * q) + off; }
        const int nig = WGM * nN, gid = wgid / nig, fm = gid * WGM, gsz = (nM - fm) < WGM ? (nM - fm) : WGM;
        u.pm = fm + ((wgid % nig) % gsz); u.pn = (wgid % nig) / gsz; return true;
    }
    __device__ __forceinline__ void a_ready(const Unit&) const {}
    __device__ __forceinline__ void done(const Unit&) const {}
};

typedef float f32x2 __attribute__((ext_vector_type(2))); typedef __bf16 bf16x2p __attribute__((ext_vector_type(2)));
__device__ __forceinline__ unsigned cvt_pk_bf16(float lo, float hi) { f32x2 v = {lo, hi}; bf16x2p b = __builtin_convertvector(v, bf16x2p); return __builtin_bit_cast(unsigned, b); }
typedef unsigned u32x2e __attribute__((ext_vector_type(2)));
__device__ __forceinline__ u32x4 pack8(const f32x4 a, const f32x4 b) { u32x4 w; w.x = cvt_pk_bf16(a[0], a[1]); w.y = cvt_pk_bf16(a[2], a[3]); w.z = cvt_pk_bf16(b[0], b[1]); w.w = cvt_pk_bf16(b[2], b[3]); return w; }
__device__ __forceinline__ float bf_lo(unsigned w) { return __builtin_bit_cast(float, w << 16); }
__device__ __forceinline__ float bf_hi(unsigned w) { return __builtin_bit_cast(float, w & 0xffff0000u); }
__device__ __forceinline__ float fsigm(float x) { return __builtin_amdgcn_rcpf(1.f + __builtin_amdgcn_exp2f(-1.4426950408889634f * x)); }

typedef float f32x2e __attribute__((ext_vector_type(2))); typedef __bf16 bf16x2e __attribute__((ext_vector_type(2)));
__device__ __forceinline__ unsigned cvt2c(float lo, float hi) { f32x2e v = {lo, hi}; bf16x2e b = __builtin_convertvector(v, bf16x2e); return __builtin_bit_cast(unsigned, b); }
__device__ __forceinline__ u32x4 pack8c(const f32x4 a, const f32x4 b) { u32x4 w; w.x = cvt2c(a[0], a[1]); w.y = cvt2c(a[2], a[3]); w.z = cvt2c(b[0], b[1]); w.w = cvt2c(b[2], b[3]); return w; }
__device__ __forceinline__ int img_lane(int wr, int wc, int fr, int fq) { int o = (wr * 4 + wc) * 64 + fq * 16 + fr; asm volatile("" : "+v"(o)); return o; }
__device__ __forceinline__ int img16(int ai, int m, int bj, int lo) { return ((ai * 4 + m) * 2 + bj) * 512 + lo; }
template <int ACT> struct EpiStore {
    static constexpr bool PERM = true, AFTER_DRAIN = false;
    bf16_t* O; int ldc; float scale;
    __device__ __forceinline__ void operator()(const f32x4 (&acc)[2][2][4][2], const Unit& u, int wr, int wc, int fr, int fq) const {
        const int row0 = u.pm * BM + wr * 64 + fr, col0 = u.pn * BM + wc * 32 + 8 * fq; const int ilo = (ACT == 2) ? img_lane(wr, wc, fr, fq) : 0;
#pragma unroll
        for (int ai = 0; ai < 2; ++ai)
#pragma unroll
            for (int m = 0; m < 4; ++m) { bf16_t* rowp = O + (size_t)(row0 + ai * HALF + m * 16) * ldc + col0;
#pragma unroll
                for (int bj = 0; bj < 2; ++bj) { f32x4 v0 = acc[ai][bj][m][0], v1 = acc[ai][bj][m][1];
                    if (ACT == 1) {
#pragma unroll
                        for (int e = 0; e < 4; ++e) { float a = fmaxf(v0[e], 0.f), b = fmaxf(v1[e], 0.f); v0[e] = a * a; v1[e] = b * b; } }
                    if (ACT == 2) {
#pragma unroll
                        for (int e = 0; e < 4; ++e) { v0[e] = fsigm(v0[e]); v1[e] = fsigm(v1[e]); } }
                    if (ACT == 0) { v0 = v0 * scale; v1 = v1 * scale; }
                    if (ACT == 1) st16(rowp + bj * HALF, pack8(v0, v1));
                    else if (ACT == 2) ((u32x4*)O)[(size_t)(u.pm * 12 + u.pn) * 8192 + img16(ai, m, bj, ilo)] = pack8c(v0, v1);
                    else *(u32x4*)(rowp + bj * HALF) = pack8(v0, v1); } }
    }
};
struct EpiKV {
    static constexpr bool PERM = true, AFTER_DRAIN = false;
    bf16_t* Kd; bf16_t* Vd;
    __device__ __forceinline__ void operator()(const f32x4 (&acc)[2][2][4][2], const Unit& u, int wr, int wc, int fr, int fq) const {
        bf16_t* O = (u.pn >= 2) ? Vd : Kd; const int row0 = u.pm * BM + wr * 64 + fr, col0 = (u.pn & 1) * BM + wc * 32 + 8 * fq;
#pragma unroll
        for (int ai = 0; ai < 2; ++ai)
#pragma unroll
            for (int m = 0; m < 4; ++m) { bf16_t* rowp = O + (size_t)(row0 + ai * HALF + m * 16) * 512 + col0;
#pragma unroll
                for (int bj = 0; bj < 2; ++bj) *(u32x4*)(rowp + bj * HALF) = pack8(acc[ai][bj][m][0], acc[ai][bj][m][1]); }
    }
};
struct ThreePassOrder {
    StaticOrder base;
    __host__ __device__ void init(int M, int G_, int c_) { base.init(M, 1024, G_, c_); }
    __host__ __device__ bool next(int i, Unit& u) const { Unit t; if (!base.next(i / 3, t)) return false; const int n = i % 3; u.pm = t.pm + 64 * (n == 0 ? 2 : n - 1); u.pn = t.pn + 4 * n; return true; }
    __device__ __forceinline__ void a_ready(const Unit&) const {}
    __device__ __forceinline__ void done(const Unit&) const {}
};
struct EpiZ3 {
    static constexpr bool PERM = true, AFTER_DRAIN = false;
    bf16_t* ZB; const bf16_t* GATE; bf16_t* ZT;
    __device__ __forceinline__ void operator()(const f32x4 (&acc)[2][2][4][2], const Unit& u, int wr, int wc, int fr, int fq) const {
        const int n = u.pn >> 2, pm = u.pm & 63, pn = u.pn & 3, row0 = pm * BM + wr * 64 + fr, col0 = pn * BM + wc * 32 + 8 * fq;
        const bool rmw = n != 0; const int ilo = img_lane(wr, wc, fr, fq);
        const u32x4* gimg = (const u32x4*)GATE + (size_t)(pm * 12 + n * 4 + pn) * 8192; u32x4* zimg = (u32x4*)ZT + (size_t)(pm * 4 + pn) * 8192;
#pragma unroll
        for (int ai = 0; ai < 2; ++ai) {
            u32x4 gq[4][2], zq[4][2];
#pragma unroll
            for (int m = 0; m < 4; ++m)
#pragma unroll
                for (int bj = 0; bj < 2; ++bj) gq[m][bj] = gimg[img16(ai, m, bj, ilo)];
            if (rmw) {
#pragma unroll
                for (int m = 0; m < 4; ++m)
#pragma unroll
                    for (int bj = 0; bj < 2; ++bj) zq[m][bj] = zimg[img16(ai, m, bj, ilo)];
            } else {
#pragma unroll
                for (int m = 0; m < 4; ++m)
#pragma unroll
                    for (int bj = 0; bj < 2; ++bj) zq[m][bj] = (u32x4){0u, 0u, 0u, 0u};
            }
#pragma unroll
            for (int m = 0; m < 4; ++m)
#pragma unroll
                for (int bj = 0; bj < 2; ++bj) { const u32x4 g = gq[m][bj], z = zq[m][bj];
                    f32x4 v0 = acc[ai][bj][m][0], v1 = acc[ai][bj][m][1];
                    v0[0] = v0[0] * bf_lo(g.x) + bf_lo(z.x); v0[1] = v0[1] * bf_hi(g.x) + bf_hi(z.x); v0[2] = v0[2] * bf_lo(g.y) + bf_lo(z.y); v0[3] = v0[3] * bf_hi(g.y) + bf_hi(z.y);
                    v1[0] = v1[0] * bf_lo(g.z) + bf_lo(z.z); v1[1] = v1[1] * bf_hi(g.z) + bf_hi(z.z); v1[2] = v1[2] * bf_lo(g.w) + bf_lo(z.w); v1[3] = v1[3] * bf_hi(g.w) + bf_hi(z.w);
                    gq[m][bj] = pack8(v0, v1); }
            if (n == 2) {
#pragma unroll
                for (int m = 0; m < 4; ++m)
#pragma unroll
                    for (int bj = 0; bj < 2; ++bj) *(u32x4*)(ZB + (size_t)(row0 + ai * HALF + m * 16) * 1024 + col0 + bj * HALF) = gq[m][bj];
            } else {
#pragma unroll
                for (int m = 0; m < 4; ++m)
#pragma unroll
                    for (int bj = 0; bj < 2; ++bj) zimg[img16(ai, m, bj, ilo)] = gq[m][bj];
            }
        }
    }
};
struct EpiZ {
    static constexpr bool PERM = true, AFTER_DRAIN = false;
    bf16_t* ZB; const bf16_t* GATE; int goff; int first;
    __device__ __forceinline__ void operator()(const f32x4 (&acc)[2][2][4][2], const Unit& u, int wr, int wc, int fr, int fq) const {
        const int row0 = u.pm * BM + wr * 64 + fr, col0 = u.pn * BM + wc * 32 + 8 * fq;
#pragma unroll
        for (int ai = 0; ai < 2; ++ai)
#pragma unroll
            for (int m = 0; m < 4; ++m) { const size_t r = (size_t)(row0 + ai * HALF + m * 16);
#pragma unroll
                for (int bj = 0; bj < 2; ++bj) { const int c = col0 + bj * HALF;
                    const u32x4 g = *(const u32x4*)(GATE + r * 3072 + goff + c);
                    f32x4 v0 = acc[ai][bj][m][0], v1 = acc[ai][bj][m][1];
                    v0[0] *= bf_lo(g.x); v0[1] *= bf_hi(g.x); v0[2] *= bf_lo(g.y); v0[3] *= bf_hi(g.y);
                    v1[0] *= bf_lo(g.z); v1[1] *= bf_hi(g.z); v1[2] *= bf_lo(g.w); v1[3] *= bf_hi(g.w);
                    bf16_t* zp = ZB + r * 1024 + c;
                    if (!first) { const u32x4 z = *(const u32x4*)zp;
                        v0[0] += bf_lo(z.x); v0[1] += bf_hi(z.x); v0[2] += bf_lo(z.y); v0[3] += bf_hi(z.y);
                        v1[0] += bf_lo(z.z); v1[1] += bf_hi(z.z); v1[2] += bf_lo(z.w); v1[3] += bf_hi(z.w); }
                    *(u32x4*)zp = pack8(v0, v1); } }
    }
};
constexpr size_t G1_MiB = 1u << 20, G1_KM = 1 * G1_MiB + 512 * 1024, G1_ROPE = 2 * G1_MiB, G1_URW = 72 * G1_MiB, G1_MK = 128 * G1_MiB, G1_MV = 144 * G1_MiB, G1_SK = 160 * G1_MiB, G1_SV = 164 * G1_MiB,
                 G1_MQ = 168 * G1_MiB, G1_SQ = 184 * G1_MiB, G1_VM = 254 * G1_MiB;
struct EpiG1 {
    static constexpr bool PERM = true, AFTER_DRAIN = false;
    unsigned char* ws; float qscale; int pn0;
    __device__ __forceinline__ void operator()(const f32x4 (&acc)[2][2][4][2], const Unit& u, int wr, int wc, int fr, int fq) const {
        const int pn = u.pn + pn0, row0 = u.pm * BM + wr * 64 + fr, cw = wc * 32 + 8 * fq;
        bf16_t* const URW = (bf16_t*)(ws + G1_URW); bf16_t* const MQ = (bf16_t*)(ws + G1_MQ); bf16_t* const MK = (bf16_t*)(ws + G1_MK); bf16_t* const MV = (bf16_t*)(ws + G1_MV);
        bf16_t* const SQ = (bf16_t*)(ws + G1_SQ); bf16_t* const SK = (bf16_t*)(ws + G1_SK); bf16_t* const SV = (bf16_t*)(ws + G1_SV); bf16_t* const VM = (bf16_t*)(ws + G1_VM);
        float* const KM = (float*)(ws + G1_KM); const float* const ROPE = (const float*)(ws + G1_ROPE);
        float ks[2][8];
#pragma unroll
        for (int bj = 0; bj < 2; ++bj)
#pragma unroll
            for (int e = 0; e < 8; ++e) ks[bj][e] = 0.f;
#pragma unroll
        for (int bj = 0; bj < 2; ++bj) {
            bf16_t* dst; int ldc, col, mode;
            const int ct = bj * HALF + cw;
            if (pn < 7) { dst = URW; ldc = 1792; col = pn * 256 + ct; mode = 0; }
            else if (pn < 9) { dst = MQ; ldc = 512; col = (pn - 7) * 256 + ct; mode = 2; }
            else if (pn < 11) { dst = MK; ldc = 512; col = (pn - 9) * 256 + ct; mode = 1; }
            else if (pn < 13) { dst = MV; ldc = 512; col = (pn - 11) * 256 + ct; mode = 0; }
            else if (pn < 15) { dst = SQ; ldc = 512; col = (pn - 13) * 256 + ct; mode = 2; }
            else if (pn == 15) { if (bj == 0) { dst = SK; ldc = 128; col = cw; mode = 1; } else { dst = SV; ldc = 128; col = cw; mode = 0; } }
            else { dst = VM; ldc = 32; col = ct; mode = (ct < 32) ? 0 : 3; }
            if (mode == 3) continue;
            const int i0 = (col & 63) >> 1;
#pragma unroll
            for (int ai = 0; ai < 2; ++ai) {
                f32x4 rc[4][2];
                if (mode != 0) {
#pragma unroll
                    for (int m = 0; m < 4; ++m) { const size_t r = (size_t)(row0 + ai * HALF + m * 16);
                        rc[m][0] = *(const f32x4*)(ROPE + (r * 32 + i0) * 2); rc[m][1] = *(const f32x4*)(ROPE + (r * 32 + i0) * 2 + 4); }
                } else {
#pragma unroll
                    for (int m = 0; m < 4; ++m) { rc[m][0] = (f32x4){1.f, 0.f, 1.f, 0.f}; rc[m][1] = (f32x4){1.f, 0.f, 1.f, 0.f}; }
                }
#pragma unroll
                for (int m = 0; m < 4; ++m) { const size_t r = (size_t)(row0 + ai * HALF + m * 16);
                    f32x4 v0 = acc[ai][bj][m][0], v1 = acc[ai][bj][m][1];
                    if (mode != 0) {
                        const f32x4 c0 = rc[m][0], c1 = rc[m][1];
                        f32x4 o0, o1;
                        o0[0] = v0[0] * c0[0] - v0[1] * c0[1]; o0[1] = v0[1] * c0[0] + v0[0] * c0[1];
                        o0[2] = v0[2] * c0[2] - v0[3] * c0[3]; o0[3] = v0[3] * c0[2] + v0[2] * c0[3];
                        o1[0] = v1[0] * c1[0] - v1[1] * c1[1]; o1[1] = v1[1] * c1[0] + v1[0] * c1[1];
                        o1[2] = v1[2] * c1[2] - v1[3] * c1[3]; o1[3] = v1[3] * c1[2] + v1[2] * c1[3];
                        v0 = o0; v1 = o1;
                        if (mode == 2) { v0 = v0 * qscale; v1 = v1 * qscale; }
                        if (pn == 9 || pn == 10) {
#pragma unroll
                            for (int e = 0; e < 4; ++e) { ks[bj][e] += v0[e]; ks[bj][4 + e] += v1[e]; } }
                    }
                    *(u32x4*)(dst + r * ldc + col) = pack8(v0, v1); }
            }
        }
        if (pn == 9 || pn == 10) {
#pragma unroll
            for (int bj = 0; bj < 2; ++bj)
#pragma unroll
                for (int e = 0; e < 8; ++e) { float s = ks[bj][e]; s += __shfl_xor(s, 1); s += __shfl_xor(s, 2); s += __shfl_xor(s, 4); s += __shfl_xor(s, 8);
                    if (fr == 0) atomicAdd(KM + (size_t)u.pm * 512 + (pn - 9) * 256 + bj * HALF + cw + e, s); }
        }
    }
};
struct PanelRms {
    unsigned* xbuf;
    unsigned tag;
    __device__ __forceinline__ void post(const f32x4 (&v)[2][2][4][2], const Unit& u, int wr, int wc, int fr, int fq, PG8_LAS unsigned char* lds, int wid, int lane) const {
        PG8_LAS float* P = (PG8_LAS float*)lds;
#pragma unroll
        for (int ai = 0; ai < 2; ++ai)
#pragma unroll
            for (int m = 0; m < 4; ++m) {
                float s = 0.f;
#pragma unroll
                for (int bj = 0; bj < 2; ++bj)
#pragma unroll
                    for (int n = 0; n < 2; ++n) { const f32x4 x = v[ai][bj][m][n]; s += (x[0] * x[0] + x[1] * x[1]) + (x[2] * x[2] + x[3] * x[3]); }
                s += __shfl_xor(s, 16); s += __shfl_xor(s, 32);
                if (fq == 0) P[(ai * HALF + wr * 64 + m * 16 + fr) * 4 + wc] = s;
            }
        asm volatile("s_waitcnt lgkmcnt(0)" ::: "memory"); __builtin_amdgcn_s_barrier(); asm volatile("" ::: "memory");
        const int row = wid * 32 + (lane & 31);
        if (lane < 32) {
            const float tot = (P[row * 4 + 0] + P[row * 4 + 1]) + (P[row * 4 + 2] + P[row * 4 + 3]);
            unsigned long long* slot = (unsigned long long*)xbuf + ((size_t)(u.pm * BM + row) * 4 + u.pn);
            __hip_atomic_store(slot, ((unsigned long long)tag << 32) | (unsigned long long)__float_as_uint(tot), __ATOMIC_RELAXED, __HIP_MEMORY_SCOPE_AGENT);
        }
    }
    __device__ __forceinline__ void finish(const Unit& u, PG8_LAS unsigned char* lds, int wid, int lane, float* rsw) const {
        PG8_LAS float* S = (PG8_LAS float*)(lds + 8192);
        const int row = wid * 32 + (lane & 31);
        unsigned long long* slot = (unsigned long long*)xbuf + (size_t)(u.pm * BM + row) * 4;
        unsigned long long w0, w1, w2, w3; bool ok; unsigned spins = 0;
        { const unsigned long long* rep = (const unsigned long long*)xbuf + (size_t)(u.pm * BM + wid * 32 + 31) * 4; unsigned sp2 = 0;
          for (;;) { bool rdy = true;
              if (lane < 4) rdy = (unsigned)(__hip_atomic_load(rep + lane, __ATOMIC_RELAXED, __HIP_MEMORY_SCOPE_AGENT) >> 32) == tag;
              if (__all(rdy)) break;
              if (++sp2 > 400000u) break;
              __builtin_amdgcn_s_sleep(2); } }
        for (;;) {
            w0 = __hip_atomic_load(slot + 0, __ATOMIC_RELAXED, __HIP_MEMORY_SCOPE_AGENT); w1 = __hip_atomic_load(slot + 1, __ATOMIC_RELAXED, __HIP_MEMORY_SCOPE_AGENT);
            w2 = __hip_atomic_load(slot + 2, __ATOMIC_RELAXED, __HIP_MEMORY_SCOPE_AGENT); w3 = __hip_atomic_load(slot + 3, __ATOMIC_RELAXED, __HIP_MEMORY_SCOPE_AGENT);
            ok = ((unsigned)(w0 >> 32) == tag) & ((unsigned)(w1 >> 32) == tag) & ((unsigned)(w2 >> 32) == tag) & ((unsigned)(w3 >> 32) == tag);
            if (__all(ok)) break;
            if (++spins > 400000u) break;
            __builtin_amdgcn_s_sleep(1);
        }
        if (lane < 32) {
            float q = (__uint_as_float((unsigned)w0) + __uint_as_float((unsigned)w1)) + (__uint_as_float((unsigned)w2) + __uint_as_float((unsigned)w3));
            if (!ok) q = __builtin_nanf("");
            const float ms = q * (1.0f / 1024.0f) + 1e-6f; S[row] = 1.0f / sqrtf(ms);
            if (rsw != nullptr && u.pn == 0) rsw[u.pm * BM + row] = sqrtf(ms);
        }
        asm volatile("s_waitcnt lgkmcnt(0)" ::: "memory"); __builtin_amdgcn_s_barrier(); asm volatile("" ::: "memory");
    }
};
struct EpiRmsResRms {
    static constexpr bool PERM = true, AFTER_DRAIN = true;
    bf16_t* xn; float* rs; float* out; const float* g; PanelRms st1, st2;
    __device__ __forceinline__ void fused(f32x4 (&acc)[2][2][4][2], const Unit& u, int wr, int wc, int fr, int fq, PG8_LAS unsigned char* lds, int wid, int lane) const {
        const PG8_LAS float* S = (const PG8_LAS float*)(lds + 8192);
        const int col0 = u.pn * BM + wc * 32 + 8 * fq;
        st1.post(acc, u, wr, wc, fr, fq, lds, wid, lane);
        st1.finish(u, lds, wid, lane, nullptr);
        f32x4 gv[2][2];
#pragma unroll
        for (int bj = 0; bj < 2; ++bj)
#pragma unroll
            for (int n = 0; n < 2; ++n) gv[bj][n] = *(const f32x4*)(g + col0 + bj * HALF + n * 4);
#pragma unroll
        for (int ai = 0; ai < 2; ++ai)
#pragma unroll
            for (int m = 0; m < 4; ++m) { const int r = ai * HALF + wr * 64 + m * 16 + fr; const float sr = S[r]; const float ro = rs[u.pm * BM + r]; const size_t off = (size_t)(u.pm * BM + r) * 1024 + col0;
#pragma unroll
                for (int bj = 0; bj < 2; ++bj) { const u32x4 w = *(const u32x4*)(xn + off + bj * HALF);
                    const f32x4 b0 = (f32x4){bf_lo(w.x), bf_hi(w.x), bf_lo(w.y), bf_hi(w.y)}, b1 = (f32x4){bf_lo(w.z), bf_hi(w.z), bf_lo(w.w), bf_hi(w.w)};
                    acc[ai][bj][m][0] = b0 * ro + acc[ai][bj][m][0] * sr * gv[bj][0]; acc[ai][bj][m][1] = b1 * ro + acc[ai][bj][m][1] * sr * gv[bj][1]; }
                asm volatile("" : "+v"(acc[ai][0][m][0]), "+v"(acc[ai][0][m][1]), "+v"(acc[ai][1][m][0]), "+v"(acc[ai][1][m][1]));
                if (m == 3) asm volatile("" ::: "memory"); }
        if (out != nullptr) {
#pragma unroll
            for (int ai = 0; ai < 2; ++ai)
#pragma unroll
                for (int m = 0; m < 4; ++m) { const int r = ai * HALF + wr * 64 + m * 16 + fr; const size_t off = (size_t)(u.pm * BM + r) * 1024 + col0;
#pragma unroll
                    for (int bj = 0; bj < 2; ++bj)
#pragma unroll
                        for (int n = 0; n < 2; ++n) *(f32x4*)(out + off + bj * HALF + n * 4) = acc[ai][bj][m][n]; }
            return; }
        st2.post(acc, u, wr, wc, fr, fq, lds, wid, lane);
        st2.finish(u, lds, wid, lane, rs);
#pragma unroll
        for (int ai = 0; ai < 2; ++ai)
#pragma unroll
            for (int m = 0; m < 4; ++m) { const int r = ai * HALF + wr * 64 + m * 16 + fr; const float sr = S[r]; const size_t off = (size_t)(u.pm * BM + r) * 1024 + col0;
#pragma unroll
                for (int bj = 0; bj < 2; ++bj) *(u32x4*)(xn + off + bj * HALF) = pack8(acc[ai][bj][m][0] * sr, acc[ai][bj][m][1] * sr);
                asm volatile("" ::: "memory"); }
    }
};
template <class Epi, class Sched, bool ALIGN_EPI = false, bool SP2 = false>
__device__ __forceinline__ void gemm_phase(PG8_LAS unsigned char* lds, const Gemm g, const Sched& S, const Epi& E) {
    int tid_ = threadIdx.x; asm volatile("" : "+v"(tid_));
    const int tid = tid_, wid = __builtin_amdgcn_readfirstlane(tid >> 6), lane = tid & 63, wr = wid >> 2, wc = wid & 3, fr = lane & 15, fq = lane >> 4;
    const int K = g.K, nt = K / BK;
    unsigned voffA[2], voffB[2];
#pragma unroll
    for (int i = 0; i < 2; ++i) { int R, C; stage_rc(tid * 16 + i * 8192, R, C); const int Rb = Epi::PERM ? ((R & ~31) + perm32(R & 31)) : R;
        voffA[i] = (unsigned)(R * K + C) * 2u; voffB[i] = (unsigned)(Rb * K + C) * 2u; }
    const size_t kstep = (size_t)(BK * 2);
    const size_t hstep = (size_t)HALF * K * 2;
    const size_t tstep = 2 * hstep;
    const unsigned ldsw = (unsigned)wid * 1024u;
    const int aoff = lds_byte(wr * 64 + fr, fq * 8), boff = lds_byte(wc * 32 + fr, fq * 8);
#define PG8_SA(b, h) (((b) * 2 + (h)) * HTB)
#define PG8_SB(b, h) ((4 + (b) * 2 + (h)) * HTB)
#define PG8_STAGE(bufoff, gbase, voff) do { _Pragma("unroll") for (int _i = 0; _i < 2; ++_i) \
        __builtin_amdgcn_global_load_lds((const unsigned*)((const char*)(gbase) + (voff)[_i]), (PG8_LAS unsigned*)(lds + (bufoff) + ldsw + _i * 8192), 16, 0, 0); } while (0)
#define PG8_LDA(dst, b, h) do { _Pragma("unroll") for (int m = 0; m < 4; ++m) _Pragma("unroll") for (int k = 0; k < 2; ++k) dst[m][k] = *(const PG8_LAS bf16x8*)(lds + PG8_SA(b, h) + aoff + m * 2048 + k * 1024); } while (0)
#define PG8_LDB(dst, b, h) do { _Pragma("unroll") for (int n = 0; n < 2; ++n) _Pragma("unroll") for (int k = 0; k < 2; ++k) dst[n][k] = *(const PG8_LAS bf16x8*)(lds + PG8_SB(b, h) + boff + n * 2048 + k * 1024); } while (0)
#define PG8_MMA(ai, bj, At, Bt) do { __builtin_amdgcn_s_setprio(1); _Pragma("unroll") for (int m = 0; m < 4; ++m) _Pragma("unroll") for (int n = 0; n < 2; ++n) _Pragma("unroll") for (int k = 0; k < 2; ++k) \
        acc[ai][bj][m][n] = __builtin_amdgcn_mfma_f32_16x16x32_bf16(Bt[n][k], At[m][k], acc[ai][bj][m][n], 0, 0, 0); __builtin_amdgcn_s_setprio(0); } while (0)
#define PG8_WAIT_V(n) asm volatile("s_waitcnt vmcnt(" #n ")" ::: "memory")
#define PG8_WAIT_L(n) asm volatile("s_waitcnt lgkmcnt(" #n ")" ::: "memory")
#define PG8_BAR __builtin_amdgcn_s_barrier()
#define PG8_SCHED __builtin_amdgcn_sched_barrier(0)
    Unit cur, nxt; int ui = 0;
    if (!S.next(0, cur)) return;
    f32x4 acc[2][2][4][2];
#pragma unroll
    for (int a = 0; a < 2; ++a)
#pragma unroll
        for (int b = 0; b < 2; ++b)
#pragma unroll
            for (int m = 0; m < 4; ++m)
#pragma unroll
                for (int n = 0; n < 2; ++n) acc[a][b][m][n] = (f32x4){0.f, 0.f, 0.f, 0.f};
    bf16x8 At[4][2], B0[2][2], B1[2][2];
    const char* cA = (const char*)g.A + (size_t)cur.pm * tstep; const char* cB = (const char*)g.Bt + (size_t)cur.pn * tstep;
    S.a_ready(cur);
    if constexpr (SP2) {
        PG8_STAGE(PG8_SB(0, 0), cB, voffB); PG8_STAGE(PG8_SB(0, 1), cB + hstep, voffB); PG8_STAGE(PG8_SA(0, 0), cA, voffA); PG8_STAGE(PG8_SA(0, 1), cA + hstep, voffA);
        if (wr == 1) PG8_BAR;
        PG8_WAIT_V(2); PG8_BAR;
        PG8_STAGE(PG8_SB(1, 0), cB + kstep, voffB); PG8_STAGE(PG8_SA(1, 0), cA + kstep, voffA); PG8_STAGE(PG8_SB(1, 1), cB + hstep + kstep, voffB);
        PG8_WAIT_V(6); PG8_BAR;
    } else {
        PG8_STAGE(PG8_SB(0, 0), cB, voffB); PG8_STAGE(PG8_SA(0, 0), cA, voffA); PG8_STAGE(PG8_SB(0, 1), cB + hstep, voffB); PG8_STAGE(PG8_SA(0, 1), cA + hstep, voffA);
        if (wr == 1) PG8_BAR;
        PG8_WAIT_V(4); PG8_BAR;
        PG8_STAGE(PG8_SB(1, 0), cB + kstep, voffB); PG8_STAGE(PG8_SA(1, 0), cA + kstep, voffA); PG8_STAGE(PG8_SB(1, 1), cB + hstep + kstep, voffB);
        PG8_WAIT_V(6); PG8_BAR;
    }
    for (;;) {
        const bool has_next = S.next(ui + 1, nxt);
        const char* nA = has_next ? (const char*)g.A + (size_t)nxt.pm * tstep : cA; const char* nB = has_next ? (const char*)g.Bt + (size_t)nxt.pn * tstep : cB;
        for (int t = 0; t < nt; t += 2) {
            const bool last = (t == nt - 2);
            const char* a1 = cA + (size_t)(t + 1) * kstep;
            const char* a2 = last ? nA : cA + (size_t)(t + 2) * kstep; const char* b2 = last ? nB : cB + (size_t)(t + 2) * kstep;
            const char* a3 = a2 + kstep; const char* b3 = b2 + kstep;
            if (last && has_next) S.a_ready(nxt);
            if constexpr (SP2) {
            PG8_LDB(B0, 0, 0); PG8_LDB(B1, 0, 1); PG8_SCHED; PG8_LDA(At, 0, 0); PG8_STAGE(PG8_SA(1, 1), a1 + hstep, voffA);
            PG8_WAIT_V(8); PG8_WAIT_L(0); PG8_BAR; PG8_MMA(0, 0, At, B0); PG8_MMA(0, 1, At, B1); PG8_BAR; PG8_SCHED;
            PG8_LDA(At, 0, 1); PG8_STAGE(PG8_SB(0, 0), b2, voffB); PG8_STAGE(PG8_SB(0, 1), b2 + hstep, voffB); PG8_STAGE(PG8_SA(0, 0), a2, voffA);
            PG8_WAIT_V(8); PG8_WAIT_L(0); PG8_BAR; PG8_MMA(1, 0, At, B0); PG8_MMA(1, 1, At, B1); PG8_BAR; PG8_SCHED;
            PG8_LDB(B0, 1, 0); PG8_LDB(B1, 1, 1); PG8_SCHED; PG8_LDA(At, 1, 0); PG8_STAGE(PG8_SA(0, 1), a2 + hstep, voffA);
            PG8_WAIT_V(8); PG8_WAIT_L(0); PG8_BAR; PG8_MMA(0, 0, At, B0); PG8_MMA(0, 1, At, B1); PG8_BAR; PG8_SCHED;
            PG8_LDA(At, 1, 1); PG8_STAGE(PG8_SB(1, 0), b3, voffB); PG8_STAGE(PG8_SB(1, 1), b3 + hstep, voffB); PG8_STAGE(PG8_SA(1, 0), a3, voffA);
            PG8_WAIT_V(8); PG8_WAIT_L(0); PG8_BAR; PG8_MMA(1, 0, At, B0); PG8_MMA(1, 1, At, B1); PG8_BAR; PG8_SCHED;
            } else {
            PG8_LDB(B0, 0, 0); PG8_SCHED; PG8_LDA(At, 0, 0); PG8_STAGE(PG8_SA(1, 1), a1 + hstep, voffA);
            PG8_WAIT_L(8); PG8_BAR; PG8_WAIT_L(0); PG8_MMA(0, 0, At, B0); PG8_BAR; PG8_SCHED;
            PG8_LDB(B1, 0, 1); PG8_STAGE(PG8_SB(0, 0), b2, voffB);
            PG8_BAR; PG8_WAIT_L(0); PG8_MMA(0, 1, At, B1); PG8_BAR;
            PG8_LDA(At, 0, 1); PG8_STAGE(PG8_SA(0, 0), a2, voffA);
            PG8_BAR; PG8_WAIT_L(0); PG8_MMA(1, 0, At, B0); PG8_BAR; PG8_SCHED;
            PG8_STAGE(PG8_SB(0, 1), b2 + hstep, voffB);
            PG8_WAIT_V(6); PG8_BAR; PG8_MMA(1, 1, At, B1); PG8_BAR;
            PG8_LDB(B0, 1, 0); PG8_SCHED; PG8_LDA(At, 1, 0); PG8_STAGE(PG8_SA(0, 1), a2 + hstep, voffA);
            PG8_WAIT_L(8); PG8_BAR; PG8_WAIT_L(0); PG8_MMA(0, 0, At, B0); PG8_BAR; PG8_SCHED;
            PG8_LDB(B1, 1, 1); PG8_STAGE(PG8_SB(1, 0), b3, voffB);
            PG8_BAR; PG8_WAIT_L(0); PG8_MMA(0, 1, At, B1); PG8_BAR;
            PG8_LDA(At, 1, 1); PG8_STAGE(PG8_SA(1, 0), a3, voffA);
            PG8_BAR; PG8_WAIT_L(0); PG8_MMA(1, 0, At, B0); PG8_BAR; PG8_SCHED;
            PG8_STAGE(PG8_SB(1, 1), b3 + hstep, voffB);
            PG8_WAIT_V(6); PG8_BAR; PG8_MMA(1, 1, At, B1); PG8_BAR;
            }
        }
        if constexpr (ALIGN_EPI) { if (wr == 0) PG8_BAR; }
        if constexpr (!Epi::AFTER_DRAIN) { E(acc, cur, wr, wc, fr, fq); S.done(cur); }
        if (!has_next) break;
#pragma unroll
        for (int a = 0; a < 2; ++a)
#pragma unroll
            for (int b = 0; b < 2; ++b)
#pragma unroll
                for (int m = 0; m < 4; ++m)
#pragma unroll
                    for (int n = 0; n < 2; ++n) acc[a][b][m][n] = (f32x4){0.f, 0.f, 0.f, 0.f};
        cur = nxt; cA = nA; cB = nB; ++ui;
        if constexpr (ALIGN_EPI) { if (wr == 1) PG8_BAR; }
    }
    PG8_WAIT_V(0);
    if constexpr (!ALIGN_EPI) { if (wr == 0) PG8_BAR; }
    PG8_BAR;
    if constexpr (Epi::AFTER_DRAIN) { E.fused(acc, cur, wr, wc, fr, fq, lds, wid, lane); S.done(cur); }
#undef PG8_SA
#undef PG8_SB
#undef PG8_STAGE
#undef PG8_LDA
#undef PG8_LDB
#undef PG8_MMA
#undef PG8_WAIT_V
#undef PG8_WAIT_L
#undef PG8_BAR
#undef PG8_SCHED
}
}
#define GAS __attribute__((address_space(1)))
#define LAS __attribute__((address_space(3)))
typedef unsigned short bf16;
typedef unsigned v4u __attribute__((ext_vector_type(4)));
typedef float f32x4 __attribute__((ext_vector_type(4)));
typedef short bf16x8 __attribute__((ext_vector_type(8)));
typedef GAS unsigned gu32;
typedef GAS unsigned long long gu64;
#define RLX_AGENT __ATOMIC_RELAXED, __HIP_MEMORY_SCOPE_AGENT
#define LDS_WAIT() asm volatile("s_waitcnt lgkmcnt(0)" ::: "memory")
#define VM_WAIT() asm volatile("s_waitcnt vmcnt(0)" ::: "memory")
__device__ __forceinline__ unsigned long long rt() { return __builtin_amdgcn_s_memrealtime(); }
__device__ __forceinline__ unsigned f2bf(float f) { unsigned u = __builtin_bit_cast(unsigned, f); return (u + 0x7fffu + ((u >> 16) & 1u)) >> 16; }
__device__ __forceinline__ unsigned pk2(float lo, float hi) { return f2bf(lo) | (f2bf(hi) << 16); }

#define XB_TMO      128
#define XB_XCNT(j)  (256  + 64 * (j))
#define XB_XSUB(j)  (1280 + 64 * (j))
#define XB_XGEN(j)  (2304 + 64 * (j))
#define XB_TOP      3328
#define XB_TOPGEN   3392
#define XCD_BAR_WORDS 3456
#define XB_SPIN_CAP (1u << 18)

__device__ __forceinline__ unsigned xb_ld(unsigned* p)              { return __hip_atomic_load(p, __ATOMIC_RELAXED, __HIP_MEMORY_SCOPE_AGENT); }
__device__ __forceinline__ unsigned xb_add(unsigned* p, unsigned v) { return __hip_atomic_fetch_add(p, v, __ATOMIC_RELAXED, __HIP_MEMORY_SCOPE_AGENT); }
__device__ __forceinline__ unsigned xb_xcc_id() { return (unsigned)__builtin_amdgcn_s_getreg((3 << 11) | 20) & 0xFu; }
#define XB_SPIN(cond, bar) do { unsigned _sp = 0; while (cond) { __builtin_amdgcn_s_sleep(1); \
    if ((++_sp & 255u) == 0u) { if (xb_ld(&(bar)[XB_TMO])) break; if (_sp > XB_SPIN_CAP) { atomicAdd(&(bar)[XB_TMO], 1u); break; } } } } while (0)

struct XcdBarrier {
    unsigned* bar; unsigned x;
    volatile LAS unsigned* st;
};

__device__ __forceinline__ XcdBarrier xcd_barrier_post(unsigned* bar, volatile LAS unsigned* st) {
    XcdBarrier b; b.bar = bar; b.x = xb_xcc_id(); b.st = st;
    if (threadIdx.x == 0) (void)xb_add(&bar[XB_XCNT(b.x)], 1u);
    return b;
}
__device__ __forceinline__ void xcd_barrier_complete(unsigned* bar, unsigned x, unsigned& nloc, unsigned& nx) {
    const unsigned G = gridDim.x * gridDim.y * gridDim.z;
    unsigned sum, cnt, mine, sp = 0u;
    for (;;) {
        sum = 0u; cnt = 0u; mine = 0u;
#pragma unroll
        for (unsigned j = 0; j < 16; ++j) { const unsigned c = xb_ld(&bar[XB_XCNT(j)]); sum += c; cnt += (c > 0u) ? 1u : 0u; mine = (j == x) ? c : mine; }
        if (sum == G) break;
        __builtin_amdgcn_s_sleep(1);
        if ((++sp & 255u) == 0u) { if (xb_ld(&bar[XB_TMO])) break; if (sp > XB_SPIN_CAP) { atomicAdd(&bar[XB_TMO], 1u); break; } }
    }
    nloc = mine > 0u ? mine : 1u; nx = cnt > 0u ? cnt : 1u;
}

__device__ __forceinline__ void xcd_barrier(const XcdBarrier& b) {
    asm volatile("s_waitcnt vmcnt(0)" ::: "memory");
    __syncthreads();
    if (threadIdx.x == 0) {
        unsigned* bar = b.bar;
        __builtin_amdgcn_s_waitcnt(0);
        unsigned nloc = b.st[0], nx = b.st[1];
        if (nloc == 0u) { xcd_barrier_complete(bar, b.x, nloc, nx); b.st[0] = nloc; b.st[1] = nx; }
        const unsigned old = xb_add(&bar[XB_XSUB(b.x)], 1u);
        const unsigned gen = old / nloc;
        if (old + 1u == (gen + 1u) * nloc) {
            __builtin_amdgcn_fence(__ATOMIC_RELEASE, "agent");
            asm volatile("s_waitcnt vmcnt(0)" ::: "memory");
            const unsigned og = xb_add(&bar[XB_TOP], 1u);
            const unsigned tg = og / nx;
            if (og + 1u == (tg + 1u) * nx) xb_add(&bar[XB_TOPGEN], 1u);
            else XB_SPIN(xb_ld(&bar[XB_TOPGEN]) == tg, bar);
            __builtin_amdgcn_fence(__ATOMIC_ACQUIRE, "agent");
            xb_add(&bar[XB_XGEN(b.x)], 1u);
            asm volatile("s_waitcnt vmcnt(0)" ::: "memory");
        } else {
            XB_SPIN(xb_ld(&bar[XB_XGEN(b.x)]) == gen, bar);
            __builtin_amdgcn_fence(__ATOMIC_ACQUIRE, "agent");
            asm volatile("s_waitcnt vmcnt(0)" ::: "memory");
        }
    }
    __syncthreads();
}
constexpr int NWAVES = 8, NT = NWAVES * 64;
constexpr int BATCH = 8, SEQ = 2048, DM = 1024, M = BATCH * SEQ, MEMLEN = 256, MM = BATCH * MEMLEN, FFD = 4096;
constexpr int INC = 7168, RWC = 1792;
constexpr float LOG2E = 1.4426950408889634f;
constexpr float QS64 = 0.125f * LOG2E;
constexpr float QS128 = 0.08838834764831845f * LOG2E;
constexpr size_t MiB = 1u << 20;
constexpr size_t WS_CTL = 0, CTL_ZERO_BYTES = 1536 * 1024;
constexpr size_t WS_XB = 512 * 1024;
constexpr int CW_PANEL = 16384, PANEL_BANK = 64 * 64;
constexpr size_t WS_KM = 1 * MiB + 512 * 1024;
constexpr size_t WS_RS = 1 * MiB + 768 * 1024;
constexpr size_t WS_ROPE = 2 * MiB;
constexpr size_t WS_WA = 6 * MiB;
constexpr size_t WS_WBR = 34 * MiB + MiB / 2, WS_WOUT = 37 * MiB + MiB / 2;
constexpr size_t WS_VFIRST = 16 * MiB;
constexpr size_t WS_MEMKV = 112 * MiB;
constexpr size_t WS_WAB = 32 * MiB;
constexpr size_t WS_XN = 40 * MiB;
constexpr size_t WS_URW = 72 * MiB;
constexpr size_t WS_MK = 128 * MiB, WS_MV = 144 * MiB, WS_SK = 160 * MiB, WS_SV = 164 * MiB;
constexpr size_t WS_GATE = 72 * MiB;
constexpr size_t WS_Y = 72 * MiB;
constexpr size_t WS_QX = 136 * MiB;
constexpr size_t WS_HMID = 72 * MiB;
constexpr size_t WS_MQ = 168 * MiB, WS_SQ = 184 * MiB, WS_ORW = 200 * MiB;
constexpr size_t WS_G = 216 * MiB, WS_BV = 232 * MiB;
constexpr size_t WS_WXQ = 15 * MiB  , WS_WXO = 217 * MiB, WS_WUP = 218 * MiB, WS_WDN = 226 * MiB;
constexpr size_t WS_MN = 104 * MiB, WS_WKV = 108 * MiB;
constexpr size_t WS_WG = 248 * MiB;
constexpr size_t WS_VM = 254 * MiB;
constexpr size_t WS_END = 256 * MiB;
constexpr int CW_BAR = 1024;

constexpr int LDS_BYTES = 147456, LDSCTL_OFF = LDS_BYTES - 1024, MISC_OFF = LDSCTL_OFF + 320;

struct Params {
    const float* in[35]; float* out; unsigned char* ws;
};

struct Frame {
    LAS unsigned char* lds; int wave, G, bid;
};
__device__ __forceinline__ int tid_now() { int t = threadIdx.x; asm volatile("" : "+v"(t)); return t; }

__device__ __forceinline__ float wave_sum(float v) {
#pragma unroll
    for (int o = 1; o < 64; o <<= 1) v += __shfl_xor(v, o);
    return v;
}
__device__ __forceinline__ float row16_sum(float v) {
    v += __builtin_bit_cast(float, __builtin_amdgcn_update_dpp(0, __builtin_bit_cast(int, v), 0x128, 0xf, 0xf, false));
    v += __builtin_bit_cast(float, __builtin_amdgcn_update_dpp(0, __builtin_bit_cast(int, v), 0x124, 0xf, 0xf, false));
    v += __builtin_bit_cast(float, __builtin_amdgcn_update_dpp(0, __builtin_bit_cast(int, v), 0x122, 0xf, 0xf, false));
    v += __builtin_bit_cast(float, __builtin_amdgcn_update_dpp(0, __builtin_bit_cast(int, v), 0x121, 0xf, 0xf, false));
    return v;
}
__device__ __forceinline__ float bfl(unsigned w) { return __builtin_bit_cast(float, w << 16); }
__device__ __forceinline__ float bfh(unsigned w) { return __builtin_bit_cast(float, w & 0xffff0000u); }
__device__ __forceinline__ float bf1(bf16 h) { return __builtin_bit_cast(float, (unsigned)h << 16); }
__device__ __forceinline__ float sigm(float x) { return 1.f / (1.f + __expf(-x)); }
typedef float f32x2_g __attribute__((ext_vector_type(2))); typedef __bf16 bf16x2_g __attribute__((ext_vector_type(2)));
__device__ __forceinline__ unsigned cvt_pk(float lo, float hi) { f32x2_g v = {lo, hi}; bf16x2_g b = __builtin_convertvector(v, bf16x2_g); return __builtin_bit_cast(unsigned, b); }
__device__ __forceinline__ bf16 cvt_1(float x) { return (bf16)(cvt_pk(x, 0.f) & 0xffffu); }

template <class RowMap>
__device__ __forceinline__ void transpose_store(const f32x4 (&v)[8], int K, const float* gain, bf16* WT, RowMap rowmap, LAS float* scr, int kb, int nb, int lane) {
    const int k0 = 64 * kb, n0 = 32 * nb, kr = lane >> 3, n4 = (lane & 7) * 4;
#pragma unroll
    for (int i = 0; i < 8; ++i) { const int kk = 8 * i + kr; f32x4 x = v[i]; if (gain) x = x * gain[k0 + kk];
        LAS float* d = scr + kk * 33 + n4; d[0] = x.x; d[1] = x.y; d[2] = x.z; d[3] = x.w; }
    LDS_WAIT(); asm volatile("" ::: "memory");
    const int c = lane & 7;
#pragma unroll
    for (int j = 0; j < 4; ++j) { const int n = (lane >> 3) + 8 * j; const LAS float* s = scr + (8 * c) * 33 + n;
        v4u o; o.x = cvt_pk(s[0 * 33], s[1 * 33]); o.y = cvt_pk(s[2 * 33], s[3 * 33]); o.z = cvt_pk(s[4 * 33], s[5 * 33]); o.w = cvt_pk(s[6 * 33], s[7 * 33]);
        const int dr = rowmap(n0 + n);
        *(GAS v4u*)(WT + (size_t)dr * K + k0 + 8 * c) = o; }
    LDS_WAIT(); asm volatile("" ::: "memory");
}
template <class RowMap>
__device__ __forceinline__ void transpose_item2(const float* W, int ldw, int c0, int K, const float* gain, bf16* WT, RowMap rowmap, LAS float* scr, int kb1, int nb1, int kb2, int nb2, bool has2, int lane) {
    const int kr = lane >> 3, n4 = (lane & 7) * 4;
    f32x4 v1[8], v2[8];
#pragma unroll
    for (int i = 0; i < 8; ++i) v1[i] = *(const GAS f32x4*)(W + (size_t)(64 * kb1 + 8 * i + kr) * ldw + c0 + 32 * nb1 + n4);
#pragma unroll
    for (int i = 0; i < 8; ++i) v2[i] = *(const GAS f32x4*)(W + (size_t)(64 * kb2 + 8 * i + kr) * ldw + c0 + 32 * nb2 + n4);
    transpose_store(v1, K, gain, WT, rowmap, scr, kb1, nb1, lane);
    if (has2) transpose_store(v2, K, gain, WT, rowmap, scr, kb2, nb2, lane);
}
struct MapWAB { __device__ __forceinline__ int operator()(int n) const; };
struct MapId { int off; __device__ __forceinline__ int operator()(int n) const { return off + n; } };
struct CvItem { const float* W; int ldw; int K; const float* gain; bf16* WT; int roff; int kb, nb; int rmode = 0; };
struct MapCv { int mode, roff; __device__ __forceinline__ int operator()(int n) const; };
__device__ __forceinline__ void transpose_pair(const CvItem& a, const CvItem& b, bool has2, LAS float* scr, int lane) {
    const int kr = lane >> 3, n4 = (lane & 7) * 4;
    f32x4 v1[8], v2[8];
#pragma unroll
    for (int i = 0; i < 8; ++i) v1[i] = *(const GAS f32x4*)(a.W + (size_t)(64 * a.kb + 8 * i + kr) * a.ldw + 32 * a.nb + n4);
#pragma unroll
    for (int i = 0; i < 8; ++i) v2[i] = *(const GAS f32x4*)(b.W + (size_t)(64 * b.kb + 8 * i + kr) * b.ldw + 32 * b.nb + n4);
    transpose_store(v1, a.K, a.gain, a.WT, MapCv{a.rmode, a.roff}, scr, a.kb, a.nb, lane);
    if (has2) transpose_store(v2, b.K, b.gain, b.WT, MapCv{b.rmode, b.roff}, scr, b.kb, b.nb, lane);
}
__device__ __forceinline__ void transpose_quad(const CvItem& a, const CvItem& b, const CvItem& c, const CvItem& d, int n, LAS float* scr, int lane) {
    const int kr = lane >> 3, n4 = (lane & 7) * 4;
    f32x4 v1[8], v2[8], v3[8], v4[8];
#pragma unroll
    for (int i = 0; i < 8; ++i) v1[i] = *(const GAS f32x4*)(a.W + (size_t)(64 * a.kb + 8 * i + kr) * a.ldw + 32 * a.nb + n4);
#pragma unroll
    for (int i = 0; i < 8; ++i) v2[i] = *(const GAS f32x4*)(b.W + (size_t)(64 * b.kb + 8 * i + kr) * b.ldw + 32 * b.nb + n4);
#pragma unroll
    for (int i = 0; i < 8; ++i) v3[i] = *(const GAS f32x4*)(c.W + (size_t)(64 * c.kb + 8 * i + kr) * c.ldw + 32 * c.nb + n4);
#pragma unroll
    for (int i = 0; i < 8; ++i) v4[i] = *(const GAS f32x4*)(d.W + (size_t)(64 * d.kb + 8 * i + kr) * d.ldw + 32 * d.nb + n4);
    transpose_store(v1, a.K, a.gain, a.WT, MapCv{a.rmode, a.roff}, scr, a.kb, a.nb, lane);
    if (n > 1) transpose_store(v2, b.K, b.gain, b.WT, MapCv{b.rmode, b.roff}, scr, b.kb, b.nb, lane);
    if (n > 2) transpose_store(v3, c.K, c.gain, c.WT, MapCv{c.rmode, c.roff}, scr, c.kb, c.nb, lane);
    if (n > 3) transpose_store(v4, d.K, d.gain, d.WT, MapCv{d.rmode, d.roff}, scr, d.kb, d.nb, lane);
}
struct MapWA { __device__ __forceinline__ int operator()(int n) const {
    const bool rp = (n >= 1792 && n < 2816) || (n >= 3328 && n < 3968);
    if (!rp) return n; const int hb = n & ~63, d = n & 63; return hb + ((d < 32) ? 2 * d : 2 * (d - 32) + 1); } };

constexpr int PA_COLS = 3072;
__device__ __forceinline__ int MapWAB::operator()(int n) const { return MapWA{}(n + PA_COLS) - PA_COLS; }
__device__ __forceinline__ int MapCv::operator()(int n) const { return mode == 1 ? MapWA{}(n) : (mode == 2 ? MapWAB{}(n) : roff + n); }
template <class RowMap>
__device__ __forceinline__ void convert_matrix(const Frame& F, const float* W, int ldw, int c0, int K, int N, const float* gain, bf16* WT, RowMap rm, int wg0 = 0, int nwg = 0) {
    LAS float* scr = (LAS float*)(F.lds + F.wave * 16384); const int lane = tid_now() & 63;
    const int gw = (F.bid - wg0) * NWAVES + F.wave, NGW = (nwg ? nwg : F.G) * NWAVES, nblk = N / 32, nit = (K / 64) * nblk;
    for (int it = gw; it < nit; it += 2 * NGW) { const int it2 = it + NGW; const bool has2 = it2 < nit; const int i2 = has2 ? it2 : it;
        transpose_item2(W, ldw, c0, K, gain, WT, rm, scr, it / nblk, it % nblk, i2 / nblk, i2 % nblk, has2, lane); }
}

__device__ __forceinline__ void norm_row_to_bf16(const float* xrow, bf16* orow, int lane, float* rsout = nullptr) {
    const GAS f32x4* xr = (const GAS f32x4*)xrow + lane; f32x4 v[4]; float s = 0.f;
#pragma unroll
    for (int j = 0; j < 4; ++j) { v[j] = xr[64 * j]; s += (v[j].x * v[j].x + v[j].y * v[j].y) + (v[j].z * v[j].z + v[j].w * v[j].w); }
    const float ms = wave_sum(s) * (1.f / DM) + 1e-6f; const float rs = 1.f / sqrtf(ms);
    if (rsout != nullptr && lane == 0) *rsout = sqrtf(ms);
    GAS unsigned long long* o8 = (GAS unsigned long long*)orow + lane;
#pragma unroll
    for (int j = 0; j < 4; ++j) o8[64 * j] = (unsigned long long)pk2(v[j].x * rs, v[j].y * rs) | ((unsigned long long)pk2(v[j].z * rs, v[j].w * rs) << 32);
}
__device__ __forceinline__ void norm_rows4_to_bf16(const float* X, bf16* O, float* rsv, int r0, int rstep, int nrows, int lane) {
    f32x4 v[4][4]; int rr[4];
#pragma unroll
    for (int k = 0; k < 4; ++k) { rr[k] = r0 + k * rstep; const int rc = rr[k] < nrows ? rr[k] : r0; const GAS f32x4* xr = (const GAS f32x4*)(X + (size_t)rc * DM) + lane;
#pragma unroll
        for (int j = 0; j < 4; ++j) v[k][j] = xr[64 * j]; }
#pragma unroll
    for (int k = 0; k < 4; ++k) { float s = 0.f;
#pragma unroll
        for (int j = 0; j < 4; ++j) s += (v[k][j].x * v[k][j].x + v[k][j].y * v[k][j].y) + (v[k][j].z * v[k][j].z + v[k][j].w * v[k][j].w);
        const float ms = wave_sum(s) * (1.f / DM) + 1e-6f; const float rs = 1.f / sqrtf(ms);
        if (rr[k] < nrows) { if (lane == 0) rsv[rr[k]] = sqrtf(ms);
            GAS unsigned long long* o8 = (GAS unsigned long long*)(O + (size_t)rr[k] * DM) + lane;
#pragma unroll
            for (int j = 0; j < 4; ++j) o8[64 * j] = (unsigned long long)pk2(v[k][j].x * rs, v[k][j].y * rs) | ((unsigned long long)pk2(v[k][j].z * rs, v[k][j].w * rs) << 32); } }
}
__device__ __forceinline__ void row_phase(const Frame& F, bf16* xn, float* rsv, const bf16* y, const float* g, float* out) {
    const int gw = F.bid * NWAVES + F.wave, NGW = F.G * NWAVES, lane = tid_now() & 63;
    for (int r = gw; r < M; r += NGW) {
        const GAS unsigned long long* y8 = (const GAS unsigned long long*)(y + (size_t)r * DM) + lane; GAS unsigned long long* x8 = (GAS unsigned long long*)(xn + (size_t)r * DM) + lane; const f32x4* g4 = (const f32x4*)g + lane;
        f32x4 yv[4]; float s = 0.f; const float ro = rsv[r];
#pragma unroll
        for (int j = 0; j < 4; ++j) { const unsigned long long w = y8[64 * j]; const unsigned lo = (unsigned)w, hi = (unsigned)(w >> 32); yv[j] = (f32x4){bfl(lo), bfh(lo), bfl(hi), bfh(hi)};
            s += (yv[j].x * yv[j].x + yv[j].y * yv[j].y) + (yv[j].z * yv[j].z + yv[j].w * yv[j].w); }
        const float rs = 1.f / sqrtf(wave_sum(s) * (1.f / DM) + 1e-6f); float s2 = 0.f; f32x4 xv[4];
#pragma unroll
        for (int j = 0; j < 4; ++j) { const unsigned long long w = x8[64 * j]; const unsigned lo = (unsigned)w, hi = (unsigned)(w >> 32);
            xv[j] = (f32x4){bfl(lo), bfh(lo), bfl(hi), bfh(hi)} * ro + yv[j] * rs * g4[64 * j]; s2 += (xv[j].x * xv[j].x + xv[j].y * xv[j].y) + (xv[j].z * xv[j].z + xv[j].w * xv[j].w); }
        if (out != nullptr) { GAS f32x4* xo = (GAS f32x4*)(out + (size_t)r * DM) + lane;
#pragma unroll
            for (int j = 0; j < 4; ++j) xo[64 * j] = xv[j]; }
        else { const float ms = wave_sum(s2) * (1.f / DM) + 1e-6f; const float rs2 = 1.f / sqrtf(ms); if (lane == 0) rsv[r] = sqrtf(ms);
#pragma unroll
            for (int j = 0; j < 4; ++j) x8[64 * j] = (unsigned long long)pk2(xv[j].x * rs2, xv[j].y * rs2) | ((unsigned long long)pk2(xv[j].z * rs2, xv[j].w * rs2) << 32); }
    }
}

__device__ __forceinline__ void vm_phase(const Frame& F, const bf16* XNp, const bf16* WT  , bf16* VMp) {
    constexpr int BST = 2112;
    const int tid = tid_now(), lane = tid & 63, fr = lane & 15, fq = lane >> 4, rt = F.wave & 3, kh = F.wave >> 2;
    LAS unsigned char* bl = F.lds; LAS float* red = (LAS float*)(F.lds + 32 * BST);
    __syncthreads();
#pragma unroll
    for (int i = 0; i < 8; ++i) { const int idx = tid + i * NT, row = idx >> 7, c16 = idx & 127;
        *(LAS v4u*)(bl + row * BST + c16 * 16) = *(const GAS v4u*)(WT + (size_t)row * DM + c16 * 8); }
    __syncthreads();
    for (int blk = F.bid; blk < M / 64; blk += F.G) {
        const bf16* ap = XNp + (size_t)(blk * 64 + rt * 16 + fr) * DM + kh * 512 + fq * 8;
        const LAS unsigned char* b0 = bl + fr * BST + (kh * 512 + fq * 8) * 2; const LAS unsigned char* b1 = b0 + 16 * BST;
        bf16x8 av[16];
#pragma unroll
        for (int ks = 0; ks < 16; ++ks) av[ks] = *(const bf16x8*)(ap + ks * 32);
        f32x4 acc0 = (f32x4){0.f, 0.f, 0.f, 0.f}, acc1 = acc0;
#pragma unroll
        for (int ks = 0; ks < 16; ++ks) { acc0 = __builtin_amdgcn_mfma_f32_16x16x32_bf16(av[ks], *(const LAS bf16x8*)(b0 + ks * 64), acc0, 0, 0, 0);
                                          acc1 = __builtin_amdgcn_mfma_f32_16x16x32_bf16(av[ks], *(const LAS bf16x8*)(b1 + ks * 64), acc1, 0, 0, 0); }
        if (kh == 1) { *(LAS f32x4*)(red + ((rt * 2 + 0) * 64 + lane) * 4) = acc0; *(LAS f32x4*)(red + ((rt * 2 + 1) * 64 + lane) * 4) = acc1; }
        __syncthreads();
        if (kh == 0) { acc0 = acc0 + *(const LAS f32x4*)(red + ((rt * 2 + 0) * 64 + lane) * 4); acc1 = acc1 + *(const LAS f32x4*)(red + ((rt * 2 + 1) * 64 + lane) * 4);
#pragma unroll
            for (int j = 0; j < 4; ++j) { VMp[(size_t)(blk * 64 + rt * 16 + fq * 4 + j) * 32 + fr] = cvt_1(acc0[j]); VMp[(size_t)(blk * 64 + rt * 16 + fq * 4 + j) * 32 + 16 + fr] = cvt_1(acc1[j]); } }
        __syncthreads();
    }
}

__device__ __forceinline__ void sub_barrier(unsigned* cnt, unsigned n) {
    asm volatile("s_waitcnt vmcnt(0)" ::: "memory"); __syncthreads();
    if (threadIdx.x == 0) {
        __builtin_amdgcn_fence(__ATOMIC_RELEASE, "agent"); asm volatile("s_waitcnt vmcnt(0)" ::: "memory");
        __hip_atomic_fetch_add(cnt, 1u, __ATOMIC_RELAXED, __HIP_MEMORY_SCOPE_AGENT);
        unsigned spins = 0;
        while (__hip_atomic_load(cnt, __ATOMIC_RELAXED, __HIP_MEMORY_SCOPE_AGENT) < n) { __builtin_amdgcn_s_sleep(4); if (++spins > (1u << 22)) break; }
        __builtin_amdgcn_fence(__ATOMIC_ACQUIRE, "agent"); asm volatile("s_waitcnt vmcnt(0)" ::: "memory");
    }
    __syncthreads();
}
namespace at {
using bf16x8 = __attribute__((ext_vector_type(8))) short;
using s16x4 = __attribute__((ext_vector_type(4))) short;
using f32x16 = __attribute__((ext_vector_type(16))) float;
using u32x4 = __attribute__((ext_vector_type(4))) unsigned;
typedef short v4i16_t __attribute__((ext_vector_type(4)));
typedef __attribute__((address_space(3))) const char* lds_cptr;
typedef __attribute__((address_space(3))) char* lds_ptr;
__device__ __forceinline__ int crow(int r, int hi) { return (r & 3) + 8 * (r >> 2) + 4 * hi; }
__device__ __forceinline__ void glds16(const void* gsrc, unsigned lds_dst) { unsigned keep;
    asm volatile("s_mov_b32 %0, m0\n\ts_mov_b32 m0, %2\n\ts_nop 0\n\tglobal_load_lds_dwordx4 %1, off\n\ts_mov_b32 m0, %0" : "=&s"(keep) : "v"(gsrc), "s"(lds_dst) : "memory"); }
typedef float f32x2_t __attribute__((ext_vector_type(2))); typedef __bf16 bf16x2_t __attribute__((ext_vector_type(2)));
__device__ __forceinline__ unsigned cvtpk(float lo, float hi) { f32x2_t v = {lo, hi}; bf16x2_t b = __builtin_convertvector(v, bf16x2_t); return __builtin_bit_cast(unsigned, b); }
__device__ __forceinline__ s16x4 vtr(lds_cptr p) { return __builtin_bit_cast(s16x4, __builtin_amdgcn_ds_read_tr16_b64_v4i16((__attribute__((address_space(3))) v4i16_t*)p)); }
#define AT_WAIT_BAR() asm volatile("s_waitcnt vmcnt(0) lgkmcnt(0)\n\ts_barrier" ::: "memory")

template <int HD, int NS> struct Lay {
    static constexpr int NCH = HD / 8, SLOT = 64 * HD * 2, LDS_K = 0, LDS_V = NS * SLOT, LDS_WS = 2 * NS * SLOT, LDS_OST = LDS_WS + 8 * 64 * 4, BYTES = LDS_OST + 8 * 32 * HD * 2;
};
struct Ten { const bf16* Q; int qp; const bf16* K; const bf16* V; int kvp; bf16* O; int op; };

template <int HD, int MODE>
__device__ __forceinline__ void attn_unit(const Ten& T, int q0, int kt0, int nt, float sink_l2, const float* kmsum  , lds_ptr shm) {
    constexpr int NS = (HD == 64) ? 4 : 2;
    using L = Lay<HD, NS>;
    constexpr int ND = HD / 16, NO = HD / 32;
    const int tid = tid_now(), lane = tid & 63, r32 = lane & 31, hi = lane >> 5; const int wid = __builtin_amdgcn_readfirstlane(tid >> 6);
    const unsigned lds0 = (unsigned)(uintptr_t)shm;
    __attribute__((address_space(3))) float* wsf = (__attribute__((address_space(3))) float*)(shm + L::LDS_WS) + wid * 64;
    const int qb = q0 >> 8;
    const int NTILES = (MODE == 0) ? 4 * (qb + 1) : nt;
    auto tile_of = [&](int s) -> int { if (MODE == 0) return (s < 4) ? 4 * qb + s : s - 4; return kt0 + s; };
    auto dma = [&](int s, int slot) {
        const int kt = tile_of(s);
#pragma unroll
        for (int c = wid; c < L::NCH; c += 8) {
            const bf16* ksrc = T.K + (size_t)(kt * 64 + lane) * T.kvp + c * 8;
            glds16(ksrc, (unsigned)__builtin_amdgcn_readfirstlane(lds0 + L::LDS_K + slot * L::SLOT + c * 1024));
            const bf16* vsrc = T.V + (size_t)(kt * 64 + 16 * (c & 3) + (lane >> 2)) * T.kvp + (c >> 2) * 32 + (lane & 3) * 8;
            glds16(vsrc, (unsigned)__builtin_amdgcn_readfirstlane(lds0 + L::LDS_V + slot * L::SLOT + c * 1024));
        }
    };
    dma(0, 0);
    if (NS == 4) { if (1 < NTILES) dma(1, 1); if (2 < NTILES) dma(2, 2); }
    const bf16* Qw = T.Q + (size_t)(q0 + wid * 32) * T.qp;
    bf16x8 qr[ND];
#pragma unroll
    for (int d0 = 0; d0 < ND; ++d0) qr[d0] = *reinterpret_cast<const bf16x8*>(&Qw[(size_t)r32 * T.qp + d0 * 16 + hi * 8]);
    const int qrel = wid * 32 + r32;
    unsigned selbits = 0xffu;
    if (MODE == 0 && qb > 3) {
        { __attribute__((address_space(3))) float* kml = (__attribute__((address_space(3))) float*)(shm + L::LDS_WS);
          kml[tid] = kmsum[(size_t)(tid >> 6) * 512 + (tid & 63)];
          asm volatile("s_waitcnt vmcnt(0) lgkmcnt(0)\n\ts_barrier" ::: "memory"); }
        const __attribute__((address_space(3))) float* kml = (const __attribute__((address_space(3))) float*)(shm + L::LDS_WS);
        float g[7];
#pragma unroll
        for (int j = 0; j < 7; ++j) { g[j] = 0.f;
            if (j < qb) { float a = 0.f;
#pragma unroll
                for (int d0 = 0; d0 < ND; ++d0) { const __attribute__((address_space(3))) float* kp = kml + j * 64 + d0 * 16 + hi * 8; const f32x4 k0 = *(const __attribute__((address_space(3))) f32x4*)kp, k1 = *(const __attribute__((address_space(3))) f32x4*)(kp + 4);
                    const bf16x8 qq = qr[d0];
                    a += bf1((bf16)qq[0]) * k0[0] + bf1((bf16)qq[1]) * k0[1] + bf1((bf16)qq[2]) * k0[2] + bf1((bf16)qq[3]) * k0[3]
                       + bf1((bf16)qq[4]) * k1[0] + bf1((bf16)qq[5]) * k1[1] + bf1((bf16)qq[6]) * k1[2] + bf1((bf16)qq[7]) * k1[3]; }
                a = pg8::xsum_32(a); g[j] = a; } }
        selbits = 0u;
#pragma unroll
        for (int j = 0; j < 7; ++j) { int rank = 0;
#pragma unroll
            for (int i = 0; i < 7; ++i) if (i != j && i < qb) rank += (g[i] > g[j] || (g[i] == g[j] && i < j)) ? 1 : 0;
            if (j < qb && rank < 3) selbits |= 1u << j; }
    }
    float mhat = (MODE == 1) ? sink_l2 : 0.f, l_reg = (MODE == 1 && hi == 0) ? 1.f : 0.f;
    f32x16 o[NO];
#pragma unroll
    for (int d = 0; d < NO; ++d) o[d] = f32x16{};
    f32x16 negm;
#pragma unroll
    for (int r = 0; r < 16; ++r) negm[r] = -mhat;
    const lds_cptr shm3 = (lds_cptr)shm;
    for (int s = 0; s < NTILES; ++s) {
        const int slot = s & (NS - 1);
        if (NS == 4) {
            const int rem = NTILES - 1 - s;
            if (rem >= 2) asm volatile("s_waitcnt vmcnt(4) lgkmcnt(0)\n\ts_barrier" ::: "memory");
            else if (rem == 1) asm volatile("s_waitcnt vmcnt(2) lgkmcnt(0)\n\ts_barrier" ::: "memory");
            else AT_WAIT_BAR();
            if (s + 3 < NTILES) dma(s + 3, (s + 3) & 3);
        } else {
            AT_WAIT_BAR();
            if (s + 1 < NTILES) dma(s + 1, slot ^ 1);
        }
        int tclass = 2;
        if (MODE == 0) { if (s < 4) { const int klo_t = 64 * s, khi_t = 64 * s + 63, rlo = wid * 32, rhi = wid * 32 + 31; tclass = (klo_t > rhi) ? 0 : (khi_t <= rlo ? 2 : 1); }
                         else { const bool sel = ((selbits >> ((s - 4) >> 2)) & 1u) != 0u; tclass = __all(sel) ? 2 : (__any(sel) ? 1 : 0); } }
        else if (MODE == 1) { const int klo_t = 64 * (kt0 + s) - q0, khi_t = klo_t + 63, rlo = wid * 32, rhi = wid * 32 + 31;
                              tclass = (klo_t > rhi || khi_t < rlo - 127) ? 0 : ((khi_t <= rlo && klo_t >= rhi - 127) ? 2 : 1); }
        if (tclass == 0) continue;
        f32x16 p0 = negm, p1 = negm;
        const lds_cptr kb = shm3 + L::LDS_K + slot * L::SLOT + hi * 1024 + r32 * 16;
#pragma unroll
        for (int d0 = 0; d0 < ND; ++d0) {
            const bf16x8 b0 = *(const __attribute__((address_space(3))) bf16x8*)(kb + d0 * 2048);
            const bf16x8 b1 = *(const __attribute__((address_space(3))) bf16x8*)(kb + d0 * 2048 + 512);
            p0 = __builtin_amdgcn_mfma_f32_32x32x16_bf16(b0, qr[d0], p0, 0, 0, 0);
            p1 = __builtin_amdgcn_mfma_f32_32x32x16_bf16(b1, qr[d0], p1, 0, 0, 0);
        }
        if (MODE != 2 && tclass == 1) {
            int klo, khi, kbase;
            if (MODE == 0) { if (s < 4) { kbase = 64 * s; klo = -1000000; khi = qrel; } else { kbase = -1000000; klo = -2000000; khi = ((selbits >> ((s - 4) >> 2)) & 1u) ? 0 : -2000000; } }
            else { kbase = 64 * (kt0 + s) - q0; klo = qrel - 127; khi = qrel; }
            const int kb4 = kbase + 4 * hi;
#pragma unroll
            for (int r = 0; r < 16; ++r) { const int kv = kb4 + (r & 3) + 8 * (r >> 2);
                if (kv > khi || kv < klo) p0[r] = -INFINITY;
                if (kv + 32 > khi || kv + 32 < klo) p1[r] = -INFINITY; }
        }
        float rm = p0[0];
#pragma unroll
        for (int r = 1; r < 16; ++r) rm = fmaxf(rm, p0[r]);
#pragma unroll
        for (int r = 0; r < 16; ++r) rm = fmaxf(rm, p1[r]);
        rm = pg8::xmax_32(rm);
        bool resc = false;
        if (__any(rm > 6.f)) { const float dl = fmaxf(rm, 0.f); mhat += dl;
#pragma unroll
            for (int r = 0; r < 16; ++r) { p0[r] -= dl; p1[r] -= dl; negm[r] = -mhat; }
            const float f = __builtin_amdgcn_exp2f(-dl); l_reg *= f; if (hi == 0) wsf[r32] = f; resc = true; }
        float sacc = 0.f;
#pragma unroll
        for (int r = 0; r < 16; ++r) { p0[r] = __builtin_amdgcn_exp2f(p0[r]); p1[r] = __builtin_amdgcn_exp2f(p1[r]); sacc += p0[r] + p1[r]; }
        l_reg += sacc;
        if (resc) {
#pragma unroll
            for (int r = 0; r < 16; ++r) { const float f = wsf[crow(r, hi)];
#pragma unroll
                for (int d = 0; d < NO; ++d) o[d][r] *= f; }
        }
        u32x4 pw[4];
        pw[0] = (u32x4){cvtpk(p0[0], p0[1]), cvtpk(p0[2], p0[3]), cvtpk(p0[4], p0[5]), cvtpk(p0[6], p0[7])};
        pw[1] = (u32x4){cvtpk(p0[8], p0[9]), cvtpk(p0[10], p0[11]), cvtpk(p0[12], p0[13]), cvtpk(p0[14], p0[15])};
        pw[2] = (u32x4){cvtpk(p1[0], p1[1]), cvtpk(p1[2], p1[3]), cvtpk(p1[4], p1[5]), cvtpk(p1[6], p1[7])};
        pw[3] = (u32x4){cvtpk(p1[8], p1[9]), cvtpk(p1[10], p1[11]), cvtpk(p1[12], p1[13]), cvtpk(p1[14], p1[15])};
        const lds_cptr vp = shm3 + L::LDS_V + slot * L::SLOT + ((lane >> 4) & 1) * 32 + (lane & 3) * 8 + (4 * hi + ((lane & 15) >> 2)) * 64;
#pragma unroll
        for (int d0 = 0; d0 < NO; ++d0)
#pragma unroll
            for (int ks = 0; ks < 4; ++ks) { const s16x4 lo = vtr(vp + d0 * 4096 + ks * 1024), hh = vtr(vp + d0 * 4096 + ks * 1024 + 512);
                const bf16x8 vf = (bf16x8){lo[0], lo[1], lo[2], lo[3], hh[0], hh[1], hh[2], hh[3]};
                o[d0] = __builtin_amdgcn_mfma_f32_32x32x16_bf16(__builtin_bit_cast(bf16x8, pw[ks]), vf, o[d0], 0, 0, 0); }
    }
    l_reg = pg8::xsum_32(l_reg);
    if (hi == 0) wsf[32 + r32] = l_reg;
    asm volatile("s_waitcnt lgkmcnt(0)" ::: "memory");
    float rli[16];
#pragma unroll
    for (int r = 0; r < 16; ++r) rli[r] = 1.f / wsf[32 + crow(r, hi)];
    bf16* Ow = T.O + (size_t)(q0 + wid * 32) * T.op;
    { __attribute__((address_space(3))) bf16* stg = (__attribute__((address_space(3))) bf16*)(shm + L::LDS_OST) + wid * 32 * HD;
#pragma unroll
      for (int r = 0; r < 16; ++r) { const int orow = crow(r, hi);
#pragma unroll
          for (int d0 = 0; d0 < NO; ++d0) stg[orow * HD + d0 * 32 + r32] = (bf16)(cvtpk(o[d0][r] * rli[r], 0.f) & 0xffffu); }
      asm volatile("s_waitcnt lgkmcnt(0)" ::: "memory");
      constexpr int CPR = HD / 8, RPI = 64 / CPR;
#pragma unroll
      for (int i = 0; i < 32 / RPI; ++i) { const int row = i * RPI + lane / CPR, ch = lane % CPR; const u32x4 v = *(const __attribute__((address_space(3))) u32x4*)(stg + row * HD + ch * 8);
          *(u32x4*)(Ow + (size_t)row * T.op + ch * 8) = v; } }
    asm volatile("s_waitcnt vmcnt(0) lgkmcnt(0)\n\ts_barrier" ::: "memory");
}
}
namespace rw {
using bf16x8 = __attribute__((ext_vector_type(8))) short;
typedef float f4 __attribute__((ext_vector_type(4)));
typedef unsigned u4 __attribute__((ext_vector_type(4)));
typedef unsigned u2 __attribute__((ext_vector_type(2)));
#define RW_LAS __attribute__((address_space(3)))
struct Args { const bf16* URW; const bf16* LIN; bf16* VFIRST; bf16* ORW; bf16* G; bf16* BV;
              const float *mu, *w0, *w_up, *a0, *a_up, *g_up, *k_k, *k_a, *r_k, *vmu, *v0, *v_up; int layer; };
#ifndef NREP_PREP
#define NREP_PREP 1
#endif
#ifndef NREP_D
#define NREP_D 1
#endif
constexpr int CH = 32;
constexpr int O_STG = 0, O_VST = 40960, O_WS = 49152, O_AS = 57344, O_WUT = 65536, O_AUT = 74752, O_GUT = 83968, O_VUT = 92672, O_END = 95232;
constexpr int LINC = 288;
constexpr int SXW = 72, SXG = 136, SXV = 40;
__device__ __forceinline__ unsigned pkbf(float lo, float hi) { return pk2(lo, hi); }
#define RW_BAR() do { asm volatile("s_waitcnt lgkmcnt(0)" ::: "memory"); __builtin_amdgcn_s_barrier(); asm volatile("" ::: "memory"); } while (0)

__device__ __forceinline__ float fsig(float x) { return __builtin_amdgcn_rcpf(1.f + __builtin_amdgcn_exp2f(-1.4426950408889634f * x)); }
__device__ __forceinline__ float ftanh(float x) { return 1.f - 2.f * __builtin_amdgcn_rcpf(1.f + __builtin_amdgcn_exp2f(2.8853900817779268f * x)); }
__device__ __forceinline__ void lerp8(const u4 cur, const u4 prv, const float* mup, float* x) {
    const f4 m0 = *(const f4*)(mup), m1 = *(const f4*)(mup + 4);
    x[0] = bfl(cur.x) + m0[0] * (bfl(prv.x) - bfl(cur.x)); x[1] = bfh(cur.x) + m0[1] * (bfh(prv.x) - bfh(cur.x));
    x[2] = bfl(cur.y) + m0[2] * (bfl(prv.y) - bfl(cur.y)); x[3] = bfh(cur.y) + m0[3] * (bfh(prv.y) - bfh(cur.y));
    x[4] = bfl(cur.z) + m1[0] * (bfl(prv.z) - bfl(cur.z)); x[5] = bfh(cur.z) + m1[1] * (bfh(prv.z) - bfh(cur.z));
    x[6] = bfl(cur.w) + m1[2] * (bfl(prv.w) - bfl(cur.w)); x[7] = bfh(cur.w) + m1[3] * (bfh(prv.w) - bfh(cur.w)); }
__device__ __forceinline__ void lin_phase(const Frame& F, const bf16* URW, const bf16* VM, const float* mu, const float* vmu, int layer, bf16* LIN) {
    const int gt = F.bid * NT + tid_now(), GT = F.G * NT;
    for (int it = gt; it < M * 32; it += 2 * GT) { const int it2 = (it + GT < M * 32) ? it + GT : it;
        const int rowa = it >> 5, ca = it & 31, rowb = it2 >> 5, cb = it2 & 31; const int cola = 1536 + 8 * ca, colb = 1536 + 8 * cb;
        const bool fa = (rowa & (SEQ - 1)) == 0, fb = (rowb & (SEQ - 1)) == 0;
        const u4 cura = *(const u4*)(URW + (size_t)rowa * RWC + cola), curb = *(const u4*)(URW + (size_t)rowb * RWC + colb);
        u4 prva = *(const u4*)(URW + (size_t)(fa ? rowa : rowa - 1) * RWC + cola), prvb = *(const u4*)(URW + (size_t)(fb ? rowb : rowb - 1) * RWC + colb);
        if (fa) prva = (u4){0u, 0u, 0u, 0u}; if (fb) prvb = (u4){0u, 0u, 0u, 0u};
#pragma unroll
        for (int h = 0; h < 2; ++h) { const u4 cur = h ? curb : cura, prv = h ? prvb : prva; const int c8 = h ? cb : ca, col = h ? colb : cola, row = h ? rowb : rowa;
            float x[8]; lerp8(cur, prv, mu + col, x);
            if (c8 < 8) {
#pragma unroll
                for (int e = 0; e < 8; ++e) x[e] = ftanh(x[e]); }
            else if (c8 >= 16) {
#pragma unroll
                for (int e = 0; e < 8; ++e) x[e] = fsig(x[e]); }
            if (h == 0 || it2 != it) *(u4*)(LIN + (size_t)row * LINC + c8 * 8) = (u4){cvt_pk(x[0], x[1]), cvt_pk(x[2], x[3]), cvt_pk(x[4], x[5]), cvt_pk(x[6], x[7])}; }
    }
    for (int it = gt; it < M * 4; it += GT) { const int row = it >> 2, c4 = it & 3; const bool first = (row & (SEQ - 1)) == 0; u4 o = (u4){0u, 0u, 0u, 0u};
        if (layer > 0) { const int col = c4 * 8; const u4 cur = *(const u4*)(VM + (size_t)row * 32 + col); u4 prv = (u4){0u, 0u, 0u, 0u}; if (!first) prv = *(const u4*)(VM + (size_t)(row - 1) * 32 + col);
            float x[8]; lerp8(cur, prv, vmu + col, x); o = (u4){cvt_pk(x[0], x[1]), cvt_pk(x[2], x[3]), cvt_pk(x[4], x[5]), cvt_pk(x[6], x[7])}; }
        *(u4*)(LIN + (size_t)row * LINC + 256 + c4 * 8) = o; }
}
struct Raw { bf16x8 la0, la1, la2, la3, lg0, lg1, lg2, lg3; u2 rc, kc, rp, kp; unsigned short vb0, vb1, vb2, vb3, vb4, vf0, vf1, vf2, vf3; };
__device__ __forceinline__ void scan_unit(const Args& A, int u, RW_LAS unsigned char* lds) {
    const int tid = tid_now(), lane = tid & 63; const int wid = __builtin_amdgcn_readfirstlane(tid >> 6);
    const int b = u >> 4, h = (u >> 1) & 7, half = u & 1; const size_t rowbase = (size_t)b * SEQ; const int hc = h * 64, vcb = h * 64 + half * 32;
    RW_LAS float* STG = (RW_LAS float*)(lds + O_STG); RW_LAS float* VST = (RW_LAS float*)(lds + O_VST);
    RW_LAS float* WS = (RW_LAS float*)(lds + O_WS); RW_LAS float* AS = (RW_LAS float*)(lds + O_AS);
    RW_LAS bf16* WUT = (RW_LAS bf16*)(lds + O_WUT); RW_LAS bf16* AUT = (RW_LAS bf16*)(lds + O_AUT); RW_LAS bf16* GUT = (RW_LAS bf16*)(lds + O_GUT); RW_LAS bf16* VUT = (RW_LAS bf16*)(lds + O_VUT);
    for (int idx = tid; idx < 4096; idx += NT) { const int k = idx >> 6, n = idx & 63;
        WUT[n * SXW + k] = cvt_1(A.w_up[(size_t)k * 512 + hc + n]); AUT[n * SXW + k] = cvt_1(A.a_up[(size_t)k * 512 + hc + n]); }
    for (int idx = tid; idx < 4096; idx += NT) { const int k = idx >> 5, n = idx & 31; GUT[n * SXG + k] = cvt_1(A.g_up[(size_t)k * 512 + vcb + n]); }
    if (A.layer > 0) for (int idx = tid; idx < 1024; idx += NT) { const int k = idx >> 5, n = idx & 31; VUT[n * SXV + k] = cvt_1(A.v_up[(size_t)k * 512 + vcb + n]); }
    const int q = tid & 15, tq = tid >> 4, k4 = 4 * q, fr = lane & 15, fq = lane >> 4;
    const f4 c_kk = *(const f4*)(A.k_k + hc + k4), c_ka = *(const f4*)(A.k_a + hc + k4), c_rk = *(const f4*)(A.r_k + hc + k4);
    const f4 mu_r = *(const f4*)(A.mu + hc + k4), mu_k = *(const f4*)(A.mu + 512 + hc + k4);
    const int vrt = wid & 1, vct = (wid >> 1) & 1, vvc = vct * 16 + fr, vcol = 1024 + vcb + vvc;
    const float muv = A.mu[vcol], v0c = (A.layer > 0) ? A.v0[vcb + vvc] : 0.f;
    const int lrt = wid & 1, lch = (wid >> 1) * 16 + fr; const float w0c = A.w0[hc + lch], a0c = A.a0[hc + lch];
    f4 S = (f4){0.f, 0.f, 0.f, 0.f};
    Raw R;
    auto load_raw = [&](int t0) {
        { const bf16* lp = A.LIN + (rowbase + t0 + lrt * 16 + fr) * LINC + fq * 8;
          R.la0 = *(const bf16x8*)(lp); R.la1 = *(const bf16x8*)(lp + 32); R.la2 = *(const bf16x8*)(lp + 64); R.la3 = *(const bf16x8*)(lp + 96); }
        { const bf16* gp = A.LIN + (rowbase + t0 + vrt * 16 + fr) * LINC + fq * 8;
          const int gc0 = (wid < 4) ? 128 : 256, gst = (wid < 4) ? 32 : 0;
          R.lg0 = *(const bf16x8*)(gp + gc0); R.lg1 = *(const bf16x8*)(gp + gc0 + gst); R.lg2 = *(const bf16x8*)(gp + gc0 + 2 * gst); R.lg3 = *(const bf16x8*)(gp + gc0 + 3 * gst); }
        { const size_t row = rowbase + t0 + tq;
          R.rc = *(const u2*)(A.URW + row * RWC + hc + k4); R.kc = *(const u2*)(A.URW + row * RWC + 512 + hc + k4); R.rp = (u2){0u, 0u}; R.kp = R.rp;
          if (t0 + tq > 0) { R.rp = *(const u2*)(A.URW + (row - 1) * RWC + hc + k4); R.kp = *(const u2*)(A.URW + (row - 1) * RWC + 512 + hc + k4); } }
        if (wid >= 4) { const int tb = vrt * 16 + fq * 4; const size_t row = rowbase + t0 + tb;
            R.vb0 = (t0 + tb > 0) ? A.URW[(row - 1) * RWC + vcol] : (unsigned short)0;
            R.vb1 = A.URW[(row + 0) * RWC + vcol]; R.vb2 = A.URW[(row + 1) * RWC + vcol]; R.vb3 = A.URW[(row + 2) * RWC + vcol]; R.vb4 = A.URW[(row + 3) * RWC + vcol];
            if (A.layer > 0) { R.vf0 = A.VFIRST[(row + 0) * 512 + vcb + vvc]; R.vf1 = A.VFIRST[(row + 1) * 512 + vcb + vvc]; R.vf2 = A.VFIRST[(row + 2) * 512 + vcb + vvc]; R.vf3 = A.VFIRST[(row + 3) * 512 + vcb + vvc]; } }
    };
    auto prep = [&](int t0) {
        RW_LAS float* VSTw = VST + ((t0 >> 5) & 1) * 1024;
        { f4 aw = (f4){0.f, 0.f, 0.f, 0.f}, aa = aw;
          { const bf16x8 wb0 = *(const RW_LAS bf16x8*)(WUT + lch * SXW + fq * 8), ab0 = *(const RW_LAS bf16x8*)(AUT + lch * SXW + fq * 8);
            const bf16x8 wb1 = *(const RW_LAS bf16x8*)(WUT + lch * SXW + 32 + fq * 8), ab1 = *(const RW_LAS bf16x8*)(AUT + lch * SXW + 32 + fq * 8);
            aw = __builtin_amdgcn_mfma_f32_16x16x32_bf16(R.la0, wb0, aw, 0, 0, 0); aw = __builtin_amdgcn_mfma_f32_16x16x32_bf16(R.la1, wb1, aw, 0, 0, 0);
            aa = __builtin_amdgcn_mfma_f32_16x16x32_bf16(R.la2, ab0, aa, 0, 0, 0); aa = __builtin_amdgcn_mfma_f32_16x16x32_bf16(R.la3, ab1, aa, 0, 0, 0); }
#pragma unroll
          for (int j = 0; j < 4; ++j) { const int tok = lrt * 16 + fq * 4 + j;
              WS[tok * 64 + lch] = __builtin_amdgcn_exp2f(-0.8750404f * fsig(w0c + aw[j]));
              AS[tok * 64 + lch] = fsig(a0c + aa[j]); }
          if (wid < 4) { f4 ag = (f4){0.f, 0.f, 0.f, 0.f};
            { const RW_LAS bf16* gp_ = GUT + vvc * SXG + fq * 8;
              ag = __builtin_amdgcn_mfma_f32_16x16x32_bf16(R.lg0, *(const RW_LAS bf16x8*)(gp_), ag, 0, 0, 0); ag = __builtin_amdgcn_mfma_f32_16x16x32_bf16(R.lg1, *(const RW_LAS bf16x8*)(gp_ + 32), ag, 0, 0, 0);
              ag = __builtin_amdgcn_mfma_f32_16x16x32_bf16(R.lg2, *(const RW_LAS bf16x8*)(gp_ + 64), ag, 0, 0, 0); ag = __builtin_amdgcn_mfma_f32_16x16x32_bf16(R.lg3, *(const RW_LAS bf16x8*)(gp_ + 96), ag, 0, 0, 0); }
#pragma unroll
            for (int j = 0; j < 4; ++j) { const int tok = vrt * 16 + fq * 4 + j; A.G[(rowbase + t0 + tok) * 512 + vcb + vvc] = cvt_1(ag[j]); } }
          else { f4 av = (f4){0.f, 0.f, 0.f, 0.f};
            if (A.layer > 0) { const bf16x8 vb = *(const RW_LAS bf16x8*)(VUT + vvc * SXV + fq * 8); av = __builtin_amdgcn_mfma_f32_16x16x32_bf16(R.lg0, vb, av, 0, 0, 0); }
            const unsigned short vbs[5] = {R.vb0, R.vb1, R.vb2, R.vb3, R.vb4}; const unsigned short vfs[4] = {R.vf0, R.vf1, R.vf2, R.vf3};
#pragma unroll
            for (int j = 0; j < 4; ++j) { const int tok = vrt * 16 + fq * 4 + j; const size_t row = rowbase + t0 + tok;
                const float cur = bf1(vbs[1 + j]), prv = bf1(vbs[j]); float v = cur + muv * (prv - cur);
                if (A.layer == 0) A.VFIRST[row * 512 + vcb + vvc] = cvt_1(v);
                else { const float vf = bf1(vfs[j]), vg = fsig(v0c + av[j]); v = v + (vf - v) * vg; }
                VSTw[tok * 32 + vvc] = v; } } }
        RW_BAR();
        { const size_t row = rowbase + t0 + tq; const u2 rc = R.rc, kc = R.kc, rp = R.rp, kp = R.kp;
          f4 r, k;
          r[0] = bfl(rc.x) + mu_r[0] * (bfl(rp.x) - bfl(rc.x)); r[1] = bfh(rc.x) + mu_r[1] * (bfh(rp.x) - bfh(rc.x)); r[2] = bfl(rc.y) + mu_r[2] * (bfl(rp.y) - bfl(rc.y)); r[3] = bfh(rc.y) + mu_r[3] * (bfh(rp.y) - bfh(rc.y));
          k[0] = bfl(kc.x) + mu_k[0] * (bfl(kp.x) - bfl(kc.x)); k[1] = bfh(kc.x) + mu_k[1] * (bfh(kp.x) - bfh(kc.x)); k[2] = bfl(kc.y) + mu_k[2] * (bfl(kp.y) - bfl(kc.y)); k[3] = bfh(kc.y) + mu_k[3] * (bfh(kp.y) - bfh(kc.y));
          const f4 a = *(const RW_LAS f4*)(AS + tq * 64 + k4), w = *(const RW_LAS f4*)(WS + tq * 64 + k4);
          f4 kk = k * c_kk; float n2 = row16_sum(kk[0] * kk[0] + kk[1] * kk[1] + kk[2] * kk[2] + kk[3] * kk[3]);
          const float inv = fminf(__builtin_amdgcn_rsqf(n2), 1e12f); kk = kk * inv;
          const f4 bb = kk * a; f4 ke;
#pragma unroll
          for (int e = 0; e < 4; ++e) ke[e] = k[e] * (1.f + (a[e] - 1.f) * c_ka[e]);
          const float bon = row16_sum(r[0] * ke[0] * c_rk[0] + r[1] * ke[1] * c_rk[1] + r[2] * ke[2] * c_rk[2] + r[3] * ke[3] * c_rk[3]);
          RW_LAS float* sp = STG + tq * 320 + k4;
          *(RW_LAS f4*)(sp) = r; *(RW_LAS f4*)(sp + 64) = w; *(RW_LAS f4*)(sp + 128) = ke; *(RW_LAS f4*)(sp + 192) = kk; *(RW_LAS f4*)(sp + 256) = bb;
          const float v0 = VSTw[tq * 32 + 2 * q], v1 = VSTw[tq * 32 + 2 * q + 1];
          *(unsigned*)(A.BV + row * 512 + vcb + 2 * q) = cvt_pk(bon * v0, bon * v1); }
        RW_BAR();
    };
    load_raw(0);
    RW_BAR();
    prep(0);
    const int rho = tid >> 4;
    for (int t0 = 0; t0 < SEQ; t0 += CH) {
        if (t0 + CH < SEQ) load_raw(t0 + CH);
        float olo = 0.f, ohi = 0.f;
        { const RW_LAS float* sp = STG + k4; const RW_LAS float* vp = VST + ((t0 >> 5) & 1) * 1024 + rho;
          f4 r = *(const RW_LAS f4*)(sp), w = *(const RW_LAS f4*)(sp + 64), ke = *(const RW_LAS f4*)(sp + 128), kk = *(const RW_LAS f4*)(sp + 192), bb = *(const RW_LAS f4*)(sp + 256); float v = vp[0];
#pragma unroll
          for (int t = 0; t < CH; ++t) {
              f4 rn = r, wn = w, ken = ke, kkn = kk, bbn = bb; float vn = v;
              if (t + 1 < CH) { const RW_LAS float* sn = sp + (t + 1) * 320; rn = *(const RW_LAS f4*)(sn); wn = *(const RW_LAS f4*)(sn + 64); ken = *(const RW_LAS f4*)(sn + 128); kkn = *(const RW_LAS f4*)(sn + 192); bbn = *(const RW_LAS f4*)(sn + 256); vn = vp[(t + 1) * 32]; }
              const float sa = -row16_sum(__builtin_fmaf(S[3], kk[3], __builtin_fmaf(S[2], kk[2], __builtin_fmaf(S[1], kk[1], S[0] * kk[0]))));
              S = S * w + (bb * sa + ke * v);
              const float ov = row16_sum(__builtin_fmaf(S[3], r[3], __builtin_fmaf(S[2], r[2], __builtin_fmaf(S[1], r[1], S[0] * r[0]))));
              if (t < 16) olo = (q == t) ? ov : olo; else ohi = (q == t - 16) ? ov : ohi;
              r = rn; w = wn; ke = ken; kk = kkn; bb = bbn; v = vn; } }
        A.ORW[(rowbase + t0 + q) * 512 + vcb + rho] = cvt_1(olo); A.ORW[(rowbase + t0 + 16 + q) * 512 + vcb + rho] = cvt_1(ohi);
        if (t0 + CH < SEQ) prep(t0 + CH);
    }
    RW_BAR();
}
constexpr int L_STG = 0, L_VST = 81920, L_WS = 90112, L_AS = 98304, L_WUT = 106496, L_AUT = 115712, L_GUT = 124928, L_VUT = 133632, L_END = 136192;
static_assert(L_END <= 146432 - 1024, "scan LDS map");
__device__ __forceinline__ float half8_sum(float v) {
    v += __builtin_bit_cast(float, __builtin_amdgcn_update_dpp(0, __builtin_bit_cast(int, v), 0x141, 0xf, 0xf, false));
    v += __builtin_bit_cast(float, __builtin_amdgcn_update_dpp(0, __builtin_bit_cast(int, v), 0xB1, 0xf, 0xf, false));
    v += __builtin_bit_cast(float, __builtin_amdgcn_update_dpp(0, __builtin_bit_cast(int, v), 0x4E, 0xf, 0xf, false));
    return v;
}
__device__ __forceinline__ void scan_unit_l8(const Args& A, int u, RW_LAS unsigned char* lds) {
    const int tid = tid_now(), lane = tid & 63; const int wid = __builtin_amdgcn_readfirstlane(tid >> 6);
    const int b = u >> 4, h = (u >> 1) & 7, half = u & 1; const size_t rowbase = (size_t)b * SEQ; const int hc = h * 64, vcb = h * 64 + half * 32;
    RW_LAS float* STG = (RW_LAS float*)(lds + L_STG); RW_LAS float* VST = (RW_LAS float*)(lds + L_VST);
    RW_LAS float* WS = (RW_LAS float*)(lds + L_WS); RW_LAS float* AS = (RW_LAS float*)(lds + L_AS);
    RW_LAS bf16* WUT = (RW_LAS bf16*)(lds + L_WUT); RW_LAS bf16* AUT = (RW_LAS bf16*)(lds + L_AUT); RW_LAS bf16* GUT = (RW_LAS bf16*)(lds + L_GUT); RW_LAS bf16* VUT = (RW_LAS bf16*)(lds + L_VUT);
    for (int idx = tid; idx < 4096; idx += NT) { const int k = idx >> 6, n = idx & 63;
        WUT[n * SXW + k] = cvt_1(A.w_up[(size_t)k * 512 + hc + n]); AUT[n * SXW + k] = cvt_1(A.a_up[(size_t)k * 512 + hc + n]); }
    for (int idx = tid; idx < 4096; idx += NT) { const int k = idx >> 5, n = idx & 31; GUT[n * SXG + k] = cvt_1(A.g_up[(size_t)k * 512 + vcb + n]); }
    if (A.layer > 0) for (int idx = tid; idx < 1024; idx += NT) { const int k = idx >> 5, n = idx & 31; VUT[n * SXV + k] = cvt_1(A.v_up[(size_t)k * 512 + vcb + n]); }
    RW_BAR();
    const int fr = lane & 15, fq = lane >> 4;
    if (wid >= 4) {
        const int pw = wid - 4, ptid = tid - 256, q = ptid & 15, k4 = 4 * q, rt = pw & 1, cth = pw >> 1;
        const f4 c_kk = *(const f4*)(A.k_k + hc + k4), c_ka = *(const f4*)(A.k_a + hc + k4), c_rk = *(const f4*)(A.r_k + hc + k4);
        const f4 mu_r = *(const f4*)(A.mu + hc + k4), mu_k = *(const f4*)(A.mu + 512 + hc + k4);
        const int vvc = cth * 16 + fr, vcol = 1024 + vcb + vvc; const float muv = A.mu[vcol], v0c = (A.layer > 0) ? A.v0[vcb + vvc] : 0.f;
        const int ch0 = cth * 16 + fr, ch1 = ch0 + 32; const float w0c0 = A.w0[hc + ch0], a0c0 = A.a0[hc + ch0], w0c1 = A.w0[hc + ch1], a0c1 = A.a0[hc + ch1];
        bf16x8 la0, la1, la2, la3, lg0, lg1, lg2, lg3, lv; u2 rc0, kc0, rp0, kp0, rc1, kc1, rp1, kp1; unsigned short vb0, vb1, vb2, vb3, vb4, vf0, vf1, vf2, vf3;
        auto load_raw = [&](int t0) {
            const bf16* lp = A.LIN + (rowbase + t0 + rt * 16 + fr) * LINC + fq * 8;
            la0 = *(const bf16x8*)(lp); la1 = *(const bf16x8*)(lp + 32); la2 = *(const bf16x8*)(lp + 64); la3 = *(const bf16x8*)(lp + 96);
            lg0 = *(const bf16x8*)(lp + 128); lg1 = *(const bf16x8*)(lp + 160); lg2 = *(const bf16x8*)(lp + 192); lg3 = *(const bf16x8*)(lp + 224); lv = *(const bf16x8*)(lp + 256);
            { const int tq = ptid >> 4; const size_t row = rowbase + t0 + tq; const size_t prow = (t0 + tq > 0) ? row - 1 : row; const bool z_ = (t0 + tq == 0);
              rc0 = *(const u2*)(A.URW + row * RWC + hc + k4); kc0 = *(const u2*)(A.URW + row * RWC + 512 + hc + k4);
              const u2 rp_ = *(const u2*)(A.URW + prow * RWC + hc + k4), kp_ = *(const u2*)(A.URW + prow * RWC + 512 + hc + k4);
              rp0 = (u2){z_ ? 0u : rp_.x, z_ ? 0u : rp_.y}; kp0 = (u2){z_ ? 0u : kp_.x, z_ ? 0u : kp_.y};
              rc1 = *(const u2*)(A.URW + (row + 16) * RWC + hc + k4); kc1 = *(const u2*)(A.URW + (row + 16) * RWC + 512 + hc + k4);
              rp1 = *(const u2*)(A.URW + (row + 15) * RWC + hc + k4); kp1 = *(const u2*)(A.URW + (row + 15) * RWC + 512 + hc + k4); }
            { const int tb = rt * 16 + fq * 4; const size_t row = rowbase + t0 + tb; const size_t prow = (t0 + tb > 0) ? row - 1 : row;
              { const unsigned short v_ = A.URW[prow * RWC + vcol]; vb0 = (t0 + tb == 0) ? (unsigned short)0 : v_; }
              vb1 = A.URW[(row + 0) * RWC + vcol]; vb2 = A.URW[(row + 1) * RWC + vcol]; vb3 = A.URW[(row + 2) * RWC + vcol]; vb4 = A.URW[(row + 3) * RWC + vcol];
              const bf16* fp = (A.layer > 0) ? A.VFIRST + row * 512 + vcb + vvc : A.URW + row * RWC + vcol; const int fs = (A.layer > 0) ? 512 : RWC;
              vf0 = fp[0]; vf1 = fp[fs]; vf2 = fp[2 * fs]; vf3 = fp[3 * fs]; }
        };
        auto prepB = [&](int t0, int nb) {
            RW_LAS float* VSTw = VST + nb * 1024;
            { f4 aw0 = (f4){0.f, 0.f, 0.f, 0.f}, aa0 = aw0, aw1 = aw0, aa1 = aw0;
              { const RW_LAS bf16* wp = WUT + ch0 * SXW + fq * 8; const RW_LAS bf16* ap = AUT + ch0 * SXW + fq * 8;
                aw0 = __builtin_amdgcn_mfma_f32_16x16x32_bf16(la0, *(const RW_LAS bf16x8*)(wp), aw0, 0, 0, 0); aw0 = __builtin_amdgcn_mfma_f32_16x16x32_bf16(la1, *(const RW_LAS bf16x8*)(wp + 32), aw0, 0, 0, 0);
                aa0 = __builtin_amdgcn_mfma_f32_16x16x32_bf16(la2, *(const RW_LAS bf16x8*)(ap), aa0, 0, 0, 0); aa0 = __builtin_amdgcn_mfma_f32_16x16x32_bf16(la3, *(const RW_LAS bf16x8*)(ap + 32), aa0, 0, 0, 0);
                aw1 = __builtin_amdgcn_mfma_f32_16x16x32_bf16(la0, *(const RW_LAS bf16x8*)(wp + 32 * SXW), aw1, 0, 0, 0); aw1 = __builtin_amdgcn_mfma_f32_16x16x32_bf16(la1, *(const RW_LAS bf16x8*)(wp + 32 * SXW + 32), aw1, 0, 0, 0);
                aa1 = __builtin_amdgcn_mfma_f32_16x16x32_bf16(la2, *(const RW_LAS bf16x8*)(ap + 32 * SXW), aa1, 0, 0, 0); aa1 = __builtin_amdgcn_mfma_f32_16x16x32_bf16(la3, *(const RW_LAS bf16x8*)(ap + 32 * SXW + 32), aa1, 0, 0, 0); }
#pragma unroll
              for (int j = 0; j < 4; ++j) { const int tok = rt * 16 + fq * 4 + j;
                  WS[tok * 64 + ch0] = __builtin_amdgcn_exp2f(-0.8750404f * fsig(w0c0 + aw0[j])); AS[tok * 64 + ch0] = fsig(a0c0 + aa0[j]);
                  WS[tok * 64 + ch1] = __builtin_amdgcn_exp2f(-0.8750404f * fsig(w0c1 + aw1[j])); AS[tok * 64 + ch1] = fsig(a0c1 + aa1[j]); } }
            { f4 ag = (f4){0.f, 0.f, 0.f, 0.f}; const RW_LAS bf16* gp_ = GUT + vvc * SXG + fq * 8;
              ag = __builtin_amdgcn_mfma_f32_16x16x32_bf16(lg0, *(const RW_LAS bf16x8*)(gp_), ag, 0, 0, 0); ag = __builtin_amdgcn_mfma_f32_16x16x32_bf16(lg1, *(const RW_LAS bf16x8*)(gp_ + 32), ag, 0, 0, 0);
              ag = __builtin_amdgcn_mfma_f32_16x16x32_bf16(lg2, *(const RW_LAS bf16x8*)(gp_ + 64), ag, 0, 0, 0); ag = __builtin_amdgcn_mfma_f32_16x16x32_bf16(lg3, *(const RW_LAS bf16x8*)(gp_ + 96), ag, 0, 0, 0);
#pragma unroll
              for (int j = 0; j < 4; ++j) A.G[(rowbase + t0 + rt * 16 + fq * 4 + j) * 512 + vcb + vvc] = cvt_1(ag[j]); }
            { f4 av = (f4){0.f, 0.f, 0.f, 0.f};
              if (A.layer > 0) av = __builtin_amdgcn_mfma_f32_16x16x32_bf16(lv, *(const RW_LAS bf16x8*)(VUT + vvc * SXV + fq * 8), av, 0, 0, 0);
              const unsigned short vbs[5] = {vb0, vb1, vb2, vb3, vb4}; const unsigned short vfs[4] = {vf0, vf1, vf2, vf3};
#pragma unroll
              for (int j = 0; j < 4; ++j) { const int tok = rt * 16 + fq * 4 + j; const size_t row = rowbase + t0 + tok;
                  const float cur = bf1(vbs[1 + j]), prv = bf1(vbs[j]); float v = cur + muv * (prv - cur);
                  if (A.layer == 0) A.VFIRST[row * 512 + vcb + vvc] = cvt_1(v);
                  else { const float vf = bf1(vfs[j]), vg = fsig(v0c + av[j]); v = v + (vf - v) * vg; }
                  VSTw[tok * 32 + vvc] = v; } }
        };
        auto prepC = [&](int t0, int nb) {
            RW_LAS float* VSTw = VST + nb * 1024;
#pragma unroll
            for (int pass = 0; pass < 2; ++pass) { const int tq = (ptid >> 4) + 16 * pass; const size_t row = rowbase + t0 + tq;
                const u2 rc = pass ? rc1 : rc0, kc = pass ? kc1 : kc0, rp = pass ? rp1 : rp0, kp = pass ? kp1 : kp0; f4 r, k;
                r[0] = bfl(rc.x) + mu_r[0] * (bfl(rp.x) - bfl(rc.x)); r[1] = bfh(rc.x) + mu_r[1] * (bfh(rp.x) - bfh(rc.x)); r[2] = bfl(rc.y) + mu_r[2] * (bfl(rp.y) - bfl(rc.y)); r[3] = bfh(rc.y) + mu_r[3] * (bfh(rp.y) - bfh(rc.y));
                k[0] = bfl(kc.x) + mu_k[0] * (bfl(kp.x) - bfl(kc.x)); k[1] = bfh(kc.x) + mu_k[1] * (bfh(kp.x) - bfh(kc.x)); k[2] = bfl(kc.y) + mu_k[2] * (bfl(kp.y) - bfl(kc.y)); k[3] = bfh(kc.y) + mu_k[3] * (bfh(kp.y) - bfh(kc.y));
                const f4 a = *(const RW_LAS f4*)(AS + tq * 64 + k4), w = *(const RW_LAS f4*)(WS + tq * 64 + k4);
                f4 kk = k * c_kk; const float n2 = row16_sum(kk[0] * kk[0] + kk[1] * kk[1] + kk[2] * kk[2] + kk[3] * kk[3]);
                const float inv = fminf(__builtin_amdgcn_rsqf(n2), 1e12f); kk = kk * inv;
                const f4 bb = kk * a; f4 ke;
#pragma unroll
                for (int e = 0; e < 4; ++e) ke[e] = k[e] * (1.f + (a[e] - 1.f) * c_ka[e]);
                const float bon = row16_sum(r[0] * ke[0] * c_rk[0] + r[1] * ke[1] * c_rk[1] + r[2] * ke[2] * c_rk[2] + r[3] * ke[3] * c_rk[3]);
                RW_LAS float* sp = STG + nb * 10240 + tq * 320 + k4;
                *(RW_LAS f4*)(sp) = r; *(RW_LAS f4*)(sp + 64) = w; *(RW_LAS f4*)(sp + 128) = ke; *(RW_LAS f4*)(sp + 192) = kk; *(RW_LAS f4*)(sp + 256) = bb;
                const float v0 = VSTw[tq * 32 + 2 * q], v1 = VSTw[tq * 32 + 2 * q + 1];
                *(unsigned*)(A.BV + row * 512 + vcb + 2 * q) = cvt_pk(bon * v0, bon * v1); }
        };
        load_raw(0);
#pragma unroll 1
        for (int t0 = -CH; t0 < SEQ; t0 += CH) { const bool has_next = t0 + CH < SEQ; const int nb = ((t0 >> 5) + 1) & 1;
            if (has_next) prepB(t0 + CH, nb);
            RW_BAR();
            if (has_next) { prepC(t0 + CH, nb); if (t0 + 2 * CH < SEQ) load_raw(t0 + 2 * CH); }
            RW_BAR(); }
    } else {
        const int q8 = lane & 7, rho = wid * 8 + (lane >> 3), k8 = 8 * q8;
        typedef float f2 __attribute__((ext_vector_type(2)));
        f2 S0 = (f2){0.f, 0.f}, S1 = S0, S2 = S0, S3 = S0;
#define LO2(v_) __builtin_shufflevector(v_, v_, 0, 1)
#define HI2(v_) __builtin_shufflevector(v_, v_, 2, 3)
        RW_BAR(); RW_BAR();
        for (int t0 = 0; t0 < SEQ; t0 += CH) { const int cb = (t0 >> 5) & 1;
            float o0 = 0.f, o1 = 0.f, o2 = 0.f, o3 = 0.f;
            const RW_LAS float* sp = STG + cb * 10240 + k8; const RW_LAS float* vp = VST + cb * 1024 + rho;
            f4 ra = *(const RW_LAS f4*)(sp), rb = *(const RW_LAS f4*)(sp + 4), wa = *(const RW_LAS f4*)(sp + 64), wb = *(const RW_LAS f4*)(sp + 68), kea = *(const RW_LAS f4*)(sp + 128), keb = *(const RW_LAS f4*)(sp + 132),
               kka = *(const RW_LAS f4*)(sp + 192), kkb = *(const RW_LAS f4*)(sp + 196), bba = *(const RW_LAS f4*)(sp + 256), bbb = *(const RW_LAS f4*)(sp + 260); float v = vp[0];
#pragma unroll
            for (int t = 0; t < CH; ++t) {
                if (t == 16) RW_BAR();
                f4 ran = ra, rbn = rb, wan = wa, wbn = wb, kean = kea, kebn = keb, kkan = kka, kkbn = kkb, bban = bba, bbbn = bbb; float vn = v;
                if (t + 1 < CH) { const RW_LAS float* sn = sp + (t + 1) * 320; ran = *(const RW_LAS f4*)(sn); rbn = *(const RW_LAS f4*)(sn + 4); wan = *(const RW_LAS f4*)(sn + 64); wbn = *(const RW_LAS f4*)(sn + 68);
                    kean = *(const RW_LAS f4*)(sn + 128); kebn = *(const RW_LAS f4*)(sn + 132); kkan = *(const RW_LAS f4*)(sn + 192); kkbn = *(const RW_LAS f4*)(sn + 196); bban = *(const RW_LAS f4*)(sn + 256); bbbn = *(const RW_LAS f4*)(sn + 260);
                    vn = vp[(t + 1) * 32]; }
                f2 dA = S0 * LO2(kka); dA = S1 * HI2(kka) + dA; f2 dB = S2 * LO2(kkb); dB = S3 * HI2(kkb) + dB; const f2 d2 = dA + dB;
                const f2 Sw0 = S0 * LO2(wa) + LO2(kea) * v, Sw1 = S1 * HI2(wa) + HI2(kea) * v, Sw2 = S2 * LO2(wb) + LO2(keb) * v, Sw3 = S3 * HI2(wb) + HI2(keb) * v;
                const float sum = half8_sum(d2.x + d2.y);
                S0 = Sw0 - LO2(bba) * sum; S1 = Sw1 - HI2(bba) * sum; S2 = Sw2 - LO2(bbb) * sum; S3 = Sw3 - HI2(bbb) * sum;
                f2 eA = S0 * LO2(ra); eA = S1 * HI2(ra) + eA; f2 eB = S2 * LO2(rb); eB = S3 * HI2(rb) + eB; const f2 e2 = eA + eB;
                const float ov = half8_sum(e2.x + e2.y);
                if (t < 8) o0 = (q8 == t) ? ov : o0; else if (t < 16) o1 = (q8 == t - 8) ? ov : o1; else if (t < 24) o2 = (q8 == t - 16) ? ov : o2; else o3 = (q8 == t - 24) ? ov : o3;
                ra = ran; rb = rbn; wa = wan; wb = wbn; kea = kean; keb = kebn; kka = kkan; kkb = kkbn; bba = bban; bbb = bbbn; v = vn; }
            { bf16* op = A.ORW + (rowbase + t0 + q8) * 512 + vcb + rho; op[0] = cvt_1(o0); op[8 * 512] = cvt_1(o1); op[16 * 512] = cvt_1(o2); op[24 * 512] = cvt_1(o3); }
            RW_BAR();
        }
    }
}
__device__ __forceinline__ void post_phase(const Frame& F, bf16* ORW, const bf16* G, const bf16* BV, const float* lw, const float* lb) {
    const int tid = tid_now(); const int q = tid & 7, grp = (F.bid * NT + tid) >> 3, ngrp = (F.G * NT) >> 3;
    for (int it = grp; it < M * 8; it += 2 * ngrp) { const int it2 = it + ngrp; const bool two = it2 < M * 8;
        const size_t offa = (size_t)(it >> 3) * 512 + (it & 7) * 64 + 8 * q, offb = two ? (size_t)(it2 >> 3) * 512 + (it2 & 7) * 64 + 8 * q : offa;
        const u4 ova = *(const u4*)(ORW + offa), gva = *(const u4*)(G + offa), bva = *(const u4*)(BV + offa);
        const u4 ovb = *(const u4*)(ORW + offb), gvb = *(const u4*)(G + offb), bvb = *(const u4*)(BV + offb);
#pragma unroll
        for (int h = 0; h < 2; ++h) { const u4 ov = h ? ovb : ova, gv = h ? gvb : gva, bv = h ? bvb : bva; const int ih = h ? it2 : it; const size_t off = h ? offb : offa;
            f4 o0 = (f4){bfl(ov.x), bfh(ov.x), bfl(ov.y), bfh(ov.y)}, o1 = (f4){bfl(ov.z), bfh(ov.z), bfl(ov.w), bfh(ov.w)};
            const float mean = half8_sum((o0[0] + o0[1] + o0[2] + o0[3]) + (o1[0] + o1[1] + o1[2] + o1[3])) * (1.f / 64.f); o0 = o0 - mean; o1 = o1 - mean;
            const float var = half8_sum((o0[0] * o0[0] + o0[1] * o0[1] + o0[2] * o0[2] + o0[3] * o0[3]) + (o1[0] * o1[0] + o1[1] * o1[1] + o1[2] * o1[2] + o1[3] * o1[3])) * (1.f / 64.f);
            const float rs = __builtin_amdgcn_rsqf(var + 64e-5f);
            const int c = (ih & 7) * 64 + 8 * q; const f4 w0 = *(const f4*)(lw + c), w1 = *(const f4*)(lw + c + 4), b0 = *(const f4*)(lb + c), b1 = *(const f4*)(lb + c + 4);
            f4 r0 = o0 * rs * w0 + b0 + (f4){bfl(bv.x), bfh(bv.x), bfl(bv.y), bfh(bv.y)}, r1 = o1 * rs * w1 + b1 + (f4){bfl(bv.z), bfh(bv.z), bfl(bv.w), bfh(bv.w)};
            r0 = r0 * (f4){bfl(gv.x), bfh(gv.x), bfl(gv.y), bfh(gv.y)}; r1 = r1 * (f4){bfl(gv.z), bfh(gv.z), bfl(gv.w), bfh(gv.w)};
            if (h == 0 || two) *(u4*)(ORW + off) = (u4){cvt_pk(r0[0], r0[1]), cvt_pk(r0[2], r0[3]), cvt_pk(r1[0], r1[1]), cvt_pk(r1[2], r1[3])}; }
    }
}
}
#ifndef EN_P0
#define EN_P0 1
#endif
#ifndef EN_G1
#define EN_G1 1
#endif
#ifndef EN_SCAN
#define EN_SCAN 1
#endif
#ifndef EN_ATTN
#define EN_ATTN 1
#endif
#ifndef EN_P3
#define EN_P3 1
#endif
#ifndef EN_P4
#define EN_P4 1
#endif
#ifndef EN_REST
#define EN_REST 255
#endif
#ifndef EN_XATTN
#define EN_XATTN 1
#endif
__device__ __forceinline__ int opaque1(int v) { asm volatile("" : "+s"(v)); return v; }
#ifndef DUPMASK
#define DUPMASK 0
#endif
#define REP(bit) for (int rep_ = 0; rep_ < (((DUPMASK >> (bit)) & 1) ? opaque1(2) : 1); ++rep_)
#ifndef STOP_AFTER
#define STOP_AFTER 1000
#endif
#ifndef DIAG_BIN
#define DIAG_BIN 10.f
#endif
#ifndef DIAG_OFF
#define DIAG_OFF 0.f
#endif
#ifdef DIAG_PHASE
#define TSTAMP() do { if (F.bid == 0 && threadIdx.x == 0) ((volatile LAS unsigned long long*)(F.lds + LDSCTL_OFF + 512))[phase_no] = __builtin_amdgcn_s_memrealtime(); } while (0)
#else
#define TSTAMP() do {} while (0)
#endif
__device__ __forceinline__ CvItem tail_item(const Params& P, int l, int it, bf16* wbr, bf16* wout, bf16* wxq, bf16* wkv) {
    CvItem c;
    if (it < 768) { const int n = it >> 8, r = it & 255; c.W = P.in[27] + ((size_t)l * 3 + n) * 512 * DM; c.ldw = DM; c.K = 512; c.gain = nullptr; c.WT = wbr + (size_t)n * DM * 512; c.roff = 0; c.kb = r >> 5; c.nb = r & 31; }
    else if (it < 1280) { const int r = it - 768; c.W = P.in[28] + (size_t)l * DM * DM; c.ldw = DM; c.K = DM; c.gain = nullptr; c.WT = wout; c.roff = 0; c.kb = r >> 5; c.nb = r & 31; }
    else if (it < 1536) { const int r = it - 1280; c.W = P.in[29] + (size_t)l * DM * 512; c.ldw = 512; c.K = DM; c.gain = P.in[5] + l * DM; c.WT = wxq; c.roff = 0; c.kb = r >> 4; c.nb = r & 15; }
    else if (it < 1792) { const int r = it - 1536; c.W = P.in[30] + (size_t)l * DM * 512; c.ldw = 512; c.K = DM; c.gain = P.in[7] + l * DM; c.WT = wkv; c.roff = 0; c.kb = r >> 4; c.nb = r & 15; }
    else { const int r = it - 1792; c.W = P.in[31] + (size_t)l * DM * 512; c.ldw = 512; c.K = DM; c.gain = P.in[7] + l * DM; c.WT = wkv; c.roff = 512; c.kb = r >> 4; c.nb = r & 15; }
    return c;
}
__device__ __forceinline__ int in_items(int l) { return 3584 + (l > 0 ? 16 : 0); }
__device__ __forceinline__ CvItem in_item(const Params& P, int l, int it, bf16* wa, bf16* wab, bf16* wg) {
    CvItem c; c.ldw = INC; c.K = DM; c.gain = P.in[3] + l * DM; c.roff = 0; const float* W = P.in[10] + (size_t)l * DM * INC;
    if (it < 1536) { c.W = W; c.WT = wa; c.rmode = 1; c.kb = it / 96; c.nb = it - c.kb * 96; }
    else if (it < 2048) { const int r = it - 1536; c.W = W + PA_COLS; c.WT = wab; c.rmode = 2; c.kb = r >> 5; c.nb = r & 31; }
    else if (it < 3584) { const int r = it - 2048; c.W = W + 4096; c.WT = wg; c.rmode = 0; c.kb = r / 96; c.nb = r - c.kb * 96; }
    else { const int r = it - 3584; c.W = P.in[22]; c.ldw = 32; c.WT = wab; c.rmode = 0; c.roff = 4096 - PA_COLS; c.kb = r; c.nb = 0; }
    return c;
}
__device__ __forceinline__ CvItem late_item(const Params& P, int l, int it, bf16* wxo, bf16* wup, bf16* wdn) {
    CvItem c; c.roff = 0; c.rmode = 0;
    if (it < 256) { c.W = P.in[32] + (size_t)l * 512 * DM; c.ldw = DM; c.K = 512; c.gain = nullptr; c.WT = wxo; c.kb = it >> 5; c.nb = it & 31; }
    else if (it < 2304) { const int r = it - 256; c.W = P.in[33] + (size_t)l * DM * FFD; c.ldw = FFD; c.K = DM; c.gain = P.in[8] + l * DM; c.WT = wup; c.kb = r >> 7; c.nb = r & 127; }
    else { const int r = it - 2304; c.W = P.in[34] + (size_t)l * FFD * DM; c.ldw = DM; c.K = FFD; c.gain = nullptr; c.WT = wdn; c.kb = r >> 5; c.nb = r & 31; }
    return c;
}
__global__ void __launch_bounds__(NT, 2) fwd_megakernel(Params P) {
    extern __shared__ __attribute__((aligned(16))) unsigned char lds_raw[];
    Frame F; F.lds = (LAS unsigned char*)lds_raw; F.wave = __builtin_amdgcn_readfirstlane(threadIdx.x >> 6); F.G = gridDim.x; F.bid = blockIdx.x;
    unsigned char* ws = P.ws;
    volatile LAS unsigned* MISC = (volatile LAS unsigned*)(F.lds + MISC_OFF);
    for (int u = threadIdx.x; u < (LDS_BYTES - LDSCTL_OFF) / 4; u += NT) ((LAS unsigned*)(F.lds + LDSCTL_OFF))[u] = 0u;
    __syncthreads();
    XcdBarrier bar = xcd_barrier_post((unsigned*)(ws + WS_CTL) + CW_BAR, MISC + 8);
    int phase_no = 0; TSTAMP();
#define GRID_BAR() do { XcdBarrier b2_ = bar; asm volatile("" : "+s"(b2_.bar), "+s"(b2_.x)); xcd_barrier(b2_); ++phase_no; TSTAMP(); } while (0)
#define XN ((bf16*)(ws + WS_XN))
#define URW ((bf16*)(ws + WS_URW))
#define MQ ((bf16*)(ws + WS_MQ))
#define MK ((bf16*)(ws + WS_MK))
#define MV ((bf16*)(ws + WS_MV))
#define SQ ((bf16*)(ws + WS_SQ))
#define SK ((bf16*)(ws + WS_SK))
#define SV ((bf16*)(ws + WS_SV))
#define ORW ((bf16*)(ws + WS_ORW))
#define VM ((bf16*)(ws + WS_VM))
#define GATE ((bf16*)(ws + WS_GATE))
#define ZB ((bf16*)(P.out))
#define RS ((float*)(ws + WS_RS))
#define Y ((bf16*)(ws + WS_Y))
#define Y2 ((bf16*)(ws + WS_MQ))
#define QX ((bf16*)(ws + WS_QX))
#define HMID ((bf16*)(ws + WS_HMID))
#define WA ((bf16*)(ws + WS_WA))
#define WAB ((bf16*)(ws + WS_WAB))
#define WG ((bf16*)(ws + WS_WG))
#define WBR ((bf16*)(ws + WS_WBR))
#define WOUT ((bf16*)(ws + WS_WOUT))
#define WXQ ((bf16*)(ws + WS_WXQ))
#define WXO ((bf16*)(ws + WS_WXO))
#define WUP ((bf16*)(ws + WS_WUP))
#define WDN ((bf16*)(ws + WS_WDN))
#define MN ((bf16*)((unsigned char*)P.out + 32 * MiB))
#define WKV ((bf16*)((unsigned char*)P.out + 36 * MiB))
#define VFIRST ((bf16*)(ws + WS_VFIRST))
#define LINB ((bf16*)(ws + WS_WA))
#define GB ((bf16*)(ws + WS_G))
#define BVB ((bf16*)(ws + WS_BV))
#define KM ((float*)(ws + WS_KM))
#define ROPE ((float*)(ws + WS_ROPE))
    const int gw = F.bid * NWAVES + F.wave, NGW = F.G * NWAVES, GT = F.G * NT;
#define gtid (F.bid * NT + tid_now())

#define CONV_WA(l) do { convert_matrix(F, P.in[10] + (size_t)(l) * DM * INC, INC, 0, DM, PA_COLS, P.in[3] + (l) * DM, WA, MapWA{}); \
        convert_matrix(F, P.in[10] + (size_t)(l) * DM * INC, INC, PA_COLS, DM, 4096 - PA_COLS, P.in[3] + (l) * DM, WAB, MapWAB{}); \
        if ((l) > 0) convert_matrix(F, P.in[22], 32, 0, DM, 32, P.in[3] + (l) * DM, WAB, MapId{4096 - PA_COLS}); } while (0)
#define CONV_WG(l) convert_matrix(F, P.in[10] + (size_t)(l) * DM * INC, INC, 4096, DM, 3072, P.in[3] + (l) * DM, WG, MapId{0})

    if (EN_P0) REP(0) {
        const int lane0 = tid_now() & 63;
        for (int r = gw; r < M; r += 4 * NGW) norm_rows4_to_bf16(P.in[0], XN, RS, r, NGW, M, lane0);
        { const int* pos = (const int*)P.in[2];
          for (int i = gtid; i < M * 32; i += GT) { const int t = i >> 5, f = i & 31;
              const float invf = __builtin_amdgcn_exp2f(-(float)f * 0.41524101186092029f);
              const float ang = (float)pos[t] * invf; float rev = ang * 0.15915494309189535f; rev -= floorf(rev);
              ROPE[2 * i] = __builtin_amdgcn_cosf(rev); ROPE[2 * i + 1] = __builtin_amdgcn_sinf(rev); } }
        { const int g0_ = gtid;
#pragma unroll
          for (int k_ = 0; k_ < 4; ++k_) { const int i = g0_ + k_ * GT; if (i < 64 * 512) KM[i] = 0.f; } }
        { LAS float* scr = (LAS float*)(F.lds + F.wave * 16384); const int lane = tid_now() & 63, tot = in_items(0);
          for (int it = gw; it < tot; it += 2 * NGW) { const int it2 = it + NGW; const bool has2 = it2 < tot;
              const CvItem c1 = in_item(P, 0, it, WA, WAB, WG), c2 = in_item(P, 0, has2 ? it2 : it, WA, WAB, WG); transpose_pair(c1, c2, has2, scr, lane); } }
        { const int lane1 = tid_now() & 63; for (int r = gw; r < MM; r += NGW) norm_row_to_bf16(P.in[1] + (size_t)r * DM, MN + (size_t)r * DM, lane1); }
    }
    GRID_BAR();
    for (int l = 0; l < 2; ++l) {
        if (EN_G1) REP(1) {
          pg8::Gemm g{XN, WA, M, PA_COLS, DM}; pg8::StaticOrder S; S.init(M, PA_COLS, F.G, F.bid);
          pg8::EpiG1 E{ws, QS64, 0};
          pg8::gemm_phase<pg8::EpiG1, pg8::StaticOrder, true, true>(F.lds, g, S, E);
          if (l > 0) vm_phase(F, XN, WAB + (size_t)(4096 - PA_COLS) * DM, VM); }
        GRID_BAR();
        REP(10) rw::lin_phase(F, URW, VM, P.in[11] + l * RWC, P.in[23], l, LINB);
        GRID_BAR();
        { const int nS = F.G >> 1, nA = F.G - nS;
          if (F.bid < nS) {
            if (EN_SCAN) for (int gidx = F.bid; gidx < 128; gidx += nS) {
                rw::Args A{URW, LINB, VFIRST, ORW, GB, BVB, P.in[11] + l * RWC, P.in[12] + l * 512, P.in[13] + (size_t)l * 64 * 512, P.in[14] + l * 512, P.in[15] + (size_t)l * 64 * 512,
                           P.in[16] + (size_t)l * 128 * 512, P.in[17] + l * 512, P.in[18] + l * 512, P.in[19] + l * 512, P.in[23], P.in[24], P.in[25], l};
#ifdef SCAN_L8
                rw::scan_unit_l8(A, gidx, (RW_LAS unsigned char*)F.lds);
#else
                rw::scan_unit(A, gidx, (RW_LAS unsigned char*)F.lds);
#endif
            }
          } else {
            const int ia = F.bid - nS;
            { pg8::Gemm g{XN, WAB, M, 4096 - PA_COLS, DM}; pg8::StaticOrder S; S.init(M, 4096 - PA_COLS, nA, ia);
              pg8::EpiG1 E{ws, QS64, PA_COLS / 256};
              pg8::gemm_phase<pg8::EpiG1, pg8::StaticOrder, true, true>(F.lds, g, S, E); }
            sub_barrier((unsigned*)(ws + WS_CTL) + 512 + 64 * l, (unsigned)nA);
            if (EN_ATTN) for (int j = ia; j < 128; j += nA) {
                const int bh = j & 63, par = j >> 6, b = bh >> 3, h = bh & 7;
                for (int i = 0; i < 4; ++i) {
                    const int qb = par == 0 ? (i == 0 ? 7 : i == 1 ? 4 : i == 2 ? 3 : 0) : (i == 0 ? 6 : i == 1 ? 5 : i == 2 ? 2 : 1);
                    const size_t rb = (size_t)b * SEQ;
                    at::Ten T{MQ + rb * 512 + h * 64, 512, MK + rb * 512 + h * 64, MV + rb * 512 + h * 64, 512, MQ + rb * 512 + h * 64, 512};
                    at::attn_unit<64, 0>(T, qb * 256, 0, 0, 0.f, KM + (size_t)b * 8 * 512 + h * 64, (at::lds_ptr)F.lds);
                }
                for (int i = 0; i < 4; ++i) {
                    const int un = j * 4 + i, qb = un & 7, hq = (un >> 3) & 7, b2 = un >> 6; const size_t rb = (size_t)b2 * SEQ;
                    at::Ten T{SQ + rb * 512 + hq * 64, 512, SK + rb * 128 + (hq >> 2) * 64, SV + rb * 128 + (hq >> 2) * 64, 128, SQ + rb * 512 + hq * 64, 512};
                    const int kt0 = qb == 0 ? 0 : 4 * qb - 2, ntl = 4 * qb + 4 - kt0;
                    at::attn_unit<64, 1>(T, qb * 256, kt0, ntl, P.in[26][l * 8 + hq] * LOG2E, nullptr, (at::lds_ptr)F.lds);
                }
            }
            { LAS float* scr = (LAS float*)(F.lds + F.wave * 16384); const int lane = tid_now() & 63, nw = nA * NWAVES;
              for (int it = ia * NWAVES + F.wave; it < 2048; it += 2 * nw) { const int it2 = it + nw; const bool has2 = it2 < 2048;
                  const CvItem c1 = tail_item(P, l, it, WBR, WOUT, WXQ, WKV), c2 = tail_item(P, l, has2 ? it2 : it, WBR, WOUT, WXQ, WKV);
                  transpose_pair(c1, c2, has2, scr, lane); } }
          } }
        GRID_BAR();
        if (EN_P3) { pg8::Gemm g{XN, WG, M, 3072, DM}; pg8::StaticOrder S; S.init(M, 3072, F.G, F.bid);
          pg8::EpiStore<2> E{GATE, 3072, 1.f};
          REP(2) pg8::gemm_phase<pg8::EpiStore<2>, pg8::StaticOrder, true, true>(F.lds, g, S, E);
          rw::post_phase(F, ORW, GB, BVB, P.in[20] + l * 512, P.in[21] + l * 512);
          { const int g0_ = gtid;
#pragma unroll
          for (int k_ = 0; k_ < 4; ++k_) { const int i = g0_ + k_ * GT; if (i < 64 * 512) KM[i] = 0.f; } }     }
        GRID_BAR();
        if (EN_P4) { { pg8::Gemm g{MQ, WBR, 3 * M, 3072, 512}; pg8::ThreePassOrder S; S.init(M, F.G, F.bid);
              pg8::EpiZ3 E{ZB, GATE, (bf16*)(ws + WS_G)};
              pg8::gemm_phase<pg8::EpiZ3, pg8::ThreePassOrder, true, true>(F.lds, g, S, E); }
 }
        GRID_BAR();
        if (EN_REST & 1) {
          if (F.G == 256) {
            pg8::Gemm g{ZB, WOUT, M, DM, DM}; pg8::StaticOrder S; S.init(M, DM, F.G, F.bid);
            pg8::PanelRms s1{(unsigned*)(ws + WS_XB), (unsigned)(l * 6 + 0 + 1)}, s2{(unsigned*)(ws + WS_XB + 512 * 1024), (unsigned)(l * 6 + 1 + 1)};
            pg8::EpiRmsResRms E{XN, RS, nullptr, P.in[4] + l * DM, s1, s2};
            pg8::gemm_phase<pg8::EpiRmsResRms, pg8::StaticOrder, false, true>(F.lds, g, S, E);
          } else {
            { pg8::Gemm g{ZB, WOUT, M, DM, DM}; pg8::StaticOrder S; S.init(M, DM, F.G, F.bid);
              pg8::EpiStore<0> E{Y, DM, 1.f};
              pg8::gemm_phase<pg8::EpiStore<0>, pg8::StaticOrder, true, true>(F.lds, g, S, E); }
            GRID_BAR();
            row_phase(F, XN, RS, Y, P.in[4] + l * DM, nullptr);
          } }
        GRID_BAR();
        if (EN_REST & 4) {
          pg8::Gemm g{XN, WXQ, M, 512, DM}; pg8::StaticOrder S; S.init(M, 512, F.G, F.bid);
          pg8::EpiStore<0> E{QX, 512, QS128};
          REP(5) pg8::gemm_phase<pg8::EpiStore<0>, pg8::StaticOrder, true, true>(F.lds, g, S, E);
          { pg8::Gemm g2{MN, WKV, MM, DM, DM}; pg8::StaticOrder S2; int c2 = F.bid + 128; if (c2 >= F.G) c2 -= F.G; S2.init(MM, DM, F.G, c2);
            pg8::EpiKV E2{(bf16*)(ws + WS_MEMKV), (bf16*)(ws + WS_MEMKV + 2 * MiB)};
            pg8::gemm_phase<pg8::EpiKV, pg8::StaticOrder, true, true>(F.lds, g2, S2, E2); }
          { const bool split = (F.G == 256); const int nlate = 4352, tot = nlate + (l == 0 ? in_items(1) : 0), nI = split ? (l == 0 ? 5800 : tot) : 0;
            int first, last, w0, nwv;
            if (split && F.bid >= 160) { first = 0; last = nI; w0 = (F.bid - 160) * NWAVES + F.wave; nwv = 96 * NWAVES; }
            else { first = nI; last = tot; w0 = F.bid * NWAVES + F.wave; nwv = (split ? 160 : F.G) * NWAVES; }
            LAS float* scr = (LAS float*)(F.lds + F.wave * 16384); const int lane = tid_now() & 63;
            for (int it = first + w0; it < last; it += 2 * nwv) { const int it2r = it + nwv; const bool has2 = it2r < last; const int it2 = has2 ? it2r : it;
                const CvItem c1 = (it < nlate) ? late_item(P, l, it, WXO, WUP, WDN) : in_item(P, 1, it - nlate, WA, WAB, WG);
                const CvItem c2 = (it2 < nlate) ? late_item(P, l, it2, WXO, WUP, WDN) : in_item(P, 1, it2 - nlate, WA, WAB, WG);
                transpose_pair(c1, c2, has2, scr, lane); } } }
        GRID_BAR();
        if (EN_XATTN) REP(9) for (int un = F.bid; un < 256; un += F.G) { const int qb = un & 7, h = (un >> 3) & 3, b = un >> 5;
            const bf16* Kx = (const bf16*)(ws + WS_MEMKV) + (size_t)b * MEMLEN * 512 + h * 128; const bf16* Vx = Kx + MiB;
            bf16* Odst = (((DUPMASK >> 9) & 1) && rep_ == 0) ? (bf16*)(ws + 152 * MiB) : QX;
            at::Ten T{QX + (size_t)b * SEQ * 512 + h * 128, 512, Kx, Vx, 512, Odst + (size_t)b * SEQ * 512 + h * 128, 512};
            at::attn_unit<128, 2>(T, qb * 256, 0, 4, 0.f, nullptr, (at::lds_ptr)F.lds); }
        GRID_BAR();
        if (EN_REST & 8) {
          if (F.G == 256) {
            pg8::Gemm g{QX, WXO, M, DM, 512}; pg8::StaticOrder S; S.init(M, DM, F.G, F.bid);
            pg8::PanelRms s1{(unsigned*)(ws + WS_XB), (unsigned)(l * 6 + 2 + 1)}, s2{(unsigned*)(ws + WS_XB + 512 * 1024), (unsigned)(l * 6 + 3 + 1)};
            pg8::EpiRmsResRms E{XN, RS, nullptr, P.in[6] + l * DM, s1, s2};
            pg8::gemm_phase<pg8::EpiRmsResRms, pg8::StaticOrder, false, true>(F.lds, g, S, E);
          } else {
            { pg8::Gemm g{QX, WXO, M, DM, 512}; pg8::StaticOrder S; S.init(M, DM, F.G, F.bid);
              pg8::EpiStore<0> E{Y, DM, 1.f};
              pg8::gemm_phase<pg8::EpiStore<0>, pg8::StaticOrder, true, true>(F.lds, g, S, E); }
            GRID_BAR();
            row_phase(F, XN, RS, Y, P.in[6] + l * DM, nullptr);
          } }
        GRID_BAR();
        if (EN_REST & 32) { pg8::Gemm g{XN, WUP, M, FFD, DM}; pg8::StaticOrder S; S.init(M, FFD, F.G, F.bid);
          pg8::EpiStore<1> E{HMID, FFD, 1.f};
          REP(7) pg8::gemm_phase<pg8::EpiStore<1>, pg8::StaticOrder, true, true>(F.lds, g, S, E); }
        GRID_BAR();
        if (EN_REST & 64) {
          if (F.G == 256) {
            pg8::Gemm g{HMID, WDN, M, DM, FFD}; pg8::StaticOrder S; S.init(M, DM, F.G, F.bid);
            pg8::PanelRms s1{(unsigned*)(ws + WS_XB), (unsigned)(l * 6 + 4 + 1)}, s2{(unsigned*)(ws + WS_XB + 512 * 1024), (unsigned)(l * 6 + 5 + 1)};
            pg8::EpiRmsResRms E{XN, RS, (l == 0) ? (float*)nullptr : P.out, P.in[9] + l * DM, s1, s2};
            pg8::gemm_phase<pg8::EpiRmsResRms, pg8::StaticOrder, false, true>(F.lds, g, S, E);
          } else {
            { pg8::Gemm g{HMID, WDN, M, DM, FFD}; pg8::StaticOrder S; S.init(M, DM, F.G, F.bid);
              pg8::EpiStore<0> E{Y2, DM, 1.f};
              pg8::gemm_phase<pg8::EpiStore<0>, pg8::StaticOrder, true, true>(F.lds, g, S, E); }
            GRID_BAR();
            row_phase(F, XN, RS, Y2, P.in[9] + l * DM, (l == 0) ? (float*)nullptr : P.out);
          } }
        if (l == 0) GRID_BAR();
    }
#ifdef DIAG_PHASE
    GRID_BAR();
    if (F.bid == 0 && threadIdx.x == 0) { volatile LAS unsigned long long* ts = (volatile LAS unsigned long long*)(F.lds + LDSCTL_OFF + 512);
        const unsigned long long d = ts[DIAG_PHASE + 1] - ts[DIAG_PHASE]; const float us = (float)d * 0.01f; P.out[0] = 12.f + fminf(fmaxf((us - (float)(DIAG_BASE)) * (1.f / (float)(DIAG_STEP)), 0.f), 89.f); }
#endif
}

static int launch_mega(void* const* d_in, void* d_out, void* d_ws, hipStream_t stream) {
    static int grid = 0;
    if (grid == 0) {
        int dev = 0, cus = 0, per_cu = 0;
        if (hipGetDevice(&dev) != hipSuccess || hipDeviceGetAttribute(&cus, hipDeviceAttributeMultiprocessorCount, dev) != hipSuccess) { fprintf(stderr, "device query failed\n"); grid = -1; return -1; }
        if (hipFuncSetAttribute((const void*)fwd_megakernel, hipFuncAttributeMaxDynamicSharedMemorySize, LDS_BYTES) != hipSuccess) { fprintf(stderr, "hipFuncSetAttribute failed\n"); grid = -1; return -1; }
        if (hipOccupancyMaxActiveBlocksPerMultiprocessor(&per_cu, (const void*)fwd_megakernel, NT, LDS_BYTES) != hipSuccess || per_cu < 1) { fprintf(stderr, "occupancy query: %d\n", per_cu); per_cu = 1; }
        (void)hipGetLastError();
        grid = cus;
    }
    if (grid < 0) return -1;
    (void)hipMemsetAsync((char*)d_ws + WS_CTL, 0, CTL_ZERO_BYTES, stream);
    Params p{};
    for (int i = 0; i < 35; ++i) p.in[i] = (const float*)d_in[i];
    p.out = (float*)d_out; p.ws = (unsigned char*)d_ws;
    hipLaunchKernelGGL(fwd_megakernel, dim3(grid), dim3(NT), LDS_BYTES, stream, p);
    return 0;
}

extern "C" void kernel_launch(void* const* d_in, const int* in_sizes, int n_in, void* d_out, int out_size, void* d_ws, size_t ws_size, hipStream_t stream) {
    launch_mega(d_in, d_out, d_ws, stream);
}
```

```cpp
#include <hip/hip_runtime.h>
#include <cstdio>
#include <cstdint>
#include <cmath>
#define SCAN_L8 1
namespace pg8 {
#define PG8_LAS __attribute__((address_space(3)))
typedef unsigned short bf16_t;
typedef short bf16x8 __attribute__((ext_vector_type(8)));
typedef float f32x4 __attribute__((ext_vector_type(4)));
typedef unsigned u32x4 __attribute__((ext_vector_type(4)));
constexpr int BM = 256, BK = 64, HALF = 128, HTB = HALF * BK * 2  , STAGE_BYTES = 8 * HTB, NXCD = 8, WGM = 8;

__host__ __device__ __forceinline__ int lds_byte(int r, int c) { const int st = (r >> 4) * 2 + (c >> 5), rr = r & 15, cc = c & 31, ob = rr * 64 + cc * 2; return st * 1024 + (ob ^ (((ob >> 9) & 1) << 5)); }
__host__ __device__ __forceinline__ void stage_rc(int b, int& R, int& C) { const int st = b / 1024, sb = b % 1024, swz = sb ^ (((sb >> 9) & 1) << 5); R = (st >> 1) * 16 + swz / 64; C = (st & 1) * 32 + (swz % 64) / 2; }
__host__ __device__ __forceinline__ int perm32(int rho) { const int n = rho >> 4, i = rho & 15; return 8 * (i >> 2) + 4 * n + (i & 3); }

__device__ __forceinline__ void st16(void* p, u32x4 v) { asm volatile("global_store_dwordx4 %0, %1, off sc1\n\ts_nop 1" :: "v"(p), "v"(v) : "memory"); }
#define PG8_SWAP32(lo_, hi_, x_) unsigned lo_, hi_; { auto p_ = __builtin_amdgcn_permlane32_swap(__builtin_bit_cast(unsigned, x_), __builtin_bit_cast(unsigned, x_), false, false); lo_ = p_[0]; hi_ = p_[1]; asm volatile("" : "+v"(lo_), "+v"(hi_)); }
__device__ __forceinline__ float xsum_32(float x) { PG8_SWAP32(b0, b1, x); return __builtin_bit_cast(float, b0) + __builtin_bit_cast(float, b1); }
__device__ __forceinline__ float xmax_32(float x) { PG8_SWAP32(b0, b1, x); return fmaxf(__builtin_bit_cast(float, b0), __builtin_bit_cast(float, b1)); }
struct Unit { int pm, pn; };
struct Gemm { const bf16_t* A; const bf16_t* Bt; int M, N, K; };

struct StaticOrder {
    int nM, nN, nwg, G, c;
    __host__ __device__ void init(int M, int N, int G_, int c_) { nM = M / BM; nN = N / BM; nwg = nM * nN; G = G_; c = c_; }
    __host__ __device__ bool next(int i, Unit& u) const {
        const long L = (long)i * G + c; if (L >= nwg) return false;
        int wgid = (int)L; { const int q = nwg / NXCD, r = nwg % NXCD, xcd = wgid % NXCD, off = wgid / NXCD; wgid = (xcd < r ? xcd * (q + 1) : r * (q + 1) + (xcd - r) * q) + off; }
        const int nig = WGM * nN, gid = wgid / nig, fm = gid * WGM, gsz = (nM - fm) < WGM ? (nM - fm) : WGM;
        u.pm = fm + ((wgid % nig) % gsz); u.pn = (wgid % nig) / gsz; return true;
    }
    __device__ __forceinline__ void a_ready(const Unit&) const {}
    __device__ __forceinline__ void done(const Unit&) const {}
};

typedef float f32x2 __attribute__((ext_vector_type(2))); typedef __bf16 bf16x2p __attribute__((ext_vector_type(2)));
__device__ __forceinline__ unsigned cvt_pk_bf16(float lo, float hi) { f32x2 v = {lo, hi}; bf16x2p b = __builtin_convertvector(v, bf16x2p); return __builtin_bit_cast(unsigned, b); }
typedef unsigned u32x2e __attribute__((ext_vector_type(2)));
__device__ __forceinline__ u32x4 pack8(const f32x4 a, const f32x4 b) { u32x4 w; w.x = cvt_pk_bf16(a[0], a[1]); w.y = cvt_pk_bf16(a[2], a[3]); w.z = cvt_pk_bf16(b[0], b[1]); w.w = cvt_pk_bf16(b[2], b[3]); return w; }
__device__ __forceinline__ float bf_lo(unsigned w) { return __builtin_bit_cast(float, w << 16); }
__device__ __forceinline__ float bf_hi(unsigned w) { return __builtin_bit_cast(float, w & 0xffff0000u); }
__device__ __forceinline__ float fsigm(float x) { return __builtin_amdgcn_rcpf(1.f + __builtin_amdgcn_exp2f(-1.4426950408889634f * x)); }

typedef float f32x2e __attribute__((ext_vector_type(2))); typedef __bf16 bf16x2e __attribute__((ext_vector_type(2)));
__device__ __forceinline__ unsigned cvt2c(float lo, float hi) { f32x2e v = {lo, hi}; bf16x2e b = __builtin_convertvector(v, bf16x2e); return __builtin_bit_cast(unsigned, b); }
__device__ __forceinline__ u32x4 pack8c(const f32x4 a, const f32x4 b) { u32x4 w; w.x = cvt2c(a[0], a[1]); w.y = cvt2c(a[2], a[3]); w.z = cvt2c(b[0], b[1]); w.w = cvt2c(b[2], b[3]); return w; }
__device__ __forceinline__ int img_lane(int wr, int wc, int fr, int fq) { int o = (wr * 4 + wc) * 64 + fq * 16 + fr; asm volatile("" : "+v"(o)); return o; }
__device__ __forceinline__ int img16(int ai, int m, int bj, int lo) { return ((ai * 4 + m) * 2 + bj) * 512 + lo; }
template <int ACT> struct EpiStore {
    static constexpr bool PERM = true, AFTER_DRAIN = false;
    bf16_t* O; int ldc; float scale;
    __device__ __forceinline__ void operator()(const f32x4 (&acc)[2][2][4][2], const Unit& u, int wr, int wc, int fr, int fq) const {
        const int row0 = u.pm * BM + wr * 64 + fr, col0 = u.pn * BM + wc * 32 + 8 * fq; const int ilo = (ACT == 2) ? img_lane(wr, wc, fr, fq) : 0;
#pragma unroll
        for (int ai = 0; ai < 2; ++ai)
#pragma unroll
            for (int m = 0; m < 4; ++m) { bf16_t* rowp = O + (size_t)(row0 + ai * HALF + m * 16) * ldc + col0;
#pragma unroll
                for (int bj = 0; bj < 2; ++bj) { f32x4 v0 = acc[ai][bj][m][0], v1 = acc[ai][bj][m][1];
                    if (ACT == 1) {
#pragma unroll
                        for (int e = 0; e < 4; ++e) { float a = fmaxf(v0[e], 0.f), b = fmaxf(v1[e], 0.f); v0[e] = a * a; v1[e] = b * b; } }
                    if (ACT == 2) {
#pragma unroll
                        for (int e = 0; e < 4; ++e) { v0[e] = fsigm(v0[e]); v1[e] = fsigm(v1[e]); } }
                    if (ACT == 0) { v0 = v0 * scale; v1 = v1 * scale; }
                    if (ACT == 1) st16(rowp + bj * HALF, pack8(v0, v1));
                    else if (ACT == 2) ((u32x4*)O)[(size_t)(u.pm * 12 + u.pn) * 8192 + img16(ai, m, bj, ilo)] = pack8c(v0, v1);
                    else *(u32x4*)(rowp + bj * HALF) = pack8(v0, v1); } }
    }
};
struct EpiKV {
    static constexpr bool PERM = true, AFTER_DRAIN = false;
    bf16_t* Kd; bf16_t* Vd;
    __device__ __forceinline__ void operator()(const f32x4 (&acc)[2][2][4][2], const Unit& u, int wr, int wc, int fr, int fq) const {
        bf16_t* O = (u.pn >= 2) ? Vd : Kd; const int row0 = u.pm * BM + wr * 64 + fr, col0 = (u.pn & 1) * BM + wc * 32 + 8 * fq;
#pragma unroll
        for (int ai = 0; ai < 2; ++ai)
#pragma unroll
            for (int m = 0; m < 4; ++m) { bf16_t* rowp = O + (size_t)(row0 + ai * HALF + m * 16) * 512 + col0;
#pragma unroll
                for (int bj = 0; bj < 2; ++bj) *(u32x4*)(rowp + bj * HALF) = pack8(acc[ai][bj][m][0], acc[ai][bj][m][1]); }
    }
};
struct ThreePassOrder {
    StaticOrder base;
    __host__ __device__ void init(int M, int G_, int c_) { base.init(M, 1024, G_, c_); }
    __host__ __device__ bool next(int i, Unit& u) const { Unit t; if (!base.next(i / 3, t)) return false; const int n = i % 3; u.pm = t.pm + 64 * (n == 0 ? 2 : n - 1); u.pn = t.pn + 4 * n; return true; }
    __device__ __forceinline__ void a_ready(const Unit&) const {}
    __device__ __forceinline__ void done(const Unit&) const {}
};
struct EpiZ3 {
    static constexpr bool PERM = true, AFTER_DRAIN = false;
    bf16_t* ZB; const bf16_t* GATE; bf16_t* ZT;
    __device__ __forceinline__ void operator()(const f32x4 (&acc)[2][2][4][2], const Unit& u, int wr, int wc, int fr, int fq) const {
        const int n = u.pn >> 2, pm = u.pm & 63, pn = u.pn & 3, row0 = pm * BM + wr * 64 + fr, col0 = pn * BM + wc * 32 + 8 * fq;
        const bool rmw = n != 0; const int ilo = img_lane(wr, wc, fr, fq);
        const u32x4* gimg = (const u32x4*)GATE + (size_t)(pm * 12 + n * 4 + pn) * 8192; u32x4* zimg = (u32x4*)ZT + (size_t)(pm * 4 + pn) * 8192;
#pragma unroll
        for (int ai = 0; ai < 2; ++ai) {
            u32x4 gq[4][2], zq[4][2];
#pragma unroll
            for (int m = 0; m < 4; ++m)
#pragma unroll
                for (int bj = 0; bj < 2; ++bj) gq[m][bj] = gimg[img16(ai, m, bj, ilo)];
            if (rmw) {
#pragma unroll
                for (int m = 0; m < 4; ++m)
#pragma unroll
                    for (int bj = 0; bj < 2; ++bj) zq[m][bj] = zimg[img16(ai, m, bj, ilo)];
            } else {
#pragma unroll
                for (int m = 0; m < 4; ++m)
#pragma unroll
                    for (int bj = 0; bj < 2; ++bj) zq[m][bj] = (u32x4){0u, 0u, 0u, 0u};
            }
#pragma unroll
            for (int m = 0; m < 4; ++m)
#pragma unroll
                for (int bj = 0; bj < 2; ++bj) { const u32x4 g = gq[m][bj], z = zq[m][bj];
                    f32x4 v0 = acc[ai][bj][m][0], v1 = acc[ai][bj][m][1];
                    v0[0] = v0[0] * bf_lo(g.x) + bf_lo(z.x); v0[1] = v0[1] * bf_hi(g.x) + bf_hi(z.x); v0[2] = v0[2] * bf_lo(g.y) + bf_lo(z.y); v0[3] = v0[3] * bf_hi(g.y) + bf_hi(z.y);
                    v1[0] = v1[0] * bf_lo(g.z) + bf_lo(z.z); v1[1] = v1[1] * bf_hi(g.z) + bf_hi(z.z); v1[2] = v1[2] * bf_lo(g.w) + bf_lo(z.w); v1[3] = v1[3] * bf_hi(g.w) + bf_hi(z.w);
                    gq[m][bj] = pack8(v0, v1); }
            if (n == 2) {
#pragma unroll
                for (int m = 0; m < 4; ++m)
#pragma unroll
                    for (int bj = 0; bj < 2; ++bj) *(u32x4*)(ZB + (size_t)(row0 + ai * HALF + m * 16) * 1024 + col0 + bj * HALF) = gq[m][bj];
            } else {
#pragma unroll
                for (int m = 0; m < 4; ++m)
#pragma unroll
                    for (int bj = 0; bj < 2; ++bj) zimg[img16(ai, m, bj, ilo)] = gq[m][bj];
            }
        }
    }
};
struct EpiZ {
    static constexpr bool PERM = true, AFTER_DRAIN = false;
    bf16_t* ZB; const bf16_t* GATE; int goff; int first;
    __device__ __forceinline__ void operator()(const f32x4 (&acc)[2][2][4][2], const Unit& u, int wr, int wc, int fr, int fq) const {
        const int row0 = u.pm * BM + wr * 64 + fr, col0 = u.pn * BM + wc * 32 + 8 * fq;
#pragma unroll
        for (int ai = 0; ai < 2; ++ai)
#pragma unroll
            for (int m = 0; m < 4; ++m) { const size_t r = (size_t)(row0 + ai * HALF + m * 16);
#pragma unroll
                for (int bj = 0; bj < 2; ++bj) { const int c = col0 + bj * HALF;
                    const u32x4 g = *(const u32x4*)(GATE + r * 3072 + goff + c);
                    f32x4 v0 = acc[ai][bj][m][0], v1 = acc[ai][bj][m][1];
                    v0[0] *= bf_lo(g.x); v0[1] *= bf_hi(g.x); v0[2] *= bf_lo(g.y); v0[3] *= bf_hi(g.y);
                    v1[0] *= bf_lo(g.z); v1[1] *= bf_hi(g.z); v1[2] *= bf_lo(g.w); v1[3] *= bf_hi(g.w);
                    bf16_t* zp = ZB + r * 1024 + c;
                    if (!first) { const u32x4 z = *(const u32x4*)zp;
                        v0[0] += bf_lo(z.x); v0[1] += bf_hi(z.x); v0[2] += bf_lo(z.y); v0[3] += bf_hi(z.y);
                        v1[0] += bf_lo(z.z); v1[1] += bf_hi(z.z); v1[2] += bf_lo(z.w); v1[3] += bf_hi(z.w); }
                    *(u32x4*)zp = pack8(v0, v1); } }
    }
};
constexpr size_t G1_MiB = 1u << 20, G1_KM = 1 * G1_MiB + 512 * 1024, G1_ROPE = 2 * G1_MiB, G1_URW = 72 * G1_MiB, G1_MK = 128 * G1_MiB, G1_MV = 144 * G1_MiB, G1_SK = 160 * G1_MiB, G1_SV = 164 * G1_MiB,
                 G1_MQ = 168 * G1_MiB, G1_SQ = 184 * G1_MiB, G1_VM = 254 * G1_MiB;
struct EpiG1 {
    static constexpr bool PERM = true, AFTER_DRAIN = false;
    unsigned char* ws; float qscale; int pn0;
    __device__ __forceinline__ void operator()(const f32x4 (&acc)[2][2][4][2], const Unit& u, int wr, int wc, int fr, int fq) const {
        const int pn = u.pn + pn0, row0 = u.pm * BM + wr * 64 + fr, cw = wc * 32 + 8 * fq;
        bf16_t* const URW = (bf16_t*)(ws + G1_URW); bf16_t* const MQ = (bf16_t*)(ws + G1_MQ); bf16_t* const MK = (bf16_t*)(ws + G1_MK); bf16_t* const MV = (bf16_t*)(ws + G1_MV);
        bf16_t* const SQ = (bf16_t*)(ws + G1_SQ); bf16_t* const SK = (bf16_t*)(ws + G1_SK); bf16_t* const SV = (bf16_t*)(ws + G1_SV); bf16_t* const VM = (bf16_t*)(ws + G1_VM);
        float* const KM = (float*)(ws + G1_KM); const float* const ROPE = (const float*)(ws + G1_ROPE);
        float ks[2][8];
#pragma unroll
        for (int bj = 0; bj < 2; ++bj)
#pragma unroll
            for (int e = 0; e < 8; ++e) ks[bj][e] = 0.f;
#pragma unroll
        for (int bj = 0; bj < 2; ++bj) {
            bf16_t* dst; int ldc, col, mode;
            const int ct = bj * HALF + cw;
            if (pn < 7) { dst = URW; ldc = 1792; col = pn * 256 + ct; mode = 0; }
            else if (pn < 9) { dst = MQ; ldc = 512; col = (pn - 7) * 256 + ct; mode = 2; }
            else if (pn < 11) { dst = MK; ldc = 512; col = (pn - 9) * 256 + ct; mode = 1; }
            else if (pn < 13) { dst = MV; ldc = 512; col = (pn - 11) * 256 + ct; mode = 0; }
            else if (pn < 15) { dst = SQ; ldc = 512; col = (pn - 13) * 256 + ct; mode = 2; }
            else if (pn == 15) { if (bj == 0) { dst = SK; ldc = 128; col = cw; mode = 1; } else { dst = SV; ldc = 128; col = cw; mode = 0; } }
            else { dst = VM; ldc = 32; col = ct; mode = (ct < 32) ? 0 : 3; }
            if (mode == 3) continue;
            const int i0 = (col & 63) >> 1;
#pragma unroll
            for (int ai = 0; ai < 2; ++ai) {
                f32x4 rc[4][2];
                if (mode != 0) {
#pragma unroll
                    for (int m = 0; m < 4; ++m) { const size_t r = (size_t)(row0 + ai * HALF + m * 16);
                        rc[m][0] = *(const f32x4*)(ROPE + (r * 32 + i0) * 2); rc[m][1] = *(const f32x4*)(ROPE + (r * 32 + i0) * 2 + 4); }
                } else {
#pragma unroll
                    for (int m = 0; m < 4; ++m) { rc[m][0] = (f32x4){1.f, 0.f, 1.f, 0.f}; rc[m][1] = (f32x4){1.f, 0.f, 1.f, 0.f}; }
                }
#pragma unroll
                for (int m = 0; m < 4; ++m) { const size_t r = (size_t)(row0 + ai * HALF + m * 16);
                    f32x4 v0 = acc[ai][bj][m][0], v1 = acc[ai][bj][m][1];
                    if (mode != 0) {
                        const f32x4 c0 = rc[m][0], c1 = rc[m][1];
                        f32x4 o0, o1;
                        o0[0] = v0[0] * c0[0] - v0[1] * c0[1]; o0[1] = v0[1] * c0[0] + v0[0] * c0[1];
                        o0[2] = v0[2] * c0[2] - v0[3] * c0[3]; o0[3] = v0[3] * c0[2] + v0[2] * c0[3];
                        o1[0] = v1[0] * c1[0] - v1[1] * c1[1]; o1[1] = v1[1] * c1[0] + v1[0] * c1[1];
                        o1[2] = v1[2] * c1[2] - v1[3] * c1[3]; o1[3] = v1[3] * c1[2] + v1[2] * c1[3];
                        v0 = o0; v1 = o1;
                        if (mode == 2) { v0 = v0 * qscale; v1 = v1 * qscale; }
                        if (pn == 9 || pn == 10) {
#pragma unroll
                            for (int e = 0; e < 4; ++e) { ks[bj][e] += v0[e]; ks[bj][4 + e] += v1[e]; } }
                    }
                    *(u32x4*)(dst + r * ldc + col) = pack8(v0, v1); }
            }
        }
        if (pn == 9 || pn == 10) {
#pragma unroll
            for (int bj = 0; bj < 2; ++bj)
#pragma unroll
                for (int e = 0; e < 8; ++e) { float s = ks[bj][e]; s += __shfl_xor(s, 1); s += __shfl_xor(s, 2); s += __shfl_xor(s, 4); s += __shfl_xor(s, 8);
                    if (fr == 0) atomicAdd(KM + (size_t)u.pm * 512 + (pn - 9) * 256 + bj * HALF + cw + e, s); }
        }
    }
};
struct PanelRms {
    unsigned* xbuf;
    unsigned tag;
    __device__ __forceinline__ void post(const f32x4 (&v)[2][2][4][2], const Unit& u, int wr, int wc, int fr, int fq, PG8_LAS unsigned char* lds, int wid, int lane) const {
        PG8_LAS float* P = (PG8_LAS float*)lds;
#pragma unroll
        for (int ai = 0; ai < 2; ++ai)
#pragma unroll
            for (int m = 0; m < 4; ++m) {
                float s = 0.f;
#pragma unroll
                for (int bj = 0; bj < 2; ++bj)
#pragma unroll
                    for (int n = 0; n < 2; ++n) { const f32x4 x = v[ai][bj][m][n]; s += (x[0] * x[0] + x[1] * x[1]) + (x[2] * x[2] + x[3] * x[3]); }
                s += __shfl_xor(s, 16); s += __shfl_xor(s, 32);
                if (fq == 0) P[(ai * HALF + wr * 64 + m * 16 + fr) * 4 + wc] = s;
            }
        asm volatile("s_waitcnt lgkmcnt(0)" ::: "memory"); __builtin_amdgcn_s_barrier(); asm volatile("" ::: "memory");
        const int row = wid * 32 + (lane & 31);
        if (lane < 32) {
            const float tot = (P[row * 4 + 0] + P[row * 4 + 1]) + (P[row * 4 + 2] + P[row * 4 + 3]);
            unsigned long long* slot = (unsigned long long*)xbuf + ((size_t)(u.pm * BM + row) * 4 + u.pn);
            __hip_atomic_store(slot, ((unsigned long long)tag << 32) | (unsigned long long)__float_as_uint(tot), __ATOMIC_RELAXED, __HIP_MEMORY_SCOPE_AGENT);
        }
    }
    __device__ __forceinline__ void finish(const Unit& u, PG8_LAS unsigned char* lds, int wid, int lane, float* rsw) const {
        PG8_LAS float* S = (PG8_LAS float*)(lds + 8192);
        const int row = wid * 32 + (lane & 31);
        unsigned long long* slot = (unsigned long long*)xbuf + (size_t)(u.pm * BM + row) * 4;
        unsigned long long w0, w1, w2, w3; bool ok; unsigned spins = 0;
        { const unsigned long long* rep = (const unsigned long long*)xbuf + (size_t)(u.pm * BM + wid * 32 + 31) * 4; unsigned sp2 = 0;
          for (;;) { bool rdy = true;
              if (lane < 4) rdy = (unsigned)(__hip_atomic_load(rep + lane, __ATOMIC_RELAXED, __HIP_MEMORY_SCOPE_AGENT) >> 32) == tag;
              if (__all(rdy)) break;
              if (++sp2 > 400000u) break;
              __builtin_amdgcn_s_sleep(2); } }
        for (;;) {
            w0 = __hip_atomic_load(slot + 0, __ATOMIC_RELAXED, __HIP_MEMORY_SCOPE_AGENT); w1 = __hip_atomic_load(slot + 1, __ATOMIC_RELAXED, __HIP_MEMORY_SCOPE_AGENT);
            w2 = __hip_atomic_load(slot + 2, __ATOMIC_RELAXED, __HIP_MEMORY_SCOPE_AGENT); w3 = __hip_atomic_load(slot + 3, __ATOMIC_RELAXED, __HIP_MEMORY_SCOPE_AGENT);
            ok = ((unsigned)(w0 >> 32) == tag) & ((unsigned)(w1 >> 32) == tag) & ((unsigned)(w2 >> 32) == tag) & ((unsigned)(w3 >> 32) == tag);
            if (__all(ok)) break;
            if (++spins > 400000u) break;
            __builtin_amdgcn_s_sleep(1);
        }
        if (lane < 32) {
            float q = (__uint_as_float((unsigned)w0) + __uint_as_float((unsigned)w1)) + (__uint_as_float((unsigned)w2) + __uint_as_float((unsigned)w3));
            if (!ok) q = __builtin_nanf("");
            const float ms = q * (1.0f / 1024.0f) + 1e-6f; S[row] = 1.0f / sqrtf(ms);
            if (rsw != nullptr && u.pn == 0) rsw[u.pm * BM + row] = sqrtf(ms);
        }
        asm volatile("s_waitcnt lgkmcnt(0)" ::: "memory"); __builtin_amdgcn_s_barrier(); asm volatile("" ::: "memory");
    }
};
struct EpiRmsResRms {
    static constexpr bool PERM = true, AFTER_DRAIN = true;
    bf16_t* xn; float* rs; float* out; const float* g; PanelRms st1, st2;
    __device__ __forceinline__ void fused(f32x4 (&acc)[2][2][4][2], const Unit& u, int wr, int wc, int fr, int fq, PG8_LAS unsigned char* lds, int wid, int lane) const {
        const PG8_LAS float* S = (const PG8_LAS float*)(lds + 8192);
        const int col0 = u.pn * BM + wc * 32 + 8 * fq;
        st1.post(acc, u, wr, wc, fr, fq, lds, wid, lane);
        st1.finish(u, lds, wid, lane, nullptr);
        f32x4 gv[2][2];
#pragma unroll
        for (int bj = 0; bj < 2; ++bj)
#pragma unroll
            for (int n = 0; n < 2; ++n) gv[bj][n] = *(const f32x4*)(g + col0 + bj * HALF + n * 4);
#pragma unroll
        for (int ai = 0; ai < 2; ++ai)
#pragma unroll
            for (int m = 0; m < 4; ++m) { const int r = ai * HALF + wr * 64 + m * 16 + fr; const float sr = S[r]; const float ro = rs[u.pm * BM + r]; const size_t off = (size_t)(u.pm * BM + r) * 1024 + col0;
#pragma unroll
                for (int bj = 0; bj < 2; ++bj) { const u32x4 w = *(const u32x4*)(xn + off + bj * HALF);
                    const f32x4 b0 = (f32x4){bf_lo(w.x), bf_hi(w.x), bf_lo(w.y), bf_hi(w.y)}, b1 = (f32x4){bf_lo(w.z), bf_hi(w.z), bf_lo(w.w), bf_hi(w.w)};
                    acc[ai][bj][m][0] = b0 * ro + acc[ai][bj][m][0] * sr * gv[bj][0]; acc[ai][bj][m][1] = b1 * ro + acc[ai][bj][m][1] * sr * gv[bj][1]; }
                asm volatile("" : "+v"(acc[ai][0][m][0]), "+v"(acc[ai][0][m][1]), "+v"(acc[ai][1][m][0]), "+v"(acc[ai][1][m][1]));
                if (m == 3) asm volatile("" ::: "memory"); }
        if (out != nullptr) {
#pragma unroll
            for (int ai = 0; ai < 2; ++ai)
#pragma unroll
                for (int m = 0; m < 4; ++m) { const int r = ai * HALF + wr * 64 + m * 16 + fr; const size_t off = (size_t)(u.pm * BM + r) * 1024 + col0;
#pragma unroll
                    for (int bj = 0; bj < 2; ++bj)
#pragma unroll
                        for (int n = 0; n < 2; ++n) *(f32x4*)(out + off + bj * HALF + n * 4) = acc[ai][bj][m][n]; }
            return; }
        st2.post(acc, u, wr, wc, fr, fq, lds, wid, lane);
        st2.finish(u, lds, wid, lane, rs);
#pragma unroll
        for (int ai = 0; ai < 2; ++ai)
#pragma unroll
            for (int m = 0; m < 4; ++m) { const int r = ai * HALF + wr * 64 + m * 16 + fr; const float sr = S[r]; const size_t off = (size_t)(u.pm * BM + r) * 1024 + col0;
#pragma unroll
                for (int bj = 0; bj < 2; ++bj) *(u32x4*)(xn + off + bj * HALF) = pack8(acc[ai][bj][m][0] * sr, acc[ai][bj][m][1] * sr);
                asm volatile("" ::: "memory"); }
    }
};
template <class Epi, class Sched, bool ALIGN_EPI = false, bool SP2 = false>
__device__ __forceinline__ void gemm_phase(PG8_LAS unsigned char* lds, const Gemm g, const Sched& S, const Epi& E) {
    int tid_ = threadIdx.x; asm volatile("" : "+v"(tid_));
    const int tid = tid_, wid = __builtin_amdgcn_readfirstlane(tid >> 6), lane = tid & 63, wr = wid >> 2, wc = wid & 3, fr = lane & 15, fq = lane >> 4;
    const int K = g.K, nt = K / BK;
    unsigned voffA[2], voffB[2];
#pragma unroll
    for (int i = 0; i < 2; ++i) { int R, C; stage_rc(tid * 16 + i * 8192, R, C); const int Rb = Epi::PERM ? ((R & ~31) + perm32(R & 31)) : R;
        voffA[i] = (unsigned)(R * K + C) * 2u; voffB[i] = (unsigned)(Rb * K + C) * 2u; }
    const size_t kstep = (size_t)(BK * 2);
    const size_t hstep = (size_t)HALF * K * 2;
    const size_t tstep = 2 * hstep;
    const unsigned ldsw = (unsigned)wid * 1024u;
    const int aoff = lds_byte(wr * 64 + fr, fq * 8), boff = lds_byte(wc * 32 + fr, fq * 8);
#define PG8_SA(b, h) (((b) * 2 + (h)) * HTB)
#define PG8_SB(b, h) ((4 + (b) * 2 + (h)) * HTB)
#define PG8_STAGE(bufoff, gbase, voff) do { _Pragma("unroll") for (int _i = 0; _i < 2; ++_i) \
        __builtin_amdgcn_global_load_lds((const unsigned*)((const char*)(gbase) + (voff)[_i]), (PG8_LAS unsigned*)(lds + (bufoff) + ldsw + _i * 8192), 16, 0, 0); } while (0)
#define PG8_LDA(dst, b, h) do { _Pragma("unroll") for (int m = 0; m < 4; ++m) _Pragma("unroll") for (int k = 0; k < 2; ++k) dst[m][k] = *(const PG8_LAS bf16x8*)(lds + PG8_SA(b, h) + aoff + m * 2048 + k * 1024); } while (0)
#define PG8_LDB(dst, b, h) do { _Pragma("unroll") for (int n = 0; n < 2; ++n) _Pragma("unroll") for (int k = 0; k < 2; ++k) dst[n][k] = *(const PG8_LAS bf16x8*)(lds + PG8_SB(b, h) + boff + n * 2048 + k * 1024); } while (0)
#define PG8_MMA(ai, bj, At, Bt) do { __builtin_amdgcn_s_setprio(1); _Pragma("unroll") for (int m = 0; m < 4; ++m) _Pragma("unroll") for (int n = 0; n < 2; ++n) _Pragma("unroll") for (int k = 0; k < 2; ++k) \
        acc[ai][bj][m][n] = __builtin_amdgcn_mfma_f32_16x16x32_bf16(Bt[n][k], At[m][k], acc[ai][bj][m][n], 0, 0, 0); __builtin_amdgcn_s_setprio(0); } while (0)
#define PG8_WAIT_V(n) asm volatile("s_waitcnt vmcnt(" #n ")" ::: "memory")
#define PG8_WAIT_L(n) asm volatile("s_waitcnt lgkmcnt(" #n ")" ::: "memory")
#define PG8_BAR __builtin_amdgcn_s_barrier()
#define PG8_SCHED __builtin_amdgcn_sched_barrier(0)
    Unit cur, nxt; int ui = 0;
    if (!S.next(0, cur)) return;
    f32x4 acc[2][2][4][2];
#pragma unroll
    for (int a = 0; a < 2; ++a)
#pragma unroll
        for (int b = 0; b < 2; ++b)
#pragma unroll
            for (int m = 0; m < 4; ++m)
#pragma unroll
                for (int n = 0; n < 2; ++n) acc[a][b][m][n] = (f32x4){0.f, 0.f, 0.f, 0.f};
    bf16x8 At[4][2], B0[2][2], B1[2][2];
    const char* cA = (const char*)g.A + (size_t)cur.pm * tstep; const char* cB = (const char*)g.Bt + (size_t)cur.pn * tstep;
    S.a_ready(cur);
    if constexpr (SP2) {
        PG8_STAGE(PG8_SB(0, 0), cB, voffB); PG8_STAGE(PG8_SB(0, 1), cB + hstep, voffB); PG8_STAGE(PG8_SA(0, 0), cA, voffA); PG8_STAGE(PG8_SA(0, 1), cA + hstep, voffA);
        if (wr == 1) PG8_BAR;
        PG8_WAIT_V(2); PG8_BAR;
        PG8_STAGE(PG8_SB(1, 0), cB + kstep, voffB); PG8_STAGE(PG8_SA(1, 0), cA + kstep, voffA); PG8_STAGE(PG8_SB(1, 1), cB + hstep + kstep, voffB);
        PG8_WAIT_V(6); PG8_BAR;
    } else {
        PG8_STAGE(PG8_SB(0, 0), cB, voffB); PG8_STAGE(PG8_SA(0, 0), cA, voffA); PG8_STAGE(PG8_SB(0, 1), cB + hstep, voffB); PG8_STAGE(PG8_SA(0, 1), cA + hstep, voffA);
        if (wr == 1) PG8_BAR;
        PG8_WAIT_V(4); PG8_BAR;
        PG8_STAGE(PG8_SB(1, 0), cB + kstep, voffB); PG8_STAGE(PG8_SA(1, 0), cA + kstep, voffA); PG8_STAGE(PG8_SB(1, 1), cB + hstep + kstep, voffB);
        PG8_WAIT_V(6); PG8_BAR;
    }
    for (;;) {
        const bool has_next = S.next(ui + 1, nxt);
        const char* nA = has_next ? (const char*)g.A + (size_t)nxt.pm * tstep : cA; const char* nB = has_next ? (const char*)g.Bt + (size_t)nxt.pn * tstep : cB;
        for (int t = 0; t < nt; t += 2) {
            const bool last = (t == nt - 2);
            const char* a1 = cA + (size_t)(t + 1) * kstep;
            const char* a2 = last ? nA : cA + (size_t)(t + 2) * kstep; const char* b2 = last ? nB : cB + (size_t)(t + 2) * kstep;
            const char* a3 = a2 + kstep; const char* b3 = b2 + kstep;
            if (last && has_next) S.a_ready(nxt);
            if constexpr (SP2) {
            PG8_LDB(B0, 0, 0); PG8_LDB(B1, 0, 1); PG8_SCHED; PG8_LDA(At, 0, 0); PG8_STAGE(PG8_SA(1, 1), a1 + hstep, voffA);
            PG8_WAIT_V(8); PG8_WAIT_L(0); PG8_BAR; PG8_MMA(0, 0, At, B0); PG8_MMA(0, 1, At, B1); PG8_BAR; PG8_SCHED;
            PG8_LDA(At, 0, 1); PG8_STAGE(PG8_SB(0, 0), b2, voffB); PG8_STAGE(PG8_SB(0, 1), b2 + hstep, voffB); PG8_STAGE(PG8_SA(0, 0), a2, voffA);
            PG8_WAIT_V(8); PG8_WAIT_L(0); PG8_BAR; PG8_MMA(1, 0, At, B0); PG8_MMA(1, 1, At, B1); PG8_BAR; PG8_SCHED;
            PG8_LDB(B0, 1, 0); PG8_LDB(B1, 1, 1); PG8_SCHED; PG8_LDA(At, 1, 0); PG8_STAGE(PG8_SA(0, 1), a2 + hstep, voffA);
            PG8_WAIT_V(8); PG8_WAIT_L(0); PG8_BAR; PG8_MMA(0, 0, At, B0); PG8_MMA(0, 1, At, B1); PG8_BAR; PG8_SCHED;
            PG8_LDA(At, 1, 1); PG8_STAGE(PG8_SB(1, 0), b3, voffB); PG8_STAGE(PG8_SB(1, 1), b3 + hstep, voffB); PG8_STAGE(PG8_SA(1, 0), a3, voffA);
            PG8_WAIT_V(8); PG8_WAIT_L(0); PG8_BAR; PG8_MMA(1, 0, At, B0); PG8_MMA(1, 1, At, B1); PG8_BAR; PG8_SCHED;
            } else {
            PG8_LDB(B0, 0, 0); PG8_SCHED; PG8_LDA(At, 0, 0); PG8_STAGE(PG8_SA(1, 1), a1 + hstep, voffA);
            PG8_WAIT_L(8); PG8_BAR; PG8_WAIT_L(0); PG8_MMA(0, 0, At, B0); PG8_BAR; PG8_SCHED;
            PG8_LDB(B1, 0, 1); PG8_STAGE(PG8_SB(0, 0), b2, voffB);
            PG8_BAR; PG8_WAIT_L(0); PG8_MMA(0, 1, At, B1); PG8_BAR;
            PG8_LDA(At, 0, 1); PG8_STAGE(PG8_SA(0, 0), a2, voffA);
            PG8_BAR; PG8_WAIT_L(0); PG8_MMA(1, 0, At, B0); PG8_BAR; PG8_SCHED;
            PG8_STAGE(PG8_SB(0, 1), b2 + hstep, voffB);
            PG8_WAIT_V(6); PG8_BAR; PG8_MMA(1, 1, At, B1); PG8_BAR;
            PG8_LDB(B0, 1, 0); PG8_SCHED; PG8_LDA(At, 1, 0); PG8_STAGE(PG8_SA(0, 1), a2 + hstep, voffA);
            PG8_WAIT_L(8); PG8_BAR; PG8_WAIT_L(0); PG8_MMA(0, 0, At, B0); PG8_BAR; PG8_SCHED;
            PG8_LDB(B1, 1, 1); PG8_STAGE(PG8_SB(1, 0), b3, voffB);
            PG8_BAR; PG8_WAIT_L(0); PG8_MMA(0, 1, At, B1); PG8_BAR;
            PG8_LDA(At, 1, 1); PG8_STAGE(PG8_SA(1, 0), a3, voffA);
            PG8_BAR; PG8_WAIT_L(0); PG8_MMA(1, 0, At, B0); PG8_BAR; PG8_SCHED;
            PG8_STAGE(PG8_SB(1, 1), b3 + hstep, voffB);
            PG8_WAIT_V(6); PG8_BAR; PG8_MMA(1, 1, At, B1); PG8_BAR;
            }
        }
        if constexpr (ALIGN_EPI) { if (wr == 0) PG8_BAR; }
        if constexpr (!Epi::AFTER_DRAIN) { E(acc, cur, wr, wc, fr, fq); S.done(cur); }
        if (!has_next) break;
#pragma unroll
        for (int a = 0; a < 2; ++a)
#pragma unroll
            for (int b = 0; b < 2; ++b)
#pragma unroll
                for (int m = 0; m < 4; ++m)
#pragma unroll
                    for (int n = 0; n < 2; ++n) acc[a][b][m][n] = (f32x4){0.f, 0.f, 0.f, 0.f};
        cur = nxt; cA = nA; cB = nB; ++ui;
        if constexpr (ALIGN_EPI) { if (wr == 1) PG8_BAR; }
    }
    PG8_WAIT_V(0);
    if constexpr (!ALIGN_EPI) { if (wr == 0) PG8_BAR; }
    PG8_BAR;
    if constexpr (Epi::AFTER_DRAIN) { E.fused(acc, cur, wr, wc, fr, fq, lds, wid, lane); S.done(cur); }
#undef PG8_SA
#undef PG8_SB
#undef PG8_STAGE
#undef PG8_LDA
#undef PG8_LDB
#undef PG8_MMA
#undef PG8_WAIT_V
#undef PG8_WAIT_L
#undef PG8_BAR
#undef PG8_SCHED
}
}
#define GAS __attribute__((address_space(1)))
#define LAS __attribute__((address_space(3)))
typedef unsigned short bf16;
typedef unsigned v4u __attribute__((ext_vector_type(4)));
typedef float f32x4 __attribute__((ext_vector_type(4)));
typedef short bf16x8 __attribute__((ext_vector_type(8)));
typedef GAS unsigned gu32;
typedef GAS unsigned long long gu64;
#define RLX_AGENT __ATOMIC_RELAXED, __HIP_MEMORY_SCOPE_AGENT
#define LDS_WAIT() asm volatile("s_waitcnt lgkmcnt(0)" ::: "memory")
#define VM_WAIT() asm volatile("s_waitcnt vmcnt(0)" ::: "memory")
__device__ __forceinline__ unsigned long long rt() { return __builtin_amdgcn_s_memrealtime(); }
__device__ __forceinline__ unsigned f2bf(float f) { unsigned u = __builtin_bit_cast(unsigned, f); return (u + 0x7fffu + ((u >> 16) & 1u)) >> 16; }
__device__ __forceinline__ unsigned pk2(float lo, float hi) { return f2bf(lo) | (f2bf(hi) << 16); }

#define XB_TMO      128
#define XB_XCNT(j)  (256  + 64 * (j))
#define XB_XSUB(j)  (1280 + 64 * (j))
#define XB_XGEN(j)  (2304 + 64 * (j))
#define XB_TOP      3328
#define XB_TOPGEN   3392
#define XCD_BAR_WORDS 3456
#define XB_SPIN_CAP (1u << 18)

__device__ __forceinline__ unsigned xb_ld(unsigned* p)              { return __hip_atomic_load(p, __ATOMIC_RELAXED, __HIP_MEMORY_SCOPE_AGENT); }
__device__ __forceinline__ unsigned xb_add(unsigned* p, unsigned v) { return __hip_atomic_fetch_add(p, v, __ATOMIC_RELAXED, __HIP_MEMORY_SCOPE_AGENT); }
__device__ __forceinline__ unsigned xb_xcc_id() { return (unsigned)__builtin_amdgcn_s_getreg((3 << 11) | 20) & 0xFu; }
#define XB_SPIN(cond, bar) do { unsigned _sp = 0; while (cond) { __builtin_amdgcn_s_sleep(1); \
    if ((++_sp & 255u) == 0u) { if (xb_ld(&(bar)[XB_TMO])) break; if (_sp > XB_SPIN_CAP) { atomicAdd(&(bar)[XB_TMO], 1u); break; } } } } while (0)

struct XcdBarrier {
    unsigned* bar; unsigned x;
    volatile LAS unsigned* st;
};

__device__ __forceinline__ XcdBarrier xcd_barrier_post(unsigned* bar, volatile LAS unsigned* st) {
    XcdBarrier b; b.bar = bar; b.x = xb_xcc_id(); b.st = st;
    if (threadIdx.x == 0) (void)xb_add(&bar[XB_XCNT(b.x)], 1u);
    return b;
}
__device__ __forceinline__ void xcd_barrier_complete(unsigned* bar, unsigned x, unsigned& nloc, unsigned& nx) {
    const unsigned G = gridDim.x * gridDim.y * gridDim.z;
    unsigned sum, cnt, mine, sp = 0u;
    for (;;) {
        sum = 0u; cnt = 0u; mine = 0u;
#pragma unroll
        for (unsigned j = 0; j < 16; ++j) { const unsigned c = xb_ld(&bar[XB_XCNT(j)]); sum += c; cnt += (c > 0u) ? 1u : 0u; mine = (j == x) ? c : mine; }
        if (sum == G) break;
        __builtin_amdgcn_s_sleep(1);
        if ((++sp & 255u) == 0u) { if (xb_ld(&bar[XB_TMO])) break; if (sp > XB_SPIN_CAP) { atomicAdd(&bar[XB_TMO], 1u); break; } }
    }
    nloc = mine > 0u ? mine : 1u; nx = cnt > 0u ? cnt : 1u;
}

__device__ __forceinline__ void xcd_barrier(const XcdBarrier& b) {
    asm volatile("s_waitcnt vmcnt(0)" ::: "memory");
    __syncthreads();
    if (threadIdx.x == 0) {
        unsigned* bar = b.bar;
        __builtin_amdgcn_s_waitcnt(0);
        unsigned nloc = b.st[0], nx = b.st[1];
        if (nloc == 0u) { xcd_barrier_complete(bar, b.x, nloc, nx); b.st[0] = nloc; b.st[1] = nx; }
        const unsigned old = xb_add(&bar[XB_XSUB(b.x)], 1u);
        const unsigned gen = old / nloc;
        if (old + 1u == (gen + 1u) * nloc) {
            __builtin_amdgcn_fence(__ATOMIC_RELEASE, "agent");
            asm volatile("s_waitcnt vmcnt(0)" ::: "memory");
            const unsigned og = xb_add(&bar[XB_TOP], 1u);
            const unsigned tg = og / nx;
            if (og + 1u == (tg + 1u) * nx) xb_add(&bar[XB_TOPGEN], 1u);
            else XB_SPIN(xb_ld(&bar[XB_TOPGEN]) == tg, bar);
            __builtin_amdgcn_fence(__ATOMIC_ACQUIRE, "agent");
            xb_add(&bar[XB_XGEN(b.x)], 1u);
            asm volatile("s_waitcnt vmcnt(0)" ::: "memory");
        } else {
            XB_SPIN(xb_ld(&bar[XB_XGEN(b.x)]) == gen, bar);
            __builtin_amdgcn_fence(__ATOMIC_ACQUIRE, "agent");
            asm volatile("s_waitcnt vmcnt(0)" ::: "memory");
        }
    }
    __syncthreads();
}
constexpr int NWAVES = 8, NT = NWAVES * 64;
constexpr int BATCH = 8, SEQ = 2048, DM = 1024, M = BATCH * SEQ, MEMLEN = 256, MM = BATCH * MEMLEN, FFD = 4096;
constexpr int INC = 7168, RWC = 1792;
constexpr float LOG2E = 1.4426950408889634f;
constexpr float QS64 = 0.125f * LOG2E;
constexpr float QS128 = 0.08838834764831845f * LOG2E;
constexpr size_t MiB = 1u << 20;
constexpr size_t WS_CTL = 0, CTL_ZERO_BYTES = 1536 * 1024;
constexpr size_t WS_XB = 512 * 1024;
constexpr int CW_PANEL = 16384, PANEL_BANK = 64 * 64;
constexpr size_t WS_KM = 1 * MiB + 512 * 1024;
constexpr size_t WS_RS = 1 * MiB + 768 * 1024;
constexpr size_t WS_ROPE = 2 * MiB;
constexpr size_t WS_WA = 6 * MiB;
constexpr size_t WS_WBR = 34 * MiB + MiB / 2, WS_WOUT = 37 * MiB + MiB / 2;
constexpr size_t WS_VFIRST = 16 * MiB;
constexpr size_t WS_MEMKV = 112 * MiB;
constexpr size_t WS_WAB = 32 * MiB;
constexpr size_t WS_XN = 40 * MiB;
constexpr size_t WS_URW = 72 * MiB;
constexpr size_t WS_MK = 128 * MiB, WS_MV = 144 * MiB, WS_SK = 160 * MiB, WS_SV = 164 * MiB;
constexpr size_t WS_GATE = 72 * MiB;
constexpr size_t WS_Y = 72 * MiB;
constexpr size_t WS_QX = 136 * MiB;
constexpr size_t WS_HMID = 72 * MiB;
constexpr size_t WS_MQ = 168 * MiB, WS_SQ = 184 * MiB, WS_ORW = 200 * MiB;
constexpr size_t WS_G = 216 * MiB, WS_BV = 232 * MiB;
constexpr size_t WS_WXQ = 15 * MiB  , WS_WXO = 217 * MiB, WS_WUP = 218 * MiB, WS_WDN = 226 * MiB;
constexpr size_t WS_MN = 104 * MiB, WS_WKV = 108 * MiB;
constexpr size_t WS_WG = 248 * MiB;
constexpr size_t WS_VM = 254 * MiB;
constexpr size_t WS_END = 256 * MiB;
constexpr int CW_BAR = 1024;

constexpr int LDS_BYTES = 147456, LDSCTL_OFF = LDS_BYTES - 1024, MISC_OFF = LDSCTL_OFF + 320;

struct Params {
    const float* in[35]; float* out; unsigned char* ws;
};

struct Frame {
    LAS unsigned char* lds; int wave, G, bid;
};
__device__ __forceinline__ int tid_now() { int t = threadIdx.x; asm volatile("" : "+v"(t)); return t; }

__device__ __forceinline__ float wave_sum(float v) {
#pragma unroll
    for (int o = 1; o < 64; o <<= 1) v += __shfl_xor(v, o);
    return v;
}
__device__ __forceinline__ float row16_sum(float v) {
    v += __builtin_bit_cast(float, __builtin_amdgcn_update_dpp(0, __builtin_bit_cast(int, v), 0x128, 0xf, 0xf, false));
    v += __builtin_bit_cast(float, __builtin_amdgcn_update_dpp(0, __builtin_bit_cast(int, v), 0x124, 0xf, 0xf, false));
    v += __builtin_bit_cast(float, __builtin_amdgcn_update_dpp(0, __builtin_bit_cast(int, v), 0x122, 0xf, 0xf, false));
    v += __builtin_bit_cast(float, __builtin_amdgcn_update_dpp(0, __builtin_bit_cast(int, v), 0x121, 0xf, 0xf, false));
    return v;
}
__device__ __forceinline__ float bfl(unsigned w) { return __builtin_bit_cast(float, w << 16); }
__device__ __forceinline__ float bfh(unsigned w) { return __builtin_bit_cast(float, w & 0xffff0000u); }
__device__ __forceinline__ float bf1(bf16 h) { return __builtin_bit_cast(float, (unsigned)h << 16); }
__device__ __forceinline__ float sigm(float x) { return 1.f / (1.f + __expf(-x)); }
typedef float f32x2_g __attribute__((ext_vector_type(2))); typedef __bf16 bf16x2_g __attribute__((ext_vector_type(2)));
__device__ __forceinline__ unsigned cvt_pk(float lo, float hi) { f32x2_g v = {lo, hi}; bf16x2_g b = __builtin_convertvector(v, bf16x2_g); return __builtin_bit_cast(unsigned, b); }
__device__ __forceinline__ bf16 cvt_1(float x) { return (bf16)(cvt_pk(x, 0.f) & 0xffffu); }

template <class RowMap>
__device__ __forceinline__ void transpose_store(const f32x4 (&v)[8], int K, const float* gain, bf16* WT, RowMap rowmap, LAS float* scr, int kb, int nb, int lane) {
    const int k0 = 64 * kb, n0 = 32 * nb, kr = lane >> 3, n4 = (lane & 7) * 4;
#pragma unroll
    for (int i = 0; i < 8; ++i) { const int kk = 8 * i + kr; f32x4 x = v[i]; if (gain) x = x * gain[k0 + kk];
        LAS float* d = scr + kk * 33 + n4; d[0] = x.x; d[1] = x.y; d[2] = x.z; d[3] = x.w; }
    LDS_WAIT(); asm volatile("" ::: "memory");
    const int c = lane & 7;
#pragma unroll
    for (int j = 0; j < 4; ++j) { const int n = (lane >> 3) + 8 * j; const LAS float* s = scr + (8 * c) * 33 + n;
        v4u o; o.x = cvt_pk(s[0 * 33], s[1 * 33]); o.y = cvt_pk(s[2 * 33], s[3 * 33]); o.z = cvt_pk(s[4 * 33], s[5 * 33]); o.w = cvt_pk(s[6 * 33], s[7 * 33]);
        const int dr = rowmap(n0 + n);
        *(GAS v4u*)(WT + (size_t)dr * K + k0 + 8 * c) = o; }
    LDS_WAIT(); asm volatile("" ::: "memory");
}
template <class RowMap>
__device__ __forceinline__ void transpose_item2(const float* W, int ldw, int c0, int K, const float* gain, bf16* WT, RowMap rowmap, LAS float* scr, int kb1, int nb1, int kb2, int nb2, bool has2, int lane) {
    const int kr = lane >> 3, n4 = (lane & 7) * 4;
    f32x4 v1[8], v2[8];
#pragma unroll
    for (int i = 0; i < 8; ++i) v1[i] = *(const GAS f32x4*)(W + (size_t)(64 * kb1 + 8 * i + kr) * ldw + c0 + 32 * nb1 + n4);
#pragma unroll
    for (int i = 0; i < 8; ++i) v2[i] = *(const GAS f32x4*)(W + (size_t)(64 * kb2 + 8 * i + kr) * ldw + c0 + 32 * nb2 + n4);
    transpose_store(v1, K, gain, WT, rowmap, scr, kb1, nb1, lane);
    if (has2) transpose_store(v2, K, gain, WT, rowmap, scr, kb2, nb2, lane);
}
struct MapWAB { __device__ __forceinline__ int operator()(int n) const; };
struct MapId { int off; __device__ __forceinline__ int operator()(int n) const { return off + n; } };
struct CvItem { const float* W; int ldw; int K; const float* gain; bf16* WT; int roff; int kb, nb; int rmode = 0; };
struct MapCv { int mode, roff; __device__ __forceinline__ int operator()(int n) const; };
__device__ __forceinline__ void transpose_pair(const CvItem& a, const CvItem& b, bool has2, LAS float* scr, int lane) {
    const int kr = lane >> 3, n4 = (lane & 7) * 4;
    f32x4 v1[8], v2[8];
#pragma unroll
    for (int i = 0; i < 8; ++i) v1[i] = *(const GAS f32x4*)(a.W + (size_t)(64 * a.kb + 8 * i + kr) * a.ldw + 32 * a.nb + n4);
#pragma unroll
    for (int i = 0; i < 8; ++i) v2[i] = *(const GAS f32x4*)(b.W + (size_t)(64 * b.kb + 8 * i + kr) * b.ldw + 32 * b.nb + n4);
    transpose_store(v1, a.K, a.gain, a.WT, MapCv{a.rmode, a.roff}, scr, a.kb, a.nb, lane);
    if (has2) transpose_store(v2, b.K, b.gain, b.WT, MapCv{b.rmode, b.roff}, scr, b.kb, b.nb, lane);
}
__device__ __forceinline__ void transpose_quad(const CvItem& a, const CvItem& b, const CvItem& c, const CvItem& d, int n, LAS float* scr, int lane) {
    const int kr = lane >> 3, n4 = (lane & 7) * 4;
    f32x4 v1[8], v2[8], v3[8], v4[8];
#pragma unroll
    for (int i = 0; i < 8; ++i) v1[i] = *(const GAS f32x4*)(a.W + (size_t)(64 * a.kb + 8 * i + kr) * a.ldw + 32 * a.nb + n4);
#pragma unroll
    for (int i = 0; i < 8; ++i) v2[i] = *(const GAS f32x4*)(b.W + (size_t)(64 * b.kb + 8 * i + kr) * b.ldw + 32 * b.nb + n4);
#pragma unroll
    for (int i = 0; i < 8; ++i) v3[i] = *(const GAS f32x4*)(c.W + (size_t)(64 * c.kb + 8 * i + kr) * c.ldw + 32 * c.nb + n4);
#pragma unroll
    for (int i = 0; i < 8; ++i) v4[i] = *(const GAS f32x4*)(d.W + (size_t)(64 * d.kb + 8 * i + kr) * d.ldw + 32 * d.nb + n4);
    transpose_store(v1, a.K, a.gain, a.WT, MapCv{a.rmode, a.roff}, scr, a.kb, a.nb, lane);
    if (n > 1) transpose_store(v2, b.K, b.gain, b.WT, MapCv{b.rmode, b.roff}, scr, b.kb, b.nb, lane);
    if (n > 2) transpose_store(v3, c.K, c.gain, c.WT, MapCv{c.rmode, c.roff}, scr, c.kb, c.nb, lane);
    if (n > 3) transpose_store(v4, d.K, d.gain, d.WT, MapCv{d.rmode, d.roff}, scr, d.kb, d.nb, lane);
}
struct MapWA { __device__ __forceinline__ int operator()(int n) const {
    const bool rp = (n >= 1792 && n < 2816) || (n >= 3328 && n < 3968);
    if (!rp) return n; const int hb = n & ~63, d = n & 63; return hb + ((d < 32) ? 2 * d : 2 * (d - 32) + 1); } };

constexpr int PA_COLS = 3072;
__device__ __forceinline__ int MapWAB::operator()(int n) const { return MapWA{}(n + PA_COLS) - PA_COLS; }
__device__ __forceinline__ int MapCv::operator()(int n) const { return mode == 1 ? MapWA{}(n) : (mode == 2 ? MapWAB{}(n) : roff + n); }
template <class RowMap>
__device__ __forceinline__ void convert_matrix(const Frame& F, const float* W, int ldw, int c0, int K, int N, const float* gain, bf16* WT, RowMap rm, int wg0 = 0, int nwg = 0) {
    LAS float* scr = (LAS float*)(F.lds + F.wave * 16384); const int lane = tid_now() & 63;
    const int gw = (F.bid - wg0) * NWAVES + F.wave, NGW = (nwg ? nwg : F.G) * NWAVES, nblk = N / 32, nit = (K / 64) * nblk;
    for (int it = gw; it < nit; it += 2 * NGW) { const int it2 = it + NGW; const bool has2 = it2 < nit; const int i2 = has2 ? it2 : it;
        transpose_item2(W, ldw, c0, K, gain, WT, rm, scr, it / nblk, it % nblk, i2 / nblk, i2 % nblk, has2, lane); }
}

__device__ __forceinline__ void norm_row_to_bf16(const float* xrow, bf16* orow, int lane, float* rsout = nullptr) {
    const GAS f32x4* xr = (const GAS f32x4*)xrow + lane; f32x4 v[4]; float s = 0.f;
#pragma unroll
    for (int j = 0; j < 4; ++j) { v[j] = xr[64 * j]; s += (v[j].x * v[j].x + v[j].y * v[j].y) + (v[j].z * v[j].z + v[j].w * v[j].w); }
    const float ms = wave_sum(s) * (1.f / DM) + 1e-6f; const float rs = 1.f / sqrtf(ms);
    if (rsout != nullptr && lane == 0) *rsout = sqrtf(ms);
    GAS unsigned long long* o8 = (GAS unsigned long long*)orow + lane;
#pragma unroll
    for (int j = 0; j < 4; ++j) o8[64 * j] = (unsigned long long)pk2(v[j].x * rs, v[j].y * rs) | ((unsigned long long)pk2(v[j].z * rs, v[j].w * rs) << 32);
}
__device__ __forceinline__ void norm_rows4_to_bf16(const float* X, bf16* O, float* rsv, int r0, int rstep, int nrows, int lane) {
    f32x4 v[4][4]; int rr[4];
#pragma unroll
    for (int k = 0; k < 4; ++k) { rr[k] = r0 + k * rstep; const int rc = rr[k] < nrows ? rr[k] : r0; const GAS f32x4* xr = (const GAS f32x4*)(X + (size_t)rc * DM) + lane;
#pragma unroll
        for (int j = 0; j < 4; ++j) v[k][j] = xr[64 * j]; }
#pragma unroll
    for (int k = 0; k < 4; ++k) { float s = 0.f;
#pragma unroll
        for (int j = 0; j < 4; ++j) s += (v[k][j].x * v[k][j].x + v[k][j].y * v[k][j].y) + (v[k][j].z * v[k][j].z + v[k][j].w * v[k][j].w);
        const float ms = wave_sum(s) * (1.f / DM) + 1e-6f; const float rs = 1.f / sqrtf(ms);
        if (rr[k] < nrows) { if (lane == 0) rsv[rr[k]] = sqrtf(ms);
            GAS unsigned long long* o8 = (GAS unsigned long long*)(O + (size_t)rr[k] * DM) + lane;
#pragma unroll
            for (int j = 0; j < 4; ++j) o8[64 * j] = (unsigned long long)pk2(v[k][j].x * rs, v[k][j].y * rs) | ((unsigned long long)pk2(v[k][j].z * rs, v[k][j].w * rs) << 32); } }
}
__device__ __forceinline__ void row_phase(const Frame& F, bf16* xn, float* rsv, const bf16* y, const float* g, float* out) {
    const int gw = F.bid * NWAVES + F.wave, NGW = F.G * NWAVES, lane = tid_now() & 63;
    for (int r = gw; r < M; r += NGW) {
        const GAS unsigned long long* y8 = (const GAS unsigned long long*)(y + (size_t)r * DM) + lane; GAS unsigned long long* x8 = (GAS unsigned long long*)(xn + (size_t)r * DM) + lane; const f32x4* g4 = (const f32x4*)g + lane;
        f32x4 yv[4]; float s = 0.f; const float ro = rsv[r];
#pragma unroll
        for (int j = 0; j < 4; ++j) { const unsigned long long w = y8[64 * j]; const unsigned lo = (unsigned)w, hi = (unsigned)(w >> 32); yv[j] = (f32x4){bfl(lo), bfh(lo), bfl(hi), bfh(hi)};
            s += (yv[j].x * yv[j].x + yv[j].y * yv[j].y) + (yv[j].z * yv[j].z + yv[j].w * yv[j].w); }
        const float rs = 1.f / sqrtf(wave_sum(s) * (1.f / DM) + 1e-6f); float s2 = 0.f; f32x4 xv[4];
#pragma unroll
        for (int j = 0; j < 4; ++j) { const unsigned long long w = x8[64 * j]; const unsigned lo = (unsigned)w, hi = (unsigned)(w >> 32);
            xv[j] = (f32x4){bfl(lo), bfh(lo), bfl(hi), bfh(hi)} * ro + yv[j] * rs * g4[64 * j]; s2 += (xv[j].x * xv[j].x + xv[j].y * xv[j].y) + (xv[j].z * xv[j].z + xv[j].w * xv[j].w); }
        if (out != nullptr) { GAS f32x4* xo = (GAS f32x4*)(out + (size_t)r * DM) + lane;
#pragma unroll
            for (int j = 0; j < 4; ++j) xo[64 * j] = xv[j]; }
        else { const float ms = wave_sum(s2) * (1.f / DM) + 1e-6f; const float rs2 = 1.f / sqrtf(ms); if (lane == 0) rsv[r] = sqrtf(ms);
#pragma unroll
            for (int j = 0; j < 4; ++j) x8[64 * j] = (unsigned long long)pk2(xv[j].x * rs2, xv[j].y * rs2) | ((unsigned long long)pk2(xv[j].z * rs2, xv[j].w * rs2) << 32); }
    }
}

__device__ __forceinline__ void vm_phase(const Frame& F, const bf16* XNp, const bf16* WT  , bf16* VMp) {
    constexpr int BST = 2112;
    const int tid = tid_now(), lane = tid & 63, fr = lane & 15, fq = lane >> 4, rt = F.wave & 3, kh = F.wave >> 2;
    LAS unsigned char* bl = F.lds; LAS float* red = (LAS float*)(F.lds + 32 * BST);
    __syncthreads();
#pragma unroll
    for (int i = 0; i < 8; ++i) { const int idx = tid + i * NT, row = idx >> 7, c16 = idx & 127;
        *(LAS v4u*)(bl + row * BST + c16 * 16) = *(const GAS v4u*)(WT + (size_t)row * DM + c16 * 8); }
    __syncthreads();
    for (int blk = F.bid; blk < M / 64; blk += F.G) {
        const bf16* ap = XNp + (size_t)(blk * 64 + rt * 16 + fr) * DM + kh * 512 + fq * 8;
        const LAS unsigned char* b0 = bl + fr * BST + (kh * 512 + fq * 8) * 2; const LAS unsigned char* b1 = b0 + 16 * BST;
        bf16x8 av[16];
#pragma unroll
        for (int ks = 0; ks < 16; ++ks) av[ks] = *(const bf16x8*)(ap + ks * 32);
        f32x4 acc0 = (f32x4){0.f, 0.f, 0.f, 0.f}, acc1 = acc0;
#pragma unroll
        for (int ks = 0; ks < 16; ++ks) { acc0 = __builtin_amdgcn_mfma_f32_16x16x32_bf16(av[ks], *(const LAS bf16x8*)(b0 + ks * 64), acc0, 0, 0, 0);
                                          acc1 = __builtin_amdgcn_mfma_f32_16x16x32_bf16(av[ks], *(const LAS bf16x8*)(b1 + ks * 64), acc1, 0, 0, 0); }
        if (kh == 1) { *(LAS f32x4*)(red + ((rt * 2 + 0) * 64 + lane) * 4) = acc0; *(LAS f32x4*)(red + ((rt * 2 + 1) * 64 + lane) * 4) = acc1; }
        __syncthreads();
        if (kh == 0) { acc0 = acc0 + *(const LAS f32x4*)(red + ((rt * 2 + 0) * 64 + lane) * 4); acc1 = acc1 + *(const LAS f32x4*)(red + ((rt * 2 + 1) * 64 + lane) * 4);
#pragma unroll
            for (int j = 0; j < 4; ++j) { VMp[(size_t)(blk * 64 + rt * 16 + fq * 4 + j) * 32 + fr] = cvt_1(acc0[j]); VMp[(size_t)(blk * 64 + rt * 16 + fq * 4 + j) * 32 + 16 + fr] = cvt_1(acc1[j]); } }
        __syncthreads();
    }
}

__device__ __forceinline__ void sub_barrier(unsigned* cnt, unsigned n) {
    asm volatile("s_waitcnt vmcnt(0)" ::: "memory"); __syncthreads();
    if (threadIdx.x == 0) {
        __builtin_amdgcn_fence(__ATOMIC_RELEASE, "agent"); asm volatile("s_waitcnt vmcnt(0)" ::: "memory");
        __hip_atomic_fetch_add(cnt, 1u, __ATOMIC_RELAXED, __HIP_MEMORY_SCOPE_AGENT);
        unsigned spins = 0;
        while (__hip_atomic_load(cnt, __ATOMIC_RELAXED, __HIP_MEMORY_SCOPE_AGENT) < n) { __builtin_amdgcn_s_sleep(4); if (++spins > (1u << 22)) break; }
        __builtin_amdgcn_fence(__ATOMIC_ACQUIRE, "agent"); asm volatile("s_waitcnt vmcnt(0)" ::: "memory");
    }
    __syncthreads();
}
namespace at {
using bf16x8 = __attribute__((ext_vector_type(8))) short;
using s16x4 = __attribute__((ext_vector_type(4))) short;
using f32x16 = __attribute__((ext_vector_type(16))) float;
using u32x4 = __attribute__((ext_vector_type(4))) unsigned;
typedef short v4i16_t __attribute__((ext_vector_type(4)));
typedef __attribute__((address_space(3))) const char* lds_cptr;
typedef __attribute__((address_space(3))) char* lds_ptr;
__device__ __forceinline__ int crow(int r, int hi) { return (r & 3) + 8 * (r >> 2) + 4 * hi; }
__device__ __forceinline__ void glds16(const void* gsrc, unsigned lds_dst) { unsigned keep;
    asm volatile("s_mov_b32 %0, m0\n\ts_mov_b32 m0, %2\n\ts_nop 0\n\tglobal_load_lds_dwordx4 %1, off\n\ts_mov_b32 m0, %0" : "=&s"(keep) : "v"(gsrc), "s"(lds_dst) : "memory"); }
typedef float f32x2_t __attribute__((ext_vector_type(2))); typedef __bf16 bf16x2_t __attribute__((ext_vector_type(2)));
__device__ __forceinline__ unsigned cvtpk(float lo, float hi) { f32x2_t v = {lo, hi}; bf16x2_t b = __builtin_convertvector(v, bf16x2_t); return __builtin_bit_cast(unsigned, b); }
__device__ __forceinline__ s16x4 vtr(lds_cptr p) { return __builtin_bit_cast(s16x4, __builtin_amdgcn_ds_read_tr16_b64_v4i16((__attribute__((address_space(3))) v4i16_t*)p)); }
#define AT_WAIT_BAR() asm volatile("s_waitcnt vmcnt(0) lgkmcnt(0)\n\ts_barrier" ::: "memory")

template <int HD, int NS> struct Lay {
    static constexpr int NCH = HD / 8, SLOT = 64 * HD * 2, LDS_K = 0, LDS_V = NS * SLOT, LDS_WS = 2 * NS * SLOT, LDS_OST = LDS_WS + 8 * 64 * 4, BYTES = LDS_OST + 8 * 32 * HD * 2;
};
struct Ten { const bf16* Q; int qp; const bf16* K; const bf16* V; int kvp; bf16* O; int op; };

template <int HD, int MODE>
__device__ __forceinline__ void attn_unit(const Ten& T, int q0, int kt0, int nt, float sink_l2, const float* kmsum  , lds_ptr shm) {
    constexpr int NS = (HD == 64) ? 4 : 2;
    using L = Lay<HD, NS>;
    constexpr int ND = HD / 16, NO = HD / 32;
    const int tid = tid_now(), lane = tid & 63, r32 = lane & 31, hi = lane >> 5; const int wid = __builtin_amdgcn_readfirstlane(tid >> 6);
    const unsigned lds0 = (unsigned)(uintptr_t)shm;
    __attribute__((address_space(3))) float* wsf = (__attribute__((address_space(3))) float*)(shm + L::LDS_WS) + wid * 64;
    const int qb = q0 >> 8;
    const int NTILES = (MODE == 0) ? 4 * (qb + 1) : nt;
    auto tile_of = [&](int s) -> int { if (MODE == 0) return (s < 4) ? 4 * qb + s : s - 4; return kt0 + s; };
    auto dma = [&](int s, int slot) {
        const int kt = tile_of(s);
#pragma unroll
        for (int c = wid; c < L::NCH; c += 8) {
            const bf16* ksrc = T.K + (size_t)(kt * 64 + lane) * T.kvp + c * 8;
            glds16(ksrc, (unsigned)__builtin_amdgcn_readfirstlane(lds0 + L::LDS_K + slot * L::SLOT + c * 1024));
            const bf16* vsrc = T.V + (size_t)(kt * 64 + 16 * (c & 3) + (lane >> 2)) * T.kvp + (c >> 2) * 32 + (lane & 3) * 8;
            glds16(vsrc, (unsigned)__builtin_amdgcn_readfirstlane(lds0 + L::LDS_V + slot * L::SLOT + c * 1024));
        }
    };
    dma(0, 0);
    if (NS == 4) { if (1 < NTILES) dma(1, 1); if (2 < NTILES) dma(2, 2); }
    const bf16* Qw = T.Q + (size_t)(q0 + wid * 32) * T.qp;
    bf16x8 qr[ND];
#pragma unroll
    for (int d0 = 0; d0 < ND; ++d0) qr[d0] = *reinterpret_cast<const bf16x8*>(&Qw[(size_t)r32 * T.qp + d0 * 16 + hi * 8]);
    const int qrel = wid * 32 + r32;
    unsigned selbits = 0xffu;
    if (MODE == 0 && qb > 3) {
        { __attribute__((address_space(3))) float* kml = (__attribute__((address_space(3))) float*)(shm + L::LDS_WS);
          kml[tid] = kmsum[(size_t)(tid >> 6) * 512 + (tid & 63)];
          asm volatile("s_waitcnt vmcnt(0) lgkmcnt(0)\n\ts_barrier" ::: "memory"); }
        const __attribute__((address_space(3))) float* kml = (const __attribute__((address_space(3))) float*)(shm + L::LDS_WS);
        float g[7];
#pragma unroll
        for (int j = 0; j < 7; ++j) { g[j] = 0.f;
            if (j < qb) { float a = 0.f;
#pragma unroll
                for (int d0 = 0; d0 < ND; ++d0) { const __attribute__((address_space(3))) float* kp = kml + j * 64 + d0 * 16 + hi * 8; const f32x4 k0 = *(const __attribute__((address_space(3))) f32x4*)kp, k1 = *(const __attribute__((address_space(3))) f32x4*)(kp + 4);
                    const bf16x8 qq = qr[d0];
                    a += bf1((bf16)qq[0]) * k0[0] + bf1((bf16)qq[1]) * k0[1] + bf1((bf16)qq[2]) * k0[2] + bf1((bf16)qq[3]) * k0[3]
                       + bf1((bf16)qq[4]) * k1[0] + bf1((bf16)qq[5]) * k1[1] + bf1((bf16)qq[6]) * k1[2] + bf1((bf16)qq[7]) * k1[3]; }
                a = pg8::xsum_32(a); g[j] = a; } }
        selbits = 0u;
#pragma unroll
        for (int j = 0; j < 7; ++j) { int rank = 0;
#pragma unroll
            for (int i = 0; i < 7; ++i) if (i != j && i < qb) rank += (g[i] > g[j] || (g[i] == g[j] && i < j)) ? 1 : 0;
            if (j < qb && rank < 3) selbits |= 1u << j; }
    }
    float mhat = (MODE == 1) ? sink_l2 : 0.f, l_reg = (MODE == 1 && hi == 0) ? 1.f : 0.f;
    f32x16 o[NO];
#pragma unroll
    for (int d = 0; d < NO; ++d) o[d] = f32x16{};
    f32x16 negm;
#pragma unroll
    for (int r = 0; r < 16; ++r) negm[r] = -mhat;
    const lds_cptr shm3 = (lds_cptr)shm;
    for (int s = 0; s < NTILES; ++s) {
        const int slot = s & (NS - 1);
        if (NS == 4) {
            const int rem = NTILES - 1 - s;
            if (rem >= 2) asm volatile("s_waitcnt vmcnt(4) lgkmcnt(0)\n\ts_barrier" ::: "memory");
            else if (rem == 1) asm volatile("s_waitcnt vmcnt(2) lgkmcnt(0)\n\ts_barrier" ::: "memory");
            else AT_WAIT_BAR();
            if (s + 3 < NTILES) dma(s + 3, (s + 3) & 3);
        } else {
            AT_WAIT_BAR();
            if (s + 1 < NTILES) dma(s + 1, slot ^ 1);
        }
        int tclass = 2;
        if (MODE == 0) { if (s < 4) { const int klo_t = 64 * s, khi_t = 64 * s + 63, rlo = wid * 32, rhi = wid * 32 + 31; tclass = (klo_t > rhi) ? 0 : (khi_t <= rlo ? 2 : 1); }
                         else { const bool sel = ((selbits >> ((s - 4) >> 2)) & 1u) != 0u; tclass = __all(sel) ? 2 : (__any(sel) ? 1 : 0); } }
        else if (MODE == 1) { const int klo_t = 64 * (kt0 + s) - q0, khi_t = klo_t + 63, rlo = wid * 32, rhi = wid * 32 + 31;
                              tclass = (klo_t > rhi || khi_t < rlo - 127) ? 0 : ((khi_t <= rlo && klo_t >= rhi - 127) ? 2 : 1); }
        if (tclass == 0) continue;
        f32x16 p0 = negm, p1 = negm;
        const lds_cptr kb = shm3 + L::LDS_K + slot * L::SLOT + hi * 1024 + r32 * 16;
#pragma unroll
        for (int d0 = 0; d0 < ND; ++d0) {
            const bf16x8 b0 = *(const __attribute__((address_space(3))) bf16x8*)(kb + d0 * 2048);
            const bf16x8 b1 = *(const __attribute__((address_space(3))) bf16x8*)(kb + d0 * 2048 + 512);
            p0 = __builtin_amdgcn_mfma_f32_32x32x16_bf16(b0, qr[d0], p0, 0, 0, 0);
            p1 = __builtin_amdgcn_mfma_f32_32x32x16_bf16(b1, qr[d0], p1, 0, 0, 0);
        }
        if (MODE != 2 && tclass == 1) {
            int klo, khi, kbase;
            if (MODE == 0) { if (s < 4) { kbase = 64 * s; klo = -1000000; khi = qrel; } else { kbase = -1000000; klo = -2000000; khi = ((selbits >> ((s - 4) >> 2)) & 1u) ? 0 : -2000000; } }
            else { kbase = 64 * (kt0 + s) - q0; klo = qrel - 127; khi = qrel; }
            const int kb4 = kbase + 4 * hi;
#pragma unroll
            for (int r = 0; r < 16; ++r) { const int kv = kb4 + (r & 3) + 8 * (r >> 2);
                if (kv > khi || kv < klo) p0[r] = -INFINITY;
                if (kv + 32 > khi || kv + 32 < klo) p1[r] = -INFINITY; }
        }
        float rm = p0[0];
#pragma unroll
        for (int r = 1; r < 16; ++r) rm = fmaxf(rm, p0[r]);
#pragma unroll
        for (int r = 0; r < 16; ++r) rm = fmaxf(rm, p1[r]);
        rm = pg8::xmax_32(rm);
        bool resc = false;
        if (__any(rm > 6.f)) { const float dl = fmaxf(rm, 0.f); mhat += dl;
#pragma unroll
            for (int r = 0; r < 16; ++r) { p0[r] -= dl; p1[r] -= dl; negm[r] = -mhat; }
            const float f = __builtin_amdgcn_exp2f(-dl); l_reg *= f; if (hi == 0) wsf[r32] = f; resc = true; }
        float sacc = 0.f;
#pragma unroll
        for (int r = 0; r < 16; ++r) { p0[r] = __builtin_amdgcn_exp2f(p0[r]); p1[r] = __builtin_amdgcn_exp2f(p1[r]); sacc += p0[r] + p1[r]; }
        l_reg += sacc;
        if (resc) {
#pragma unroll
            for (int r = 0; r < 16; ++r) { const float f = wsf[crow(r, hi)];
#pragma unroll
                for (int d = 0; d < NO; ++d) o[d][r] *= f; }
        }
        u32x4 pw[4];
        pw[0] = (u32x4){cvtpk(p0[0], p0[1]), cvtpk(p0[2], p0[3]), cvtpk(p0[4], p0[5]), cvtpk(p0[6], p0[7])};
        pw[1] = (u32x4){cvtpk(p0[8], p0[9]), cvtpk(p0[10], p0[11]), cvtpk(p0[12], p0[13]), cvtpk(p0[14], p0[15])};
        pw[2] = (u32x4){cvtpk(p1[0], p1[1]), cvtpk(p1[2], p1[3]), cvtpk(p1[4], p1[5]), cvtpk(p1[6], p1[7])};
        pw[3] = (u32x4){cvtpk(p1[8], p1[9]), cvtpk(p1[10], p1[11]), cvtpk(p1[12], p1[13]), cvtpk(p1[14], p1[15])};
        const lds_cptr vp = shm3 + L::LDS_V + slot * L::SLOT + ((lane >> 4) & 1) * 32 + (lane & 3) * 8 + (4 * hi + ((lane & 15) >> 2)) * 64;
#pragma unroll
        for (int d0 = 0; d0 < NO; ++d0)
#pragma unroll
            for (int ks = 0; ks < 4; ++ks) { const s16x4 lo = vtr(vp + d0 * 4096 + ks * 1024), hh = vtr(vp + d0 * 4096 + ks * 1024 + 512);
                const bf16x8 vf = (bf16x8){lo[0], lo[1], lo[2], lo[3], hh[0], hh[1], hh[2], hh[3]};
                o[d0] = __builtin_amdgcn_mfma_f32_32x32x16_bf16(__builtin_bit_cast(bf16x8, pw[ks]), vf, o[d0], 0, 0, 0); }
    }
    l_reg = pg8::xsum_32(l_reg);
    if (hi == 0) wsf[32 + r32] = l_reg;
    asm volatile("s_waitcnt lgkmcnt(0)" ::: "memory");
    float rli[16];
#pragma unroll
    for (int r = 0; r < 16; ++r) rli[r] = 1.f / wsf[32 + crow(r, hi)];
    bf16* Ow = T.O + (size_t)(q0 + wid * 32) * T.op;
    { __attribute__((address_space(3))) bf16* stg = (__attribute__((address_space(3))) bf16*)(shm + L::LDS_OST) + wid * 32 * HD;
#pragma unroll
      for (int r = 0; r < 16; ++r) { const int orow = crow(r, hi);
#pragma unroll
          for (int d0 = 0; d0 < NO; ++d0) stg[orow * HD + d0 * 32 + r32] = (bf16)(cvtpk(o[d0][r] * rli[r], 0.f) & 0xffffu); }
      asm volatile("s_waitcnt lgkmcnt(0)" ::: "memory");
      constexpr int CPR = HD / 8, RPI = 64 / CPR;
#pragma unroll
      for (int i = 0; i < 32 / RPI; ++i) { const int row = i * RPI + lane / CPR, ch = lane % CPR; const u32x4 v = *(const __attribute__((address_space(3))) u32x4*)(stg + row * HD + ch * 8);
          *(u32x4*)(Ow + (size_t)row * T.op + ch * 8) = v; } }
    asm volatile("s_waitcnt vmcnt(0) lgkmcnt(0)\n\ts_barrier" ::: "memory");
}
}
namespace rw {
using bf16x8 = __attribute__((ext_vector_type(8))) short;
typedef float f4 __attribute__((ext_vector_type(4)));
typedef unsigned u4 __attribute__((ext_vector_type(4)));
typedef unsigned u2 __attribute__((ext_vector_type(2)));
#define RW_LAS __attribute__((address_space(3)))
struct Args { const bf16* URW; const bf16* LIN; bf16* VFIRST; bf16* ORW; bf16* G; bf16* BV;
              const float *mu, *w0, *w_up, *a0, *a_up, *g_up, *k_k, *k_a, *r_k, *vmu, *v0, *v_up; int layer; };
#ifndef NREP_PREP
#define NREP_PREP 1
#endif
#ifndef NREP_D
#define NREP_D 1
#endif
constexpr int CH = 32;
constexpr int O_STG = 0, O_VST = 40960, O_WS = 49152, O_AS = 57344, O_WUT = 65536, O_AUT = 74752, O_GUT = 83968, O_VUT = 92672, O_END = 95232;
constexpr int LINC = 288;
constexpr int SXW = 72, SXG = 136, SXV = 40;
__device__ __forceinline__ unsigned pkbf(float lo, float hi) { return pk2(lo, hi); }
#define RW_BAR() do { asm volatile("s_waitcnt lgkmcnt(0)" ::: "memory"); __builtin_amdgcn_s_barrier(); asm volatile("" ::: "memory"); } while (0)

__device__ __forceinline__ float fsig(float x) { return __builtin_amdgcn_rcpf(1.f + __builtin_amdgcn_exp2f(-1.4426950408889634f * x)); }
__device__ __forceinline__ float ftanh(float x) { return 1.f - 2.f * __builtin_amdgcn_rcpf(1.f + __builtin_amdgcn_exp2f(2.8853900817779268f * x)); }
__device__ __forceinline__ void lerp8(const u4 cur, const u4 prv, const float* mup, float* x) {
    const f4 m0 = *(const f4*)(mup), m1 = *(const f4*)(mup + 4);
    x[0] = bfl(cur.x) + m0[0] * (bfl(prv.x) - bfl(cur.x)); x[1] = bfh(cur.x) + m0[1] * (bfh(prv.x) - bfh(cur.x));
    x[2] = bfl(cur.y) + m0[2] * (bfl(prv.y) - bfl(cur.y)); x[3] = bfh(cur.y) + m0[3] * (bfh(prv.y) - bfh(cur.y));
    x[4] = bfl(cur.z) + m1[0] * (bfl(prv.z) - bfl(cur.z)); x[5] = bfh(cur.z) + m1[1] * (bfh(prv.z) - bfh(cur.z));
    x[6] = bfl(cur.w) + m1[2] * (bfl(prv.w) - bfl(cur.w)); x[7] = bfh(cur.w) + m1[3] * (bfh(prv.w) - bfh(cur.w)); }
__device__ __forceinline__ void lin_phase(const Frame& F, const bf16* URW, const bf16* VM, const float* mu, const float* vmu, int layer, bf16* LIN) {
    const int gt = F.bid * NT + tid_now(), GT = F.G * NT;
    for (int it = gt; it < M * 32; it += 2 * GT) { const int it2 = (it + GT < M * 32) ? it + GT : it;
        const int rowa = it >> 5, ca = it & 31, rowb = it2 >> 5, cb = it2 & 31; const int cola = 1536 + 8 * ca, colb = 1536 + 8 * cb;
        const bool fa = (rowa & (SEQ - 1)) == 0, fb = (rowb & (SEQ - 1)) == 0;
        const u4 cura = *(const u4*)(URW + (size_t)rowa * RWC + cola), curb = *(const u4*)(URW + (size_t)rowb * RWC + colb);
        u4 prva = *(const u4*)(URW + (size_t)(fa ? rowa : rowa - 1) * RWC + cola), prvb = *(const u4*)(URW + (size_t)(fb ? rowb : rowb - 1) * RWC + colb);
        if (fa) prva = (u4){0u, 0u, 0u, 0u}; if (fb) prvb = (u4){0u, 0u, 0u, 0u};
#pragma unroll
        for (int h = 0; h < 2; ++h) { const u4 cur = h ? curb : cura, prv = h ? prvb : prva; const int c8 = h ? cb : ca, col = h ? colb : cola, row = h ? rowb : rowa;
            float x[8]; lerp8(cur, prv, mu + col, x);
            if (c8 < 8) {
#pragma unroll
                for (int e = 0; e < 8; ++e) x[e] = ftanh(x[e]); }
            else if (c8 >= 16) {
#pragma unroll
                for (int e = 0; e < 8; ++e) x[e] = fsig(x[e]); }
            if (h == 0 || it2 != it) *(u4*)(LIN + (size_t)row * LINC + c8 * 8) = (u4){cvt_pk(x[0], x[1]), cvt_pk(x[2], x[3]), cvt_pk(x[4], x[5]), cvt_pk(x[6], x[7])}; }
    }
    for (int it = gt; it < M * 4; it += GT) { const int row = it >> 2, c4 = it & 3; const bool first = (row & (SEQ - 1)) == 0; u4 o = (u4){0u, 0u, 0u, 0u};
        if (layer > 0) { const int col = c4 * 8; const u4 cur = *(const u4*)(VM + (size_t)row * 32 + col); u4 prv = (u4){0u, 0u, 0u, 0u}; if (!first) prv = *(const u4*)(VM + (size_t)(row - 1) * 32 + col);
            float x[8]; lerp8(cur, prv, vmu + col, x); o = (u4){cvt_pk(x[0], x[1]), cvt_pk(x[2], x[3]), cvt_pk(x[4], x[5]), cvt_pk(x[6], x[7])}; }
        *(u4*)(LIN + (size_t)row * LINC + 256 + c4 * 8) = o; }
}
struct Raw { bf16x8 la0, la1, la2, la3, lg0, lg1, lg2, lg3; u2 rc, kc, rp, kp; unsigned short vb0, vb1, vb2, vb3, vb4, vf0, vf1, vf2, vf3; };
__device__ __forceinline__ void scan_unit(const Args& A, int u, RW_LAS unsigned char* lds) {
    const int tid = tid_now(), lane = tid & 63; const int wid = __builtin_amdgcn_readfirstlane(tid >> 6);
    const int b = u >> 4, h = (u >> 1) & 7, half = u & 1; const size_t rowbase = (size_t)b * SEQ; const int hc = h * 64, vcb = h * 64 + half * 32;
    RW_LAS float* STG = (RW_LAS float*)(lds + O_STG); RW_LAS float* VST = (RW_LAS float*)(lds + O_VST);
    RW_LAS float* WS = (RW_LAS float*)(lds + O_WS); RW_LAS float* AS = (RW_LAS float*)(lds + O_AS);
    RW_LAS bf16* WUT = (RW_LAS bf16*)(lds + O_WUT); RW_LAS bf16* AUT = (RW_LAS bf16*)(lds + O_AUT); RW_LAS bf16* GUT = (RW_LAS bf16*)(lds + O_GUT); RW_LAS bf16* VUT = (RW_LAS bf16*)(lds + O_VUT);
    for (int idx = tid; idx < 4096; idx += NT) { const int k = idx >> 6, n = idx & 63;
        WUT[n * SXW + k] = cvt_1(A.w_up[(size_t)k * 512 + hc + n]); AUT[n * SXW + k] = cvt_1(A.a_up[(size_t)k * 512 + hc + n]); }
    for (int idx = tid; idx < 4096; idx += NT) { const int k = idx >> 5, n = idx & 31; GUT[n * SXG + k] = cvt_1(A.g_up[(size_t)k * 512 + vcb + n]); }
    if (A.layer > 0) for (int idx = tid; idx < 1024; idx += NT) { const int k = idx >> 5, n = idx & 31; VUT[n * SXV + k] = cvt_1(A.v_up[(size_t)k * 512 + vcb + n]); }
    const int q = tid & 15, tq = tid >> 4, k4 = 4 * q, fr = lane & 15, fq = lane >> 4;
    const f4 c_kk = *(const f4*)(A.k_k + hc + k4), c_ka = *(const f4*)(A.k_a + hc + k4), c_rk = *(const f4*)(A.r_k + hc + k4);
    const f4 mu_r = *(const f4*)(A.mu + hc + k4), mu_k = *(const f4*)(A.mu + 512 + hc + k4);
    const int vrt = wid & 1, vct = (wid >> 1) & 1, vvc = vct * 16 + fr, vcol = 1024 + vcb + vvc;
    const float muv = A.mu[vcol], v0c = (A.layer > 0) ? A.v0[vcb + vvc] : 0.f;
    const int lrt = wid & 1, lch = (wid >> 1) * 16 + fr; const float w0c = A.w0[hc + lch], a0c = A.a0[hc + lch];
    f4 S = (f4){0.f, 0.f, 0.f, 0.f};
    Raw R;
    auto load_raw = [&](int t0) {
        { const bf16* lp = A.LIN + (rowbase + t0 + lrt * 16 + fr) * LINC + fq * 8;
          R.la0 = *(const bf16x8*)(lp); R.la1 = *(const bf16x8*)(lp + 32); R.la2 = *(const bf16x8*)(lp + 64); R.la3 = *(const bf16x8*)(lp + 96); }
        { const bf16* gp = A.LIN + (rowbase + t0 + vrt * 16 + fr) * LINC + fq * 8;
          const int gc0 = (wid < 4) ? 128 : 256, gst = (wid < 4) ? 32 : 0;
          R.lg0 = *(const bf16x8*)(gp + gc0); R.lg1 = *(const bf16x8*)(gp + gc0 + gst); R.lg2 = *(const bf16x8*)(gp + gc0 + 2 * gst); R.lg3 = *(const bf16x8*)(gp + gc0 + 3 * gst); }
        { const size_t row = rowbase + t0 + tq;
          R.rc = *(const u2*)(A.URW + row * RWC + hc + k4); R.kc = *(const u2*)(A.URW + row * RWC + 512 + hc + k4); R.rp = (u2){0u, 0u}; R.kp = R.rp;
          if (t0 + tq > 0) { R.rp = *(const u2*)(A.URW + (row - 1) * RWC + hc + k4); R.kp = *(const u2*)(A.URW + (row - 1) * RWC + 512 + hc + k4); } }
        if (wid >= 4) { const int tb = vrt * 16 + fq * 4; const size_t row = rowbase + t0 + tb;
            R.vb0 = (t0 + tb > 0) ? A.URW[(row - 1) * RWC + vcol] : (unsigned short)0;
            R.vb1 = A.URW[(row + 0) * RWC + vcol]; R.vb2 = A.URW[(row + 1) * RWC + vcol]; R.vb3 = A.URW[(row + 2) * RWC + vcol]; R.vb4 = A.URW[(row + 3) * RWC + vcol];
            if (A.layer > 0) { R.vf0 = A.VFIRST[(row + 0) * 512 + vcb + vvc]; R.vf1 = A.VFIRST[(row + 1) * 512 + vcb + vvc]; R.vf2 = A.VFIRST[(row + 2) * 512 + vcb + vvc]; R.vf3 = A.VFIRST[(row + 3) * 512 + vcb + vvc]; } }
    };
    auto prep = [&](int t0) {
        RW_LAS float* VSTw = VST + ((t0 >> 5) & 1) * 1024;
        { f4 aw = (f4){0.f, 0.f, 0.f, 0.f}, aa = aw;
          { const bf16x8 wb0 = *(const RW_LAS bf16x8*)(WUT + lch * SXW + fq * 8), ab0 = *(const RW_LAS bf16x8*)(AUT + lch * SXW + fq * 8);
            const bf16x8 wb1 = *(const RW_LAS bf16x8*)(WUT + lch * SXW + 32 + fq * 8), ab1 = *(const RW_LAS bf16x8*)(AUT + lch * SXW + 32 + fq * 8);
            aw = __builtin_amdgcn_mfma_f32_16x16x32_bf16(R.la0, wb0, aw, 0, 0, 0); aw = __builtin_amdgcn_mfma_f32_16x16x32_bf16(R.la1, wb1, aw, 0, 0, 0);
            aa = __builtin_amdgcn_mfma_f32_16x16x32_bf16(R.la2, ab0, aa, 0, 0, 0); aa = __builtin_amdgcn_mfma_f32_16x16x32_bf16(R.la3, ab1, aa, 0, 0, 0); }
#pragma unroll
          for (int j = 0; j < 4; ++j) { const int tok = lrt * 16 + fq * 4 + j;
              WS[tok * 64 + lch] = __builtin_amdgcn_exp2f(-0.8750404f * fsig(w0c + aw[j]));
              AS[tok * 64 + lch] = fsig(a0c + aa[j]); }
          if (wid < 4) { f4 ag = (f4){0.f, 0.f, 0.f, 0.f};
            { const RW_LAS bf16* gp_ = GUT + vvc * SXG + fq * 8;
              ag = __builtin_amdgcn_mfma_f32_16x16x32_bf16(R.lg0, *(const RW_LAS bf16x8*)(gp_), ag, 0, 0, 0); ag = __builtin_amdgcn_mfma_f32_16x16x32_bf16(R.lg1, *(const RW_LAS bf16x8*)(gp_ + 32), ag, 0, 0, 0);
              ag = __builtin_amdgcn_mfma_f32_16x16x32_bf16(R.lg2, *(const RW_LAS bf16x8*)(gp_ + 64), ag, 0, 0, 0); ag = __builtin_amdgcn_mfma_f32_16x16x32_bf16(R.lg3, *(const RW_LAS bf16x8*)(gp_ + 96), ag, 0, 0, 0); }
#pragma unroll
            for (int j = 0; j < 4; ++j) { const int tok = vrt * 16 + fq * 4 + j; A.G[(rowbase + t0 + tok) * 512 + vcb + vvc] = cvt_1(ag[j]); } }
          else { f4 av = (f4){0.f, 0.f, 0.f, 0.f};
            if (A.layer > 0) { const bf16x8 vb = *(const RW_LAS bf16x8*)(VUT + vvc * SXV + fq * 8); av = __builtin_amdgcn_mfma_f32_16x16x32_bf16(R.lg0, vb, av, 0, 0, 0); }
            const unsigned short vbs[5] = {R.vb0, R.vb1, R.vb2, R.vb3, R.vb4}; const unsigned short vfs[4] = {R.vf0, R.vf1, R.vf2, R.vf3};
#pragma unroll
            for (int j = 0; j < 4; ++j) { const int tok = vrt * 16 + fq * 4 + j; const size_t row = rowbase + t0 + tok;
                const float cur = bf1(vbs[1 + j]), prv = bf1(vbs[j]); float v = cur + muv * (prv - cur);
                if (A.layer == 0) A.VFIRST[row * 512 + vcb + vvc] = cvt_1(v);
                else { const float vf = bf1(vfs[j]), vg = fsig(v0c + av[j]); v = v + (vf - v) * vg; }
                VSTw[tok * 32 + vvc] = v; } } }
        RW_BAR();
        { const size_t row = rowbase + t0 + tq; const u2 rc = R.rc, kc = R.kc, rp = R.rp, kp = R.kp;
          f4 r, k;
          r[0] = bfl(rc.x) + mu_r[0] * (bfl(rp.x) - bfl(rc.x)); r[1] = bfh(rc.x) + mu_r[1] * (bfh(rp.x) - bfh(rc.x)); r[2] = bfl(rc.y) + mu_r[2] * (bfl(rp.y) - bfl(rc.y)); r[3] = bfh(rc.y) + mu_r[3] * (bfh(rp.y) - bfh(rc.y));
          k[0] = bfl(kc.x) + mu_k[0] * (bfl(kp.x) - bfl(kc.x)); k[1] = bfh(kc.x) + mu_k[1] * (bfh(kp.x) - bfh(kc.x)); k[2] = bfl(kc.y) + mu_k[2] * (bfl(kp.y) - bfl(kc.y)); k[3] = bfh(kc.y) + mu_k[3] * (bfh(kp.y) - bfh(kc.y));
          const f4 a = *(const RW_LAS f4*)(AS + tq * 64 + k4), w = *(const RW_LAS f4*)(WS + tq * 64 + k4);
          f4 kk = k * c_kk; float n2 = row16_sum(kk[0] * kk[0] + kk[1] * kk[1] + kk[2] * kk[2] + kk[3] * kk[3]);
          const float inv = fminf(__builtin_amdgcn_rsqf(n2), 1e12f); kk = kk * inv;
          const f4 bb = kk * a; f4 ke;
#pragma unroll
          for (int e = 0; e < 4; ++e) ke[e] = k[e] * (1.f + (a[e] - 1.f) * c_ka[e]);
          const float bon = row16_sum(r[0] * ke[0] * c_rk[0] + r[1] * ke[1] * c_rk[1] + r[2] * ke[2] * c_rk[2] + r[3] * ke[3] * c_rk[3]);
          RW_LAS float* sp = STG + tq * 320 + k4;
          *(RW_LAS f4*)(sp) = r; *(RW_LAS f4*)(sp + 64) = w; *(RW_LAS f4*)(sp + 128) = ke; *(RW_LAS f4*)(sp + 192) = kk; *(RW_LAS f4*)(sp + 256) = bb;
          const float v0 = VSTw[tq * 32 + 2 * q], v1 = VSTw[tq * 32 + 2 * q + 1];
          *(unsigned*)(A.BV + row * 512 + vcb + 2 * q) = cvt_pk(bon * v0, bon * v1); }
        RW_BAR();
    };
    load_raw(0);
    RW_BAR();
    prep(0);
    const int rho = tid >> 4;
    for (int t0 = 0; t0 < SEQ; t0 += CH) {
        if (t0 + CH < SEQ) load_raw(t0 + CH);
        float olo = 0.f, ohi = 0.f;
        { const RW_LAS float* sp = STG + k4; const RW_LAS float* vp = VST + ((t0 >> 5) & 1) * 1024 + rho;
          f4 r = *(const RW_LAS f4*)(sp), w = *(const RW_LAS f4*)(sp + 64), ke = *(const RW_LAS f4*)(sp + 128), kk = *(const RW_LAS f4*)(sp + 192), bb = *(const RW_LAS f4*)(sp + 256); float v = vp[0];
#pragma unroll
          for (int t = 0; t < CH; ++t) {
              f4 rn = r, wn = w, ken = ke, kkn = kk, bbn = bb; float vn = v;
              if (t + 1 < CH) { const RW_LAS float* sn = sp + (t + 1) * 320; rn = *(const RW_LAS f4*)(sn); wn = *(const RW_LAS f4*)(sn + 64); ken = *(const RW_LAS f4*)(sn + 128); kkn = *(const RW_LAS f4*)(sn + 192); bbn = *(const RW_LAS f4*)(sn + 256); vn = vp[(t + 1) * 32]; }
              const float sa = -row16_sum(__builtin_fmaf(S[3], kk[3], __builtin_fmaf(S[2], kk[2], __builtin_fmaf(S[1], kk[1], S[0] * kk[0]))));
              S = S * w + (bb * sa + ke * v);
              const float ov = row16_sum(__builtin_fmaf(S[3], r[3], __builtin_fmaf(S[2], r[2], __builtin_fmaf(S[1], r[1], S[0] * r[0]))));
              if (t < 16) olo = (q == t) ? ov : olo; else ohi = (q == t - 16) ? ov : ohi;
              r = rn; w = wn; ke = ken; kk = kkn; bb = bbn; v = vn; } }
        A.ORW[(rowbase + t0 + q) * 512 + vcb + rho] = cvt_1(olo); A.ORW[(rowbase + t0 + 16 + q) * 512 + vcb + rho] = cvt_1(ohi);
        if (t0 + CH < SEQ) prep(t0 + CH);
    }
    RW_BAR();
}
constexpr int L_STG = 0, L_VST = 81920, L_WS = 90112, L_AS = 98304, L_WUT = 106496, L_AUT = 115712, L_GUT = 124928, L_VUT = 133632, L_END = 136192;
static_assert(L_END <= 146432 - 1024, "scan LDS map");
__device__ __forceinline__ float half8_sum(float v) {
    v += __builtin_bit_cast(float, __builtin_amdgcn_update_dpp(0, __builtin_bit_cast(int, v), 0x141, 0xf, 0xf, false));
    v += __builtin_bit_cast(float, __builtin_amdgcn_update_dpp(0, __builtin_bit_cast(int, v), 0xB1, 0xf, 0xf, false));
    v += __builtin_bit_cast(float, __builtin_amdgcn_update_dpp(0, __builtin_bit_cast(int, v), 0x4E, 0xf, 0xf, false));
    return v;
}
__device__ __forceinline__ void scan_unit_l8(const Args& A, int u, RW_LAS unsigned char* lds) {
    const int tid = tid_now(), lane = tid & 63; const int wid = __builtin_amdgcn_readfirstlane(tid >> 6);
    const int b = u >> 4, h = (u >> 1) & 7, half = u & 1; const size_t rowbase = (size_t)b * SEQ; const int hc = h * 64, vcb = h * 64 + half * 32;
    RW_LAS float* STG = (RW_LAS float*)(lds + L_STG); RW_LAS float* VST = (RW_LAS float*)(lds + L_VST);
    RW_LAS float* WS = (RW_LAS float*)(lds + L_WS); RW_LAS float* AS = (RW_LAS float*)(lds + L_AS);
    RW_LAS bf16* WUT = (RW_LAS bf16*)(lds + L_WUT); RW_LAS bf16* AUT = (RW_LAS bf16*)(lds + L_AUT); RW_LAS bf16* GUT = (RW_LAS bf16*)(lds + L_GUT); RW_LAS bf16* VUT = (RW_LAS bf16*)(lds + L_VUT);
    { float tw[8], ta[8], tg[8], tv[2];
#pragma unroll
      for (int j = 0; j < 8; ++j) { const int idx = tid + j * NT; const int k = idx >> 6, n = idx & 63; tw[j] = A.w_up[(size_t)k * 512 + hc + n]; ta[j] = A.a_up[(size_t)k * 512 + hc + n];
          const int k2 = idx >> 5, n2 = idx & 31; tg[j] = A.g_up[(size_t)k2 * 512 + vcb + n2]; }
#pragma unroll
      for (int j = 0; j < 2; ++j) { const int idx = tid + j * NT; const int k = idx >> 5, n = idx & 31; tv[j] = (A.layer > 0) ? A.v_up[(size_t)k * 512 + vcb + n] : 0.f; }
#pragma unroll
      for (int j = 0; j < 8; ++j) { const int idx = tid + j * NT; const int k = idx >> 6, n = idx & 63; WUT[n * SXW + k] = cvt_1(tw[j]); AUT[n * SXW + k] = cvt_1(ta[j]);
          const int k2 = idx >> 5, n2 = idx & 31; GUT[n2 * SXG + k2] = cvt_1(tg[j]); }
      if (A.layer > 0) {
#pragma unroll
          for (int j = 0; j < 2; ++j) { const int idx = tid + j * NT; const int k = idx >> 5, n = idx & 31; VUT[n * SXV + k] = cvt_1(tv[j]); } } }
    RW_BAR();
    const int fr = lane & 15, fq = lane >> 4;
    if (wid >= 4) {
        const int pw = wid - 4, ptid = tid - 256, q = ptid & 15, k4 = 4 * q, rt = pw & 1, cth = pw >> 1;
        const f4 c_kk = *(const f4*)(A.k_k + hc + k4), c_ka = *(const f4*)(A.k_a + hc + k4), c_rk = *(const f4*)(A.r_k + hc + k4);
        const f4 mu_r = *(const f4*)(A.mu + hc + k4), mu_k = *(const f4*)(A.mu + 512 + hc + k4);
        const int vvc = cth * 16 + fr, vcol = 1024 + vcb + vvc; const float muv = A.mu[vcol], v0c = (A.layer > 0) ? A.v0[vcb + vvc] : 0.f;
        const int ch0 = cth * 16 + fr, ch1 = ch0 + 32; const float w0c0 = A.w0[hc + ch0], a0c0 = A.a0[hc + ch0], w0c1 = A.w0[hc + ch1], a0c1 = A.a0[hc + ch1];
        bf16x8 la0, la1, la2, la3, lg0, lg1, lg2, lg3, lv; u2 rc0, kc0, rp0, kp0, rc1, kc1, rp1, kp1; unsigned short vb0, vb1, vb2, vb3, vb4, vf0, vf1, vf2, vf3;
        auto load_raw = [&](int t0) {
            const bf16* lp = A.LIN + (rowbase + t0 + rt * 16 + fr) * LINC + fq * 8;
            la0 = *(const bf16x8*)(lp); la1 = *(const bf16x8*)(lp + 32); la2 = *(const bf16x8*)(lp + 64); la3 = *(const bf16x8*)(lp + 96);
            lg0 = *(const bf16x8*)(lp + 128); lg1 = *(const bf16x8*)(lp + 160); lg2 = *(const bf16x8*)(lp + 192); lg3 = *(const bf16x8*)(lp + 224); lv = *(const bf16x8*)(lp + 256);
            { const int tq = ptid >> 4; const size_t row = rowbase + t0 + tq; const size_t prow = (t0 + tq > 0) ? row - 1 : row; const bool z_ = (t0 + tq == 0);
              rc0 = *(const u2*)(A.URW + row * RWC + hc + k4); kc0 = *(const u2*)(A.URW + row * RWC + 512 + hc + k4);
              const u2 rp_ = *(const u2*)(A.URW + prow * RWC + hc + k4), kp_ = *(const u2*)(A.URW + prow * RWC + 512 + hc + k4);
              rp0 = (u2){z_ ? 0u : rp_.x, z_ ? 0u : rp_.y}; kp0 = (u2){z_ ? 0u : kp_.x, z_ ? 0u : kp_.y};
              rc1 = *(const u2*)(A.URW + (row + 16) * RWC + hc + k4); kc1 = *(const u2*)(A.URW + (row + 16) * RWC + 512 + hc + k4);
              rp1 = *(const u2*)(A.URW + (row + 15) * RWC + hc + k4); kp1 = *(const u2*)(A.URW + (row + 15) * RWC + 512 + hc + k4); }
            { const int tb = rt * 16 + fq * 4; const size_t row = rowbase + t0 + tb; const size_t prow = (t0 + tb > 0) ? row - 1 : row;
              { const unsigned short v_ = A.URW[prow * RWC + vcol]; vb0 = (t0 + tb == 0) ? (unsigned short)0 : v_; }
              vb1 = A.URW[(row + 0) * RWC + vcol]; vb2 = A.URW[(row + 1) * RWC + vcol]; vb3 = A.URW[(row + 2) * RWC + vcol]; vb4 = A.URW[(row + 3) * RWC + vcol];
              const bf16* fp = (A.layer > 0) ? A.VFIRST + row * 512 + vcb + vvc : A.URW + row * RWC + vcol; const int fs = (A.layer > 0) ? 512 : RWC;
              vf0 = fp[0]; vf1 = fp[fs]; vf2 = fp[2 * fs]; vf3 = fp[3 * fs]; }
        };
        auto prepB = [&](int t0, int nb) {
            RW_LAS float* VSTw = VST + nb * 1024;
            { f4 aw0 = (f4){0.f, 0.f, 0.f, 0.f}, aa0 = aw0, aw1 = aw0, aa1 = aw0;
              { const RW_LAS bf16* wp = WUT + ch0 * SXW + fq * 8; const RW_LAS bf16* ap = AUT + ch0 * SXW + fq * 8;
                aw0 = __builtin_amdgcn_mfma_f32_16x16x32_bf16(la0, *(const RW_LAS bf16x8*)(wp), aw0, 0, 0, 0); aw0 = __builtin_amdgcn_mfma_f32_16x16x32_bf16(la1, *(const RW_LAS bf16x8*)(wp + 32), aw0, 0, 0, 0);
                aa0 = __builtin_amdgcn_mfma_f32_16x16x32_bf16(la2, *(const RW_LAS bf16x8*)(ap), aa0, 0, 0, 0); aa0 = __builtin_amdgcn_mfma_f32_16x16x32_bf16(la3, *(const RW_LAS bf16x8*)(ap + 32), aa0, 0, 0, 0);
                aw1 = __builtin_amdgcn_mfma_f32_16x16x32_bf16(la0, *(const RW_LAS bf16x8*)(wp + 32 * SXW), aw1, 0, 0, 0); aw1 = __builtin_amdgcn_mfma_f32_16x16x32_bf16(la1, *(const RW_LAS bf16x8*)(wp + 32 * SXW + 32), aw1, 0, 0, 0);
                aa1 = __builtin_amdgcn_mfma_f32_16x16x32_bf16(la2, *(const RW_LAS bf16x8*)(ap + 32 * SXW), aa1, 0, 0, 0); aa1 = __builtin_amdgcn_mfma_f32_16x16x32_bf16(la3, *(const RW_LAS bf16x8*)(ap + 32 * SXW + 32), aa1, 0, 0, 0); }
#pragma unroll
              for (int j = 0; j < 4; ++j) { const int tok = rt * 16 + fq * 4 + j;
                  WS[tok * 64 + ch0] = __builtin_amdgcn_exp2f(-0.8750404f * fsig(w0c0 + aw0[j])); AS[tok * 64 + ch0] = fsig(a0c0 + aa0[j]);
                  WS[tok * 64 + ch1] = __builtin_amdgcn_exp2f(-0.8750404f * fsig(w0c1 + aw1[j])); AS[tok * 64 + ch1] = fsig(a0c1 + aa1[j]); } }
            { f4 ag = (f4){0.f, 0.f, 0.f, 0.f}; const RW_LAS bf16* gp_ = GUT + vvc * SXG + fq * 8;
              ag = __builtin_amdgcn_mfma_f32_16x16x32_bf16(lg0, *(const RW_LAS bf16x8*)(gp_), ag, 0, 0, 0); ag = __builtin_amdgcn_mfma_f32_16x16x32_bf16(lg1, *(const RW_LAS bf16x8*)(gp_ + 32), ag, 0, 0, 0);
              ag = __builtin_amdgcn_mfma_f32_16x16x32_bf16(lg2, *(const RW_LAS bf16x8*)(gp_ + 64), ag, 0, 0, 0); ag = __builtin_amdgcn_mfma_f32_16x16x32_bf16(lg3, *(const RW_LAS bf16x8*)(gp_ + 96), ag, 0, 0, 0);
#pragma unroll
              for (int j = 0; j < 4; ++j) A.G[(rowbase + t0 + rt * 16 + fq * 4 + j) * 512 + vcb + vvc] = cvt_1(ag[j]); }
            { f4 av = (f4){0.f, 0.f, 0.f, 0.f};
              if (A.layer > 0) av = __builtin_amdgcn_mfma_f32_16x16x32_bf16(lv, *(const RW_LAS bf16x8*)(VUT + vvc * SXV + fq * 8), av, 0, 0, 0);
              const unsigned short vbs[5] = {vb0, vb1, vb2, vb3, vb4}; const unsigned short vfs[4] = {vf0, vf1, vf2, vf3};
#pragma unroll
              for (int j = 0; j < 4; ++j) { const int tok = rt * 16 + fq * 4 + j; const size_t row = rowbase + t0 + tok;
                  const float cur = bf1(vbs[1 + j]), prv = bf1(vbs[j]); float v = cur + muv * (prv - cur);
                  if (A.layer == 0) A.VFIRST[row * 512 + vcb + vvc] = cvt_1(v);
                  else { const float vf = bf1(vfs[j]), vg = fsig(v0c + av[j]); v = v + (vf - v) * vg; }
                  VSTw[tok * 32 + vvc] = v; } }
        };
        auto prepC = [&](int t0, int nb) {
            RW_LAS float* VSTw = VST + nb * 1024;
#pragma unroll
            for (int pass = 0; pass < 2; ++pass) { const int tq = (ptid >> 4) + 16 * pass; const size_t row = rowbase + t0 + tq;
                const u2 rc = pass ? rc1 : rc0, kc = pass ? kc1 : kc0, rp = pass ? rp1 : rp0, kp = pass ? kp1 : kp0; f4 r, k;
                r[0] = bfl(rc.x) + mu_r[0] * (bfl(rp.x) - bfl(rc.x)); r[1] = bfh(rc.x) + mu_r[1] * (bfh(rp.x) - bfh(rc.x)); r[2] = bfl(rc.y) + mu_r[2] * (bfl(rp.y) - bfl(rc.y)); r[3] = bfh(rc.y) + mu_r[3] * (bfh(rp.y) - bfh(rc.y));
                k[0] = bfl(kc.x) + mu_k[0] * (bfl(kp.x) - bfl(kc.x)); k[1] = bfh(kc.x) + mu_k[1] * (bfh(kp.x) - bfh(kc.x)); k[2] = bfl(kc.y) + mu_k[2] * (bfl(kp.y) - bfl(kc.y)); k[3] = bfh(kc.y) + mu_k[3] * (bfh(kp.y) - bfh(kc.y));
                const f4 a = *(const RW_LAS f4*)(AS + tq * 64 + k4), w = *(const RW_LAS f4*)(WS + tq * 64 + k4);
                f4 kk = k * c_kk; const float n2 = row16_sum(kk[0] * kk[0] + kk[1] * kk[1] + kk[2] * kk[2] + kk[3] * kk[3]);
                const float inv = fminf(__builtin_amdgcn_rsqf(n2), 1e12f); kk = kk * inv;
                const f4 bb = kk * a; f4 ke;
#pragma unroll
                for (int e = 0; e < 4; ++e) ke[e] = k[e] * (1.f + (a[e] - 1.f) * c_ka[e]);
                const float bon = row16_sum(r[0] * ke[0] * c_rk[0] + r[1] * ke[1] * c_rk[1] + r[2] * ke[2] * c_rk[2] + r[3] * ke[3] * c_rk[3]);
                RW_LAS float* sp = STG + nb * 10240 + tq * 320 + k4;
                *(RW_LAS f4*)(sp) = r; *(RW_LAS f4*)(sp + 64) = w; *(RW_LAS f4*)(sp + 128) = ke; *(RW_LAS f4*)(sp + 192) = kk; *(RW_LAS f4*)(sp + 256) = bb;
                const float v0 = VSTw[tq * 32 + 2 * q], v1 = VSTw[tq * 32 + 2 * q + 1];
                *(unsigned*)(A.BV + row * 512 + vcb + 2 * q) = cvt_pk(bon * v0, bon * v1); }
        };
        load_raw(0);
#pragma unroll 1
        for (int t0 = -CH; t0 < SEQ; t0 += CH) { const bool has_next = t0 + CH < SEQ; const int nb = ((t0 >> 5) + 1) & 1;
            if (has_next) prepB(t0 + CH, nb);
            RW_BAR();
            if (has_next) { prepC(t0 + CH, nb); if (t0 + 2 * CH < SEQ) load_raw(t0 + 2 * CH); }
            RW_BAR(); }
    } else {
        const int q8 = lane & 7, rho = wid * 8 + (lane >> 3), k8 = 8 * q8;
        typedef float f2 __attribute__((ext_vector_type(2)));
        f2 S0 = (f2){0.f, 0.f}, S1 = S0, S2 = S0, S3 = S0;
#define LO2(v_) __builtin_shufflevector(v_, v_, 0, 1)
#define HI2(v_) __builtin_shufflevector(v_, v_, 2, 3)
        RW_BAR(); RW_BAR();
        for (int t0 = 0; t0 < SEQ; t0 += CH) { const int cb = (t0 >> 5) & 1;
            float o0 = 0.f, o1 = 0.f, o2 = 0.f, o3 = 0.f;
            const RW_LAS float* sp = STG + cb * 10240 + k8; const RW_LAS float* vp = VST + cb * 1024 + rho;
            f4 ra = *(const RW_LAS f4*)(sp), rb = *(const RW_LAS f4*)(sp + 4), wa = *(const RW_LAS f4*)(sp + 64), wb = *(const RW_LAS f4*)(sp + 68), kea = *(const RW_LAS f4*)(sp + 128), keb = *(const RW_LAS f4*)(sp + 132),
               kka = *(const RW_LAS f4*)(sp + 192), kkb = *(const RW_LAS f4*)(sp + 196), bba = *(const RW_LAS f4*)(sp + 256), bbb = *(const RW_LAS f4*)(sp + 260); float v = vp[0];
#pragma unroll
            for (int t = 0; t < CH; ++t) {
                if (t == 16) RW_BAR();
                f4 ran = ra, rbn = rb, wan = wa, wbn = wb, kean = kea, kebn = keb, kkan = kka, kkbn = kkb, bban = bba, bbbn = bbb; float vn = v;
                if (t + 1 < CH) { const RW_LAS float* sn = sp + (t + 1) * 320; ran = *(const RW_LAS f4*)(sn); rbn = *(const RW_LAS f4*)(sn + 4); wan = *(const RW_LAS f4*)(sn + 64); wbn = *(const RW_LAS f4*)(sn + 68);
                    kean = *(const RW_LAS f4*)(sn + 128); kebn = *(const RW_LAS f4*)(sn + 132); kkan = *(const RW_LAS f4*)(sn + 192); kkbn = *(const RW_LAS f4*)(sn + 196); bban = *(const RW_LAS f4*)(sn + 256); bbbn = *(const RW_LAS f4*)(sn + 260);
                    vn = vp[(t + 1) * 32]; }
                f2 dA = S0 * LO2(kka); dA = S1 * HI2(kka) + dA; f2 dB = S2 * LO2(kkb); dB = S3 * HI2(kkb) + dB; const f2 d2 = dA + dB;
                const f2 Sw0 = S0 * LO2(wa) + LO2(kea) * v, Sw1 = S1 * HI2(wa) + HI2(kea) * v, Sw2 = S2 * LO2(wb) + LO2(keb) * v, Sw3 = S3 * HI2(wb) + HI2(keb) * v;
                const float sum = half8_sum(d2.x + d2.y);
                S0 = Sw0 - LO2(bba) * sum; S1 = Sw1 - HI2(bba) * sum; S2 = Sw2 - LO2(bbb) * sum; S3 = Sw3 - HI2(bbb) * sum;
                f2 eA = S0 * LO2(ra); eA = S1 * HI2(ra) + eA; f2 eB = S2 * LO2(rb); eB = S3 * HI2(rb) + eB; const f2 e2 = eA + eB;
                const float ov = half8_sum(e2.x + e2.y);
                if (t < 8) o0 = (q8 == t) ? ov : o0; else if (t < 16) o1 = (q8 == t - 8) ? ov : o1; else if (t < 24) o2 = (q8 == t - 16) ? ov : o2; else o3 = (q8 == t - 24) ? ov : o3;
                ra = ran; rb = rbn; wa = wan; wb = wbn; kea = kean; keb = kebn; kka = kkan; kkb = kkbn; bba = bban; bbb = bbbn; v = vn; }
            { bf16* op = A.ORW + (rowbase + t0 + q8) * 512 + vcb + rho; op[0] = cvt_1(o0); op[8 * 512] = cvt_1(o1); op[16 * 512] = cvt_1(o2); op[24 * 512] = cvt_1(o3); }
            RW_BAR();
        }
    }
}
__device__ __forceinline__ void post_phase(const Frame& F, bf16* ORW, const bf16* G, const bf16* BV, const float* lw, const float* lb) {
    const int tid = tid_now(); const int q = tid & 7, grp = (F.bid * NT + tid) >> 3, ngrp = (F.G * NT) >> 3;
    for (int it = grp; it < M * 8; it += 2 * ngrp) { const int it2 = it + ngrp; const bool two = it2 < M * 8;
        const size_t offa = (size_t)(it >> 3) * 512 + (it & 7) * 64 + 8 * q, offb = two ? (size_t)(it2 >> 3) * 512 + (it2 & 7) * 64 + 8 * q : offa;
        const u4 ova = *(const u4*)(ORW + offa), gva = *(const u4*)(G + offa), bva = *(const u4*)(BV + offa);
        const u4 ovb = *(const u4*)(ORW + offb), gvb = *(const u4*)(G + offb), bvb = *(const u4*)(BV + offb);
#pragma unroll
        for (int h = 0; h < 2; ++h) { const u4 ov = h ? ovb : ova, gv = h ? gvb : gva, bv = h ? bvb : bva; const int ih = h ? it2 : it; const size_t off = h ? offb : offa;
            f4 o0 = (f4){bfl(ov.x), bfh(ov.x), bfl(ov.y), bfh(ov.y)}, o1 = (f4){bfl(ov.z), bfh(ov.z), bfl(ov.w), bfh(ov.w)};
            const float mean = half8_sum((o0[0] + o0[1] + o0[2] + o0[3]) + (o1[0] + o1[1] + o1[2] + o1[3])) * (1.f / 64.f); o0 = o0 - mean; o1 = o1 - mean;
            const float var = half8_sum((o0[0] * o0[0] + o0[1] * o0[1] + o0[2] * o0[2] + o0[3] * o0[3]) + (o1[0] * o1[0] + o1[1] * o1[1] + o1[2] * o1[2] + o1[3] * o1[3])) * (1.f / 64.f);
            const float rs = __builtin_amdgcn_rsqf(var + 64e-5f);
            const int c = (ih & 7) * 64 + 8 * q; const f4 w0 = *(const f4*)(lw + c), w1 = *(const f4*)(lw + c + 4), b0 = *(const f4*)(lb + c), b1 = *(const f4*)(lb + c + 4);
            f4 r0 = o0 * rs * w0 + b0 + (f4){bfl(bv.x), bfh(bv.x), bfl(bv.y), bfh(bv.y)}, r1 = o1 * rs * w1 + b1 + (f4){bfl(bv.z), bfh(bv.z), bfl(bv.w), bfh(bv.w)};
            r0 = r0 * (f4){bfl(gv.x), bfh(gv.x), bfl(gv.y), bfh(gv.y)}; r1 = r1 * (f4){bfl(gv.z), bfh(gv.z), bfl(gv.w), bfh(gv.w)};
            if (h == 0 || two) *(u4*)(ORW + off) = (u4){cvt_pk(r0[0], r0[1]), cvt_pk(r0[2], r0[3]), cvt_pk(r1[0], r1[1]), cvt_pk(r1[2], r1[3])}; }
    }
}
}
#ifndef EN_P0
#define EN_P0 1
#endif
#ifndef EN_G1
#define EN_G1 1
#endif
#ifndef EN_SCAN
#define EN_SCAN 1
#endif
#ifndef EN_ATTN
#define EN_ATTN 1
#endif
#ifndef EN_P3
#define EN_P3 1
#endif
#ifndef EN_P4
#define EN_P4 1
#endif
#ifndef EN_REST
#define EN_REST 255
#endif
#ifndef EN_XATTN
#define EN_XATTN 1
#endif
__device__ __forceinline__ int opaque1(int v) { asm volatile("" : "+s"(v)); return v; }
#ifndef DUPMASK
#define DUPMASK 0
#endif
#define REP(bit) for (int rep_ = 0; rep_ < (((DUPMASK >> (bit)) & 1) ? opaque1(2) : 1); ++rep_)
#ifndef STOP_AFTER
#define STOP_AFTER 1000
#endif
#ifndef DIAG_BIN
#define DIAG_BIN 10.f
#endif
#ifndef DIAG_OFF
#define DIAG_OFF 0.f
#endif
#ifdef DIAG_PHASE
#define TSTAMP() do { if (F.bid == 0 && threadIdx.x == 0) ((volatile LAS unsigned long long*)(F.lds + LDSCTL_OFF + 512))[phase_no] = __builtin_amdgcn_s_memrealtime(); } while (0)
#else
#define TSTAMP() do {} while (0)
#endif
__device__ __forceinline__ CvItem tail_item(const Params& P, int l, int it, bf16* wbr, bf16* wout, bf16* wxq, bf16* wkv) {
    CvItem c;
    if (it < 768) { const int n = it >> 8, r = it & 255; c.W = P.in[27] + ((size_t)l * 3 + n) * 512 * DM; c.ldw = DM; c.K = 512; c.gain = nullptr; c.WT = wbr + (size_t)n * DM * 512; c.roff = 0; c.kb = r >> 5; c.nb = r & 31; }
    else if (it < 1280) { const int r = it - 768; c.W = P.in[28] + (size_t)l * DM * DM; c.ldw = DM; c.K = DM; c.gain = nullptr; c.WT = wout; c.roff = 0; c.kb = r >> 5; c.nb = r & 31; }
    else if (it < 1536) { const int r = it - 1280; c.W = P.in[29] + (size_t)l * DM * 512; c.ldw = 512; c.K = DM; c.gain = P.in[5] + l * DM; c.WT = wxq; c.roff = 0; c.kb = r >> 4; c.nb = r & 15; }
    else if (it < 1792) { const int r = it - 1536; c.W = P.in[30] + (size_t)l * DM * 512; c.ldw = 512; c.K = DM; c.gain = P.in[7] + l * DM; c.WT = wkv; c.roff = 0; c.kb = r >> 4; c.nb = r & 15; }
    else { const int r = it - 1792; c.W = P.in[31] + (size_t)l * DM * 512; c.ldw = 512; c.K = DM; c.gain = P.in[7] + l * DM; c.WT = wkv; c.roff = 512; c.kb = r >> 4; c.nb = r & 15; }
    return c;
}
__device__ __forceinline__ int in_items(int l) { return 3584 + (l > 0 ? 16 : 0); }
__device__ __forceinline__ CvItem in_item(const Params& P, int l, int it, bf16* wa, bf16* wab, bf16* wg) {
    CvItem c; c.ldw = INC; c.K = DM; c.gain = P.in[3] + l * DM; c.roff = 0; const float* W = P.in[10] + (size_t)l * DM * INC;
    if (it < 1536) { c.W = W; c.WT = wa; c.rmode = 1; c.kb = it / 96; c.nb = it - c.kb * 96; }
    else if (it < 2048) { const int r = it - 1536; c.W = W + PA_COLS; c.WT = wab; c.rmode = 2; c.kb = r >> 5; c.nb = r & 31; }
    else if (it < 3584) { const int r = it - 2048; c.W = W + 4096; c.WT = wg; c.rmode = 0; c.kb = r / 96; c.nb = r - c.kb * 96; }
    else { const int r = it - 3584; c.W = P.in[22]; c.ldw = 32; c.WT = wab; c.rmode = 0; c.roff = 4096 - PA_COLS; c.kb = r; c.nb = 0; }
    return c;
}
__device__ __forceinline__ CvItem late_item(const Params& P, int l, int it, bf16* wxo, bf16* wup, bf16* wdn) {
    CvItem c; c.roff = 0; c.rmode = 0;
    if (it < 256) { c.W = P.in[32] + (size_t)l * 512 * DM; c.ldw = DM; c.K = 512; c.gain = nullptr; c.WT = wxo; c.kb = it >> 5; c.nb = it & 31; }
    else if (it < 2304) { const int r = it - 256; c.W = P.in[33] + (size_t)l * DM * FFD; c.ldw = FFD; c.K = DM; c.gain = P.in[8] + l * DM; c.WT = wup; c.kb = r >> 7; c.nb = r & 127; }
    else { const int r = it - 2304; c.W = P.in[34] + (size_t)l * FFD * DM; c.ldw = DM; c.K = FFD; c.gain = nullptr; c.WT = wdn; c.kb = r >> 5; c.nb = r & 31; }
    return c;
}
__global__ void __launch_bounds__(NT, 2) fwd_megakernel(Params P) {
    extern __shared__ __attribute__((aligned(16))) unsigned char lds_raw[];
    Frame F; F.lds = (LAS unsigned char*)lds_raw; F.wave = __builtin_amdgcn_readfirstlane(threadIdx.x >> 6); F.G = gridDim.x; F.bid = blockIdx.x;
    unsigned char* ws = P.ws;
    volatile LAS unsigned* MISC = (volatile LAS unsigned*)(F.lds + MISC_OFF);
    for (int u = threadIdx.x; u < (LDS_BYTES - LDSCTL_OFF) / 4; u += NT) ((LAS unsigned*)(F.lds + LDSCTL_OFF))[u] = 0u;
    __syncthreads();
    XcdBarrier bar = xcd_barrier_post((unsigned*)(ws + WS_CTL) + CW_BAR, MISC + 8);
    int phase_no = 0; TSTAMP();
#define GRID_BAR() do { XcdBarrier b2_ = bar; asm volatile("" : "+s"(b2_.bar), "+s"(b2_.x)); xcd_barrier(b2_); ++phase_no; TSTAMP(); } while (0)
#define XN ((bf16*)(ws + WS_XN))
#define URW ((bf16*)(ws + WS_URW))
#define MQ ((bf16*)(ws + WS_MQ))
#define MK ((bf16*)(ws + WS_MK))
#define MV ((bf16*)(ws + WS_MV))
#define SQ ((bf16*)(ws + WS_SQ))
#define SK ((bf16*)(ws + WS_SK))
#define SV ((bf16*)(ws + WS_SV))
#define ORW ((bf16*)(ws + WS_ORW))
#define VM ((bf16*)(ws + WS_VM))
#define GATE ((bf16*)(ws + WS_GATE))
#define ZB ((bf16*)(P.out))
#define RS ((float*)(ws + WS_RS))
#define Y ((bf16*)(ws + WS_Y))
#define Y2 ((bf16*)(ws + WS_MQ))
#define QX ((bf16*)(ws + WS_QX))
#define HMID ((bf16*)(ws + WS_HMID))
#define WA ((bf16*)(ws + WS_WA))
#define WAB ((bf16*)(ws + WS_WAB))
#define WG ((bf16*)(ws + WS_WG))
#define WBR ((bf16*)(ws + WS_WBR))
#define WOUT ((bf16*)(ws + WS_WOUT))
#define WXQ ((bf16*)(ws + WS_WXQ))
#define WXO ((bf16*)(ws + WS_WXO))
#define WUP ((bf16*)(ws + WS_WUP))
#define WDN ((bf16*)(ws + WS_WDN))
#define MN ((bf16*)((unsigned char*)P.out + 32 * MiB))
#define WKV ((bf16*)((unsigned char*)P.out + 36 * MiB))
#define VFIRST ((bf16*)(ws + WS_VFIRST))
#define LINB ((bf16*)(ws + WS_WA))
#define GB ((bf16*)(ws + WS_G))
#define BVB ((bf16*)(ws + WS_BV))
#define KM ((float*)(ws + WS_KM))
#define ROPE ((float*)(ws + WS_ROPE))
    const int gw = F.bid * NWAVES + F.wave, NGW = F.G * NWAVES, GT = F.G * NT;
#define gtid (F.bid * NT + tid_now())

#define CONV_WA(l) do { convert_matrix(F, P.in[10] + (size_t)(l) * DM * INC, INC, 0, DM, PA_COLS, P.in[3] + (l) * DM, WA, MapWA{}); \
        convert_matrix(F, P.in[10] + (size_t)(l) * DM * INC, INC, PA_COLS, DM, 4096 - PA_COLS, P.in[3] + (l) * DM, WAB, MapWAB{}); \
        if ((l) > 0) convert_matrix(F, P.in[22], 32, 0, DM, 32, P.in[3] + (l) * DM, WAB, MapId{4096 - PA_COLS}); } while (0)
#define CONV_WG(l) convert_matrix(F, P.in[10] + (size_t)(l) * DM * INC, INC, 4096, DM, 3072, P.in[3] + (l) * DM, WG, MapId{0})

    if (EN_P0) REP(0) {
        const int lane0 = tid_now() & 63;
        for (int r = gw; r < M; r += 4 * NGW) norm_rows4_to_bf16(P.in[0], XN, RS, r, NGW, M, lane0);
        { const int* pos = (const int*)P.in[2];
          for (int i = gtid; i < M * 32; i += GT) { const int t = i >> 5, f = i & 31;
              const float invf = __builtin_amdgcn_exp2f(-(float)f * 0.41524101186092029f);
              const float ang = (float)pos[t] * invf; float rev = ang * 0.15915494309189535f; rev -= floorf(rev);
              ROPE[2 * i] = __builtin_amdgcn_cosf(rev); ROPE[2 * i + 1] = __builtin_amdgcn_sinf(rev); } }
        { const int g0_ = gtid;
#pragma unroll
          for (int k_ = 0; k_ < 4; ++k_) { const int i = g0_ + k_ * GT; if (i < 64 * 512) KM[i] = 0.f; } }
        { LAS float* scr = (LAS float*)(F.lds + F.wave * 16384); const int lane = tid_now() & 63, tot = in_items(0);
          for (int it = gw; it < tot; it += 2 * NGW) { const int it2 = it + NGW; const bool has2 = it2 < tot;
              const CvItem c1 = in_item(P, 0, it, WA, WAB, WG), c2 = in_item(P, 0, has2 ? it2 : it, WA, WAB, WG); transpose_pair(c1, c2, has2, scr, lane); } }
        { const int lane1 = tid_now() & 63; for (int r = gw; r < MM; r += NGW) norm_row_to_bf16(P.in[1] + (size_t)r * DM, MN + (size_t)r * DM, lane1); }
    }
    GRID_BAR();
    for (int l = 0; l < 2; ++l) {
        if (EN_G1) REP(1) {
          pg8::Gemm g{XN, WA, M, PA_COLS, DM}; pg8::StaticOrder S; S.init(M, PA_COLS, F.G, F.bid);
          pg8::EpiG1 E{ws, QS64, 0};
          pg8::gemm_phase<pg8::EpiG1, pg8::StaticOrder, true, true>(F.lds, g, S, E);
          if (l > 0) vm_phase(F, XN, WAB + (size_t)(4096 - PA_COLS) * DM, VM); }
        GRID_BAR();
        REP(10) rw::lin_phase(F, URW, VM, P.in[11] + l * RWC, P.in[23], l, LINB);
        GRID_BAR();
        { const int nS = F.G >> 1, nA = F.G - nS;
          if (F.bid < nS) {
            if (EN_SCAN) for (int gidx = F.bid; gidx < 128; gidx += nS) {
                rw::Args A{URW, LINB, VFIRST, ORW, GB, BVB, P.in[11] + l * RWC, P.in[12] + l * 512, P.in[13] + (size_t)l * 64 * 512, P.in[14] + l * 512, P.in[15] + (size_t)l * 64 * 512,
                           P.in[16] + (size_t)l * 128 * 512, P.in[17] + l * 512, P.in[18] + l * 512, P.in[19] + l * 512, P.in[23], P.in[24], P.in[25], l};
#ifdef SCAN_L8
                rw::scan_unit_l8(A, gidx, (RW_LAS unsigned char*)F.lds);
#else
                rw::scan_unit(A, gidx, (RW_LAS unsigned char*)F.lds);
#endif
            }
          } else {
            const int ia = F.bid - nS;
            { pg8::Gemm g{XN, WAB, M, 4096 - PA_COLS, DM}; pg8::StaticOrder S; S.init(M, 4096 - PA_COLS, nA, ia);
              pg8::EpiG1 E{ws, QS64, PA_COLS / 256};
              pg8::gemm_phase<pg8::EpiG1, pg8::StaticOrder, true, true>(F.lds, g, S, E); }
            sub_barrier((unsigned*)(ws + WS_CTL) + 512 + 64 * l, (unsigned)nA);
            if (EN_ATTN) for (int j = ia; j < 128; j += nA) {
                const int bh = j & 63, par = j >> 6, b = bh >> 3, h = bh & 7;
                for (int i = 0; i < 4; ++i) {
                    const int qb = par == 0 ? (i == 0 ? 7 : i == 1 ? 4 : i == 2 ? 3 : 0) : (i == 0 ? 6 : i == 1 ? 5 : i == 2 ? 2 : 1);
                    const size_t rb = (size_t)b * SEQ;
                    at::Ten T{MQ + rb * 512 + h * 64, 512, MK + rb * 512 + h * 64, MV + rb * 512 + h * 64, 512, MQ + rb * 512 + h * 64, 512};
                    at::attn_unit<64, 0>(T, qb * 256, 0, 0, 0.f, KM + (size_t)b * 8 * 512 + h * 64, (at::lds_ptr)F.lds);
                }
                for (int i = 0; i < 4; ++i) {
                    const int un = j * 4 + i, qb = un & 7, hq = (un >> 3) & 7, b2 = un >> 6; const size_t rb = (size_t)b2 * SEQ;
                    at::Ten T{SQ + rb * 512 + hq * 64, 512, SK + rb * 128 + (hq >> 2) * 64, SV + rb * 128 + (hq >> 2) * 64, 128, SQ + rb * 512 + hq * 64, 512};
                    const int kt0 = qb == 0 ? 0 : 4 * qb - 2, ntl = 4 * qb + 4 - kt0;
                    at::attn_unit<64, 1>(T, qb * 256, kt0, ntl, P.in[26][l * 8 + hq] * LOG2E, nullptr, (at::lds_ptr)F.lds);
                }
            }
            { LAS float* scr = (LAS float*)(F.lds + F.wave * 16384); const int lane = tid_now() & 63, nw = nA * NWAVES;
              for (int it = ia * NWAVES + F.wave; it < 2048; it += 2 * nw) { const int it2 = it + nw; const bool has2 = it2 < 2048;
                  const CvItem c1 = tail_item(P, l, it, WBR, WOUT, WXQ, WKV), c2 = tail_item(P, l, has2 ? it2 : it, WBR, WOUT, WXQ, WKV);
                  transpose_pair(c1, c2, has2, scr, lane); } }
          } }
        GRID_BAR();
        if (EN_P3) { pg8::Gemm g{XN, WG, M, 3072, DM}; pg8::StaticOrder S; S.init(M, 3072, F.G, F.bid);
          pg8::EpiStore<2> E{GATE, 3072, 1.f};
          REP(2) pg8::gemm_phase<pg8::EpiStore<2>, pg8::StaticOrder, true, true>(F.lds, g, S, E);
          rw::post_phase(F, ORW, GB, BVB, P.in[20] + l * 512, P.in[21] + l * 512);
          { const int g0_ = gtid;
#pragma unroll
          for (int k_ = 0; k_ < 4; ++k_) { const int i = g0_ + k_ * GT; if (i < 64 * 512) KM[i] = 0.f; } }     }
        GRID_BAR();
        if (EN_P4) { { pg8::Gemm g{MQ, WBR, 3 * M, 3072, 512}; pg8::ThreePassOrder S; S.init(M, F.G, F.bid);
              pg8::EpiZ3 E{ZB, GATE, (bf16*)(ws + WS_G)};
              pg8::gemm_phase<pg8::EpiZ3, pg8::ThreePassOrder, true, true>(F.lds, g, S, E); }
 }
        GRID_BAR();
        if (EN_REST & 1) {
          if (F.G == 256) {
            pg8::Gemm g{ZB, WOUT, M, DM, DM}; pg8::StaticOrder S; S.init(M, DM, F.G, F.bid);
            pg8::PanelRms s1{(unsigned*)(ws + WS_XB), (unsigned)(l * 6 + 0 + 1)}, s2{(unsigned*)(ws + WS_XB + 512 * 1024), (unsigned)(l * 6 + 1 + 1)};
            pg8::EpiRmsResRms E{XN, RS, nullptr, P.in[4] + l * DM, s1, s2};
            pg8::gemm_phase<pg8::EpiRmsResRms, pg8::StaticOrder, false, true>(F.lds, g, S, E);
          } else {
            { pg8::Gemm g{ZB, WOUT, M, DM, DM}; pg8::StaticOrder S; S.init(M, DM, F.G, F.bid);
              pg8::EpiStore<0> E{Y, DM, 1.f};
              pg8::gemm_phase<pg8::EpiStore<0>, pg8::StaticOrder, true, true>(F.lds, g, S, E); }
            GRID_BAR();
            row_phase(F, XN, RS, Y, P.in[4] + l * DM, nullptr);
          } }
        GRID_BAR();
        if (EN_REST & 4) {
          pg8::Gemm g{XN, WXQ, M, 512, DM}; pg8::StaticOrder S; S.init(M, 512, F.G, F.bid);
          pg8::EpiStore<0> E{QX, 512, QS128};
          REP(5) pg8::gemm_phase<pg8::EpiStore<0>, pg8::StaticOrder, true, true>(F.lds, g, S, E);
          { pg8::Gemm g2{MN, WKV, MM, DM, DM}; pg8::StaticOrder S2; int c2 = F.bid + 128; if (c2 >= F.G) c2 -= F.G; S2.init(MM, DM, F.G, c2);
            pg8::EpiKV E2{(bf16*)(ws + WS_MEMKV), (bf16*)(ws + WS_MEMKV + 2 * MiB)};
            pg8::gemm_phase<pg8::EpiKV, pg8::StaticOrder, true, true>(F.lds, g2, S2, E2); }
          { const bool split = (F.G == 256); const int nlate = 4352, tot = nlate + (l == 0 ? in_items(1) : 0), nI = split ? (l == 0 ? 5800 : tot) : 0;
            int first, last, w0, nwv;
            if (split && F.bid >= 160) { first = 0; last = nI; w0 = (F.bid - 160) * NWAVES + F.wave; nwv = 96 * NWAVES; }
            else { first = nI; last = tot; w0 = F.bid * NWAVES + F.wave; nwv = (split ? 160 : F.G) * NWAVES; }
            LAS float* scr = (LAS float*)(F.lds + F.wave * 16384); const int lane = tid_now() & 63;
            for (int it = first + w0; it < last; it += 2 * nwv) { const int it2r = it + nwv; const bool has2 = it2r < last; const int it2 = has2 ? it2r : it;
                const CvItem c1 = (it < nlate) ? late_item(P, l, it, WXO, WUP, WDN) : in_item(P, 1, it - nlate, WA, WAB, WG);
                const CvItem c2 = (it2 < nlate) ? late_item(P, l, it2, WXO, WUP, WDN) : in_item(P, 1, it2 - nlate, WA, WAB, WG);
                transpose_pair(c1, c2, has2, scr, lane); } } }
        GRID_BAR();
        if (EN_XATTN) REP(9) for (int un = F.bid; un < 256; un += F.G) { const int qb = un & 7, h = (un >> 3) & 3, b = un >> 5;
            const bf16* Kx = (const bf16*)(ws + WS_MEMKV) + (size_t)b * MEMLEN * 512 + h * 128; const bf16* Vx = Kx + MiB;
            bf16* Odst = (((DUPMASK >> 9) & 1) && rep_ == 0) ? (bf16*)(ws + 152 * MiB) : QX;
            at::Ten T{QX + (size_t)b * SEQ * 512 + h * 128, 512, Kx, Vx, 512, Odst + (size_t)b * SEQ * 512 + h * 128, 512};
            at::attn_unit<128, 2>(T, qb * 256, 0, 4, 0.f, nullptr, (at::lds_ptr)F.lds); }
        GRID_BAR();
        if (EN_REST & 8) {
          if (F.G == 256) {
            pg8::Gemm g{QX, WXO, M, DM, 512}; pg8::StaticOrder S; S.init(M, DM, F.G, F.bid);
            pg8::PanelRms s1{(unsigned*)(ws + WS_XB), (unsigned)(l * 6 + 2 + 1)}, s2{(unsigned*)(ws + WS_XB + 512 * 1024), (unsigned)(l * 6 + 3 + 1)};
            pg8::EpiRmsResRms E{XN, RS, nullptr, P.in[6] + l * DM, s1, s2};
            pg8::gemm_phase<pg8::EpiRmsResRms, pg8::StaticOrder, false, true>(F.lds, g, S, E);
          } else {
            { pg8::Gemm g{QX, WXO, M, DM, 512}; pg8::StaticOrder S; S.init(M, DM, F.G, F.bid);
              pg8::EpiStore<0> E{Y, DM, 1.f};
              pg8::gemm_phase<pg8::EpiStore<0>, pg8::StaticOrder, true, true>(F.lds, g, S, E); }
            GRID_BAR();
            row_phase(F, XN, RS, Y, P.in[6] + l * DM, nullptr);
          } }
        GRID_BAR();
        if (EN_REST & 32) { pg8::Gemm g{XN, WUP, M, FFD, DM}; pg8::StaticOrder S; S.init(M, FFD, F.G, F.bid);
          pg8::EpiStore<1> E{HMID, FFD, 1.f};
          REP(7) pg8::gemm_phase<pg8::EpiStore<1>, pg8::StaticOrder, true, true>(F.lds, g, S, E); }
        GRID_BAR();
        if (EN_REST & 64) {
          if (F.G == 256) {
            pg8::Gemm g{HMID, WDN, M, DM, FFD}; pg8::StaticOrder S; S.init(M, DM, F.G, F.bid);
            pg8::PanelRms s1{(unsigned*)(ws + WS_XB), (unsigned)(l * 6 + 4 + 1)}, s2{(unsigned*)(ws + WS_XB + 512 * 1024), (unsigned)(l * 6 + 5 + 1)};
            pg8::EpiRmsResRms E{XN, RS, (l == 0) ? (float*)nullptr : P.out, P.in[9] + l * DM, s1, s2};
            pg8::gemm_phase<pg8::EpiRmsResRms, pg8::StaticOrder, false, true>(F.lds, g, S, E);
          } else {
            { pg8::Gemm g{HMID, WDN, M, DM, FFD}; pg8::StaticOrder S; S.init(M, DM, F.G, F.bid);
              pg8::EpiStore<0> E{Y2, DM, 1.f};
              pg8::gemm_phase<pg8::EpiStore<0>, pg8::StaticOrder, true, true>(F.lds, g, S, E); }
            GRID_BAR();
            row_phase(F, XN, RS, Y2, P.in[9] + l * DM, (l == 0) ? (float*)nullptr : P.out);
          } }
        if (l == 0) GRID_BAR();
    }
#ifdef DIAG_PHASE
    GRID_BAR();
    if (F.bid == 0 && threadIdx.x == 0) { volatile LAS unsigned long long* ts = (volatile LAS unsigned long long*)(F.lds + LDSCTL_OFF + 512);
        const unsigned long long d = ts[DIAG_PHASE + 1] - ts[DIAG_PHASE]; const float us = (float)d * 0.01f; P.out[0] = 12.f + fminf(fmaxf((us - (float)(DIAG_BASE)) * (1.f / (float)(DIAG_STEP)), 0.f), 89.f); }
#endif
}

static int launch_mega(void* const* d_in, void* d_out, void* d_ws, hipStream_t stream) {
    static int grid = 0;
    if (grid == 0) {
        int dev = 0, cus = 0, per_cu = 0;
        if (hipGetDevice(&dev) != hipSuccess || hipDeviceGetAttribute(&cus, hipDeviceAttributeMultiprocessorCount, dev) != hipSuccess) { fprintf(stderr, "device query failed\n"); grid = -1; return -1; }
        if (hipFuncSetAttribute((const void*)fwd_megakernel, hipFuncAttributeMaxDynamicSharedMemorySize, LDS_BYTES) != hipSuccess) { fprintf(stderr, "hipFuncSetAttribute failed\n"); grid = -1; return -1; }
        if (hipOccupancyMaxActiveBlocksPerMultiprocessor(&per_cu, (const void*)fwd_megakernel, NT, LDS_BYTES) != hipSuccess || per_cu < 1) { fprintf(stderr, "occupancy query: %d\n", per_cu); per_cu = 1; }
        (void)hipGetLastError();
        grid = cus;
    }
    if (grid < 0) return -1;
    (void)hipMemsetAsync((char*)d_ws + WS_CTL, 0, CTL_ZERO_BYTES, stream);
    Params p{};
    for (int i = 0; i < 35; ++i) p.in[i] = (const float*)d_in[i];
    p.out = (float*)d_out; p.ws = (unsigned char*)d_ws;
    hipLaunchKernelGGL(fwd_megakernel, dim3(grid), dim3(NT), LDS_BYTES, stream, p);
    return 0;
}

extern "C" void kernel_launch(void* const* d_in, const int* in_sizes, int n_in, void* d_out, int out_size, void* d_ws, size_t ws_size, hipStream_t stream) {
    launch_mega(d_in, d_out, d_ws, stream);
}
```
